# Optimizing an MI355X kernel written in HIP

```python
import math
import jax, jax.numpy as jnp
from jax import lax
import numpy as np

D_MODEL = 1024
BATCH = 16
SEQ = 2048
DEPTH = 2

N_MIXERS = 2
N_POOL_LAYERS = (DEPTH + 1) // 2
N_RG_LAYERS = DEPTH // 2
MEM_LEN = 256
POOL_WINDOWS = (2, 4, 8, 16)
POOL_GROUPS = len(POOL_WINDOWS)
POOL_GW = D_MODEL // POOL_GROUPS
D_RNN = D_MODEL
RG_HEADS = 4
RG_BLOCK = D_RNN // RG_HEADS
CONV_W = 4
RG_C = 8.0
XA_HEADS = 4
XA_HEAD_DIM = D_MODEL // XA_HEADS
N_GROUPS = 4
EXPERTS_PER_GROUP = 4
N_EXPERTS = N_GROUPS * EXPERTS_PER_GROUP
TOP_K_IN_GROUP = 2
D_EXPERT = D_MODEL // 2
RMS_EPS = 1e-6

kernel_name = "hybrid_pool_rglru_memxattn_hmoe"


def _rms_norm(x, g):
    xf = x.astype(jnp.float32)
    y = xf * lax.rsqrt(jnp.mean(xf * xf, axis=-1, keepdims=True) + RMS_EPS)
    return (y * g.astype(jnp.float32)).astype(x.dtype)


def _pool_mixer(xn, w_grp, scale):
    B, S, D = xn.shape
    xf = xn.astype(jnp.float32)
    pos = jnp.arange(1, S + 1, dtype=jnp.int32)
    outs = []
    for g, w in enumerate(POOL_WINDOWS):
        xg = xf[..., g * POOL_GW:(g + 1) * POOL_GW]
        c = jnp.cumsum(xg, axis=1)
        c_shift = jnp.pad(c, ((0, 0), (w, 0), (0, 0)))[:, :S]
        count = jnp.minimum(pos, w).astype(jnp.float32)[None, :, None]
        outs.append((c - c_shift) / count - xg)
    p = jnp.concatenate(outs, axis=-1).astype(xn.dtype).reshape(B, S, POOL_GROUPS, POOL_GW)
    y = jnp.einsum('bsgi,gio->bsgo', p, w_grp).reshape(B, S, D)
    return y * scale


def _causal_depthwise_conv(x, w, b):
    S = x.shape[1]
    xp = jnp.pad(x, ((0, 0), (CONV_W - 1, 0), (0, 0)))
    y = b
    for k in range(CONV_W):
        y = y + xp[:, k:k + S] * w[k]
    return y


def _lru_combine(c1, c2):
    a1, b1 = c1
    a2, b2 = c2
    return a1 * a2, a2 * b1 + b2


def _rglru_block(xn, w_in, conv_w, conv_b, w_gate, b_gate, lam, w_out):
    B, S, _ = xn.shape
    proj = xn @ w_in
    xb, yb = proj[..., :D_RNN], proj[..., D_RNN:]
    gate_branch = jax.nn.gelu(yb, approximate=True)
    xc = _causal_depthwise_conv(xb, conv_w, conv_b)
    xh = xc.reshape(B, S, RG_HEADS, RG_BLOCK)
    gates = jnp.einsum('bshi,hio->bsho', xh, w_gate) + b_gate
    r = jax.nn.sigmoid(gates[..., :RG_BLOCK].astype(jnp.float32)).reshape(B, S, D_RNN)
    i = jax.nn.sigmoid(gates[..., RG_BLOCK:].astype(jnp.float32)).reshape(B, S, D_RNN)
    log_a = -RG_C * r * jax.nn.softplus(-lam.astype(jnp.float32))
    a = jnp.exp(log_a)
    mult = jnp.sqrt(-jnp.expm1(2.0 * log_a))
    bterm = mult * (i * xc.astype(jnp.float32))
    _, h = lax.associative_scan(_lru_combine, (a, bterm), axis=1)
    y = h.astype(xn.dtype) * gate_branch
    return y @ w_out


def _mem_attention(xn, memn, wq, wkv, wo):
    B, S, D = xn.shape
    M = memn.shape[1]
    q = (xn @ wq).reshape(B, S, XA_HEADS, XA_HEAD_DIM)
    kv = memn @ wkv
    k = kv[..., :D].reshape(B, M, XA_HEADS, XA_HEAD_DIM)
    v = kv[..., D:].reshape(B, M, XA_HEADS, XA_HEAD_DIM)
    s = jnp.einsum('bshd,bmhd->bhsm', q, k).astype(jnp.float32) * (XA_HEAD_DIM ** -0.5)
    p = jax.nn.softmax(s, axis=-1).astype(v.dtype)
    o = jnp.einsum('bhsm,bmhd->bshd', p, v).reshape(B, S, D)
    return o @ wo


def _hier_moe(xn, wg, bg, we, be, w_gu, w_down):
    B, S, D = xn.shape
    t = xn.reshape(B * S, D)
    g_prob = jax.nn.softmax((t @ wg + bg).astype(jnp.float32), axis=-1)
    g_p, g_idx = lax.top_k(g_prob, 1)
    e_logits = (jnp.einsum('nd,gde->nge', t, we) + be).astype(jnp.float32)
    e_sel = jnp.take_along_axis(e_logits, g_idx[:, :, None], axis=1)[:, 0]
    e_prob = jax.nn.softmax(e_sel, axis=-1)
    e_p, e_idx = lax.top_k(e_prob, TOP_K_IN_GROUP)
    e_p = e_p / jnp.sum(e_p, axis=-1, keepdims=True)
    gate_w = g_p * e_p
    expert_id = g_idx * EXPERTS_PER_GROUP + e_idx
    combine = jnp.sum(jax.nn.one_hot(expert_id, N_EXPERTS, dtype=jnp.float32)
                      * gate_w[..., None], axis=1)
    out = jnp.zeros((B * S, D), jnp.float32)
    for e in range(N_EXPERTS):
        gu = t @ w_gu[e]
        h = jax.nn.silu(gu[:, :D_EXPERT]) * gu[:, D_EXPERT:]
        out = out + combine[:, e:e + 1] * (h @ w_down[e]).astype(jnp.float32)
    return out.astype(xn.dtype).reshape(B, S, D)


def setup_inputs(seed: int = 0) -> dict:
    key = jax.random.key(seed)
    ks = iter(jax.random.split(key, 32))

    def nrm(shape, scale):
        return jax.random.normal(next(ks), shape, jnp.float32) * scale

    def gain(shape):
        return 1.0 + nrm(shape, 0.02)

    u = jax.random.uniform(next(ks), (N_RG_LAYERS, D_RNN), jnp.float32, 0.9, 0.999)
    sa = u ** (1.0 / RG_C)
    rg_lambda = jnp.log(sa) - jnp.log1p(-sa)
    return {
        "x": nrm((BATCH, SEQ, D_MODEL), 1.0),
        "mem": nrm((BATCH, MEM_LEN, D_MODEL), 1.0),
        "pool_w": nrm((N_POOL_LAYERS, POOL_GROUPS, POOL_GW, POOL_GW), POOL_GW ** -0.5),
        "pool_scale": gain((N_POOL_LAYERS, D_MODEL)),
        "rg_w_in": nrm((N_RG_LAYERS, D_MODEL, 2 * D_RNN), D_MODEL ** -0.5),
        "rg_conv_w": nrm((N_RG_LAYERS, CONV_W, D_RNN), CONV_W ** -0.5),
        "rg_conv_b": nrm((N_RG_LAYERS, D_RNN), 0.01),
        "rg_w_gate": nrm((N_RG_LAYERS, RG_HEADS, RG_BLOCK, 2 * RG_BLOCK), RG_BLOCK ** -0.5),
        "rg_b_gate": nrm((N_RG_LAYERS, RG_HEADS, 2 * RG_BLOCK), 0.01),
        "rg_lambda": rg_lambda,
        "rg_w_out": nrm((N_RG_LAYERS, D_RNN, D_MODEL), D_RNN ** -0.5),
        "xa_wq": nrm((DEPTH, D_MODEL, D_MODEL), D_MODEL ** -0.5),
        "xa_wkv": nrm((DEPTH, D_MODEL, 2 * D_MODEL), D_MODEL ** -0.5),
        "xa_wo": nrm((DEPTH, D_MODEL, D_MODEL), D_MODEL ** -0.5),
        "moe_wg": nrm((DEPTH, D_MODEL, N_GROUPS), D_MODEL ** -0.5),
        "moe_bg": nrm((DEPTH, N_GROUPS), 0.01),
        "moe_we": nrm((DEPTH, N_GROUPS, D_MODEL, EXPERTS_PER_GROUP), D_MODEL ** -0.5),
        "moe_be": nrm((DEPTH, N_GROUPS, EXPERTS_PER_GROUP), 0.01),
        "moe_w_gu": nrm((DEPTH, N_EXPERTS, D_MODEL, 2 * D_EXPERT), D_MODEL ** -0.5),
        "moe_w_down": nrm((DEPTH, N_EXPERTS, D_EXPERT, D_MODEL), D_EXPERT ** -0.5),
        "norm_mix": gain((DEPTH, D_MODEL)),
        "norm_xattn": gain((DEPTH, D_MODEL)),
        "norm_mem": gain((DEPTH, D_MODEL)),
        "norm_moe": gain((DEPTH, D_MODEL)),
        "norm_final": gain((D_MODEL,)),
    }


def reference(x, mem, pool_w, pool_scale, rg_w_in, rg_conv_w, rg_conv_b, rg_w_gate, rg_b_gate,
              rg_lambda, rg_w_out, xa_wq, xa_wkv, xa_wo, moe_wg, moe_bg, moe_we, moe_be,
              moe_w_gu, moe_w_down, norm_mix, norm_xattn, norm_mem, norm_moe, norm_final):
    h = x
    for i in range(DEPTH):
        j = i // N_MIXERS
        xn = _rms_norm(h, norm_mix[i])
        if i % N_MIXERS == 0:
            h = h + _pool_mixer(xn, pool_w[j], pool_scale[j])
        else:
            h = h + _rglru_block(xn, rg_w_in[j], rg_conv_w[j], rg_conv_b[j], rg_w_gate[j],
                                 rg_b_gate[j], rg_lambda[j], rg_w_out[j])
        h = h + _mem_attention(_rms_norm(h, norm_xattn[i]), _rms_norm(mem, norm_mem[i]),
                               xa_wq[i], xa_wkv[i], xa_wo[i])
        h = h + _hier_moe(_rms_norm(h, norm_moe[i]), moe_wg[i], moe_bg[i], moe_we[i], moe_be[i],
                          moe_w_gu[i], moe_w_down[i])
    return _rms_norm(h, norm_final)
```

```cpp
#include <hip/hip_runtime.h>
#include <cstdio>
#include <cstdint>

#ifndef MK_KREP
#define MK_KREP 1
#endif
#ifndef MK_PER_PHASE
#define MK_PER_PHASE 0
#endif

#define GAS __attribute__((address_space(1)))
#define LAS __attribute__((address_space(3)))
typedef unsigned short bf16;
typedef short bf16x8 __attribute__((ext_vector_type(8)));
typedef float f32x4 __attribute__((ext_vector_type(4)));
typedef float f32x2 __attribute__((ext_vector_type(2)));
typedef unsigned u32x4 __attribute__((ext_vector_type(4)));
typedef unsigned u32x2 __attribute__((ext_vector_type(2)));

constexpr int NB = 16, SEQ = 2048, D = 1024, NTOK = NB * SEQ, MEML = 256, NMR = NB * MEML;
constexpr int NEXP = 16, DE = 512;
constexpr float EPS = 1e-6f;
constexpr float LOG2E = 1.4426950408889634f;
constexpr int NPH = 21;

constexpr size_t MiB = 1u << 20;
constexpr size_t WS_CTL = 0, CTL_ZERO_BYTES = 1 * MiB;
constexpr int CW_BAR = 4096;
constexpr int CW_CNT = 16384;
constexpr size_t WS_RSTD_A = 1 * MiB;
constexpr size_t WS_RSTD_B = 1 * MiB + 128 * 1024;
constexpr size_t WS_RSTD_X = 1 * MiB + 256 * 1024;
constexpr size_t WS_SS16 = 2 * MiB;
constexpr size_t WS_WRB = 4 * MiB;
constexpr size_t WS_SPL = 4 * MiB + 256 * 1024;
constexpr size_t WS_GW = 5 * MiB;
constexpr size_t WS_LIST = 6 * MiB;
constexpr size_t WS_W_POOL = 8 * MiB;
constexpr size_t WS_W_GATE = 8 * MiB + 512 * 1024;
constexpr size_t WS_W_OUT = 10 * MiB;
constexpr size_t WS_W_IN = 12 * MiB;
constexpr size_t WS_W_Q = 16 * MiB;
constexpr size_t WS_W_OT = 20 * MiB;
constexpr size_t WS_W_KV = 24 * MiB;
constexpr size_t WS_W_DOWN = 32 * MiB;
constexpr size_t WS_W_GU = 64 * MiB;
constexpr size_t WS_K = 128 * MiB;
constexpr size_t WS_V = 144 * MiB;
constexpr size_t WS_BS = 160 * MiB;
constexpr size_t WS_BO = 192 * MiB;
constexpr size_t WS_HA = 224 * MiB;
constexpr size_t WS_HB = 288 * MiB;
constexpr size_t WS_MEMN = 352 * MiB;
constexpr size_t WS_AGS = 368 * MiB;
constexpr size_t WS_AGB = 372 * MiB;
constexpr size_t WS_Y = 384 * MiB;
constexpr size_t WS_END = 512 * MiB;
constexpr size_t OB_P0 = 0, OB_PATT = 64 * MiB, OB_HMID = 0, OB_LOGA = 0, OB_BT = 64 * MiB;

constexpr int RING_OFF = 0, RING_BYTES = 131072;
constexpr int XCH_OFF = 131072;
constexpr int TAB_OFF = 139264;
constexpr int TAB2_OFF = 147456;
constexpr int MISC_OFF = 155648;
constexpr int LDS_BYTES = 155904;
constexpr int MAXU = 8;

#define LDS_WAIT() asm volatile("s_waitcnt lgkmcnt(0)" ::: "memory")
#define VM_WAIT() asm volatile("s_waitcnt vmcnt(0)" ::: "memory")

__device__ __forceinline__ unsigned f2bf(float f) { unsigned u = __builtin_bit_cast(unsigned, f); return (u + 0x7fffu + ((u >> 16) & 1u)) >> 16; }
__device__ __forceinline__ unsigned pk2(float lo, float hi) { return f2bf(lo) | (f2bf(hi) << 16); }
__device__ __forceinline__ float bflo(unsigned w) { return __builtin_bit_cast(float, w << 16); }
__device__ __forceinline__ float bfhi(unsigned w) { return __builtin_bit_cast(float, w & 0xffff0000u); }
__device__ __forceinline__ unsigned cvt_pk_bf16(float lo, float hi) { unsigned r; asm volatile("v_cvt_pk_bf16_f32 %0, %1, %2" : "=v"(r) : "v"(lo), "v"(hi)); return r; }
__device__ __forceinline__ u32x4 pack8(f32x4 a, f32x4 b) { u32x4 w; w.x = cvt_pk_bf16(a[0], a[1]); w.y = cvt_pk_bf16(a[2], a[3]); w.z = cvt_pk_bf16(b[0], b[1]); w.w = cvt_pk_bf16(b[2], b[3]); return w; }
__device__ __forceinline__ void unpack8(u32x4 w, f32x4& a, f32x4& b) { a[0] = bflo(w.x); a[1] = bfhi(w.x); a[2] = bflo(w.y); a[3] = bfhi(w.y); b[0] = bflo(w.z); b[1] = bfhi(w.z); b[2] = bflo(w.w); b[3] = bfhi(w.w); }
__device__ __forceinline__ float wave_sum(float v) {
#pragma unroll
    for (int o = 1; o < 64; o <<= 1) v += __shfl_xor(v, o);
    return v;
}
__device__ __forceinline__ float fast_exp2(float x) { return __builtin_amdgcn_exp2f(x); }
__device__ __forceinline__ float fast_rcp(float x) { return __builtin_amdgcn_rcpf(x); }
__device__ __forceinline__ float sigmoidf_(float x) { return fast_rcp(1.0f + fast_exp2(-x * LOG2E)); }

namespace pg8 {
constexpr int BM = 256, BK = 64, HALF = 128, HTB = HALF * BK * 2, STAGE_BYTES = 8 * HTB, NXCD = 8, WGM = 8;
__host__ __device__ __forceinline__ int lds_byte(int r, int c) { const int st = (r >> 4) * 2 + (c >> 5), rr = r & 15, cc = c & 31, ob = rr * 64 + cc * 2; return st * 1024 + (ob ^ (((ob >> 9) & 1) << 5)); }
__host__ __device__ __forceinline__ void stage_rc(int b, int& R, int& C) { const int st = b / 1024, sb = b % 1024, swz = sb ^ (((sb >> 9) & 1) << 5); R = (st >> 1) * 16 + swz / 64; C = (st & 1) * 32 + (swz % 64) / 2; }
__host__ __device__ __forceinline__ int perm32(int rho) { const int n = rho >> 4, i = rho & 15; return 8 * (i >> 2) + 4 * n + (i & 3); }

struct Unit { const char* A; const char* B; char* C; int row0, col0, aux; };

__device__ __forceinline__ bool tile_of(int i, int G, int c, int nM, int nN, int& pm, int& pn) {
    const int nwg = nM * nN; const long L = (long)i * G + c; if (L >= nwg) return false;
    int wgid = (int)L; { const int q = nwg / NXCD, r = nwg % NXCD, xcd = wgid % NXCD, off = wgid / NXCD; wgid = (xcd < r ? xcd * (q + 1) : r * (q + 1) + (xcd - r) * q) + off; }
    const int nig = WGM * nN, gid = wgid / nig, fm = gid * WGM, gsz = (nM - fm) < WGM ? (nM - fm) : WGM;
    pm = fm + ((wgid % nig) % gsz); pn = (wgid % nig) / gsz; return true;
}

template <class Epi, class Sched, bool GATHER>
__device__ __forceinline__ void gemm_phase(LAS unsigned char* lds, const int K, const unsigned lda, const unsigned ldb, const Sched& S, const Epi& E, const LAS int* tab) {
    const int tid = threadIdx.x, wid = __builtin_amdgcn_readfirstlane(tid >> 6), lane = tid & 63, wr = wid >> 2, wc = wid & 3, fr = lane & 15, fq = lane >> 4;
    const int nt = K / BK;
    unsigned vA[2], vB[2], vG[2][2]; int rA[2]; unsigned cA2[2];
#pragma unroll
    for (int i = 0; i < 2; ++i) { int R, C; stage_rc(tid * 16 + i * 8192, R, C); const int Rb = (R & ~31) + perm32(R & 31);
        vA[i] = (unsigned)R * lda + (unsigned)C * 2u; vB[i] = (unsigned)Rb * ldb + (unsigned)C * 2u; rA[i] = R; cA2[i] = (unsigned)C * 2u; vG[0][i] = 0; vG[1][i] = 0; }
    const size_t kstep = (size_t)(BK * 2);
    const size_t hsA = (size_t)HALF * lda, hsB = (size_t)HALF * ldb;
    const unsigned ldsw = (unsigned)wid * 1024u;
    const int aoff = lds_byte(wr * 64 + fr, fq * 8), boff = lds_byte(wc * 32 + fr, fq * 8);
#define PG8_SA(b, h) (((b) * 2 + (h)) * HTB)
#define PG8_SB(b, h) ((4 + (b) * 2 + (h)) * HTB)
#define PG8_STAGE_B(bufoff, gbase) do { _Pragma("unroll") for (int _i = 0; _i < 2; ++_i) \
        __builtin_amdgcn_global_load_lds((const unsigned*)((const char*)(gbase) + vB[_i]), (LAS unsigned*)(lds + (bufoff) + ldsw + _i * 8192), 16, 0, 0); } while (0)
#define PG8_STAGE_A(bufoff, gbase, h) do { _Pragma("unroll") for (int _i = 0; _i < 2; ++_i) { \
        if constexpr (GATHER) __builtin_amdgcn_global_load_lds((const unsigned*)((const char*)(gbase) + vG[h][_i]), (LAS unsigned*)(lds + (bufoff) + ldsw + _i * 8192), 16, 0, 0); \
        else __builtin_amdgcn_global_load_lds((const unsigned*)((const char*)(gbase) + (h) * hsA + vA[_i]), (LAS unsigned*)(lds + (bufoff) + ldsw + _i * 8192), 16, 0, 0); } } while (0)
#define PG8_LOADG(ui_) do { const int _u = ((ui_) < MAXU ? (ui_) : (MAXU - 1)) * 256; _Pragma("unroll") for (int _h = 0; _h < 2; ++_h) _Pragma("unroll") for (int _i = 0; _i < 2; ++_i) \
        vG[_h][_i] = (unsigned)tab[_u + rA[_i] + 128 * _h] * lda + cA2[_i]; } while (0)
#define PG8_LDA(dst, b, h) do { _Pragma("unroll") for (int m = 0; m < 4; ++m) _Pragma("unroll") for (int k = 0; k < 2; ++k) dst[m][k] = *(const LAS bf16x8*)(lds + PG8_SA(b, h) + aoff + m * 2048 + k * 1024); } while (0)
#define PG8_LDB(dst, b, h) do { _Pragma("unroll") for (int n = 0; n < 2; ++n) _Pragma("unroll") for (int k = 0; k < 2; ++k) dst[n][k] = *(const LAS bf16x8*)(lds + PG8_SB(b, h) + boff + n * 2048 + k * 1024); } while (0)
#define PG8_MMA(ai, bj, At, Bt) do { __builtin_amdgcn_s_setprio(1); _Pragma("unroll") for (int m = 0; m < 4; ++m) _Pragma("unroll") for (int n = 0; n < 2; ++n) _Pragma("unroll") for (int k = 0; k < 2; ++k) \
        acc[ai][bj][m][n] = __builtin_amdgcn_mfma_f32_16x16x32_bf16(Bt[n][k], At[m][k], acc[ai][bj][m][n], 0, 0, 0); __builtin_amdgcn_s_setprio(0); } while (0)
#define PG8_WAIT_V(n) asm volatile("s_waitcnt vmcnt(" #n ")" ::: "memory")
#define PG8_WAIT_L(n) asm volatile("s_waitcnt lgkmcnt(" #n ")" ::: "memory")
#define PG8_BAR __builtin_amdgcn_s_barrier()
#define PG8_SCHED __builtin_amdgcn_sched_barrier(0)
    Unit cur, nxt; int ui = 0;
    if (!S.next(0, cur)) return;
    f32x4 acc[2][2][4][2];
#pragma unroll
    for (int a = 0; a < 2; ++a)
#pragma unroll
        for (int b = 0; b < 2; ++b)
#pragma unroll
            for (int m = 0; m < 4; ++m)
#pragma unroll
                for (int n = 0; n < 2; ++n) acc[a][b][m][n] = (f32x4){0.f, 0.f, 0.f, 0.f};
    bf16x8 At[4][2], B0[2][2], B1[2][2];
    const char* cA = cur.A; const char* cB = cur.B;
    if constexpr (GATHER) { PG8_LOADG(0); }
    PG8_STAGE_B(PG8_SB(0, 0), cB); PG8_STAGE_B(PG8_SB(0, 1), cB + hsB); PG8_STAGE_A(PG8_SA(0, 0), cA, 0); PG8_STAGE_A(PG8_SA(0, 1), cA, 1);
    if (wr == 1) PG8_BAR;
    PG8_WAIT_V(2); PG8_BAR;
    PG8_STAGE_B(PG8_SB(1, 0), cB + kstep); PG8_STAGE_A(PG8_SA(1, 0), cA + kstep, 0); PG8_STAGE_B(PG8_SB(1, 1), cB + hsB + kstep);
    PG8_WAIT_V(6); PG8_BAR;
    for (;;) {
        const bool has_next = S.next(ui + 1, nxt);
        const char* nA = has_next ? nxt.A : cA; const char* nB = has_next ? nxt.B : cB;
#pragma nounroll
        for (int t = 0; t < nt * MK_KREP; t += 2) {
            const bool last = (t == nt * MK_KREP - 2);
            const char* a1 = cA + (size_t)(MK_KREP == 1 ? (t + 1) : ((t + 1) % nt)) * kstep;
            const int t2 = (MK_KREP == 1) ? (t + 2) : ((t + 2) % nt);
            const char* a2 = last ? nA : cA + (size_t)t2 * kstep; const char* b2 = last ? nB : cB + (size_t)t2 * kstep;
            const char* a3 = a2 + kstep; const char* b3 = b2 + kstep;
            PG8_LDB(B0, 0, 0); PG8_LDB(B1, 0, 1); PG8_SCHED; PG8_LDA(At, 0, 0); PG8_STAGE_A(PG8_SA(1, 1), a1, 1);
            PG8_WAIT_V(8); PG8_WAIT_L(0); PG8_BAR; PG8_MMA(0, 0, At, B0); PG8_MMA(0, 1, At, B1); PG8_BAR; PG8_SCHED;
            if constexpr (GATHER) { if (last && has_next) { PG8_LOADG(ui + 1); } }
            PG8_LDA(At, 0, 1); PG8_STAGE_B(PG8_SB(0, 0), b2); PG8_STAGE_B(PG8_SB(0, 1), b2 + hsB); PG8_STAGE_A(PG8_SA(0, 0), a2, 0);
            PG8_WAIT_V(8); PG8_WAIT_L(0); PG8_BAR; PG8_MMA(1, 0, At, B0); PG8_MMA(1, 1, At, B1); PG8_BAR; PG8_SCHED;
            PG8_LDB(B0, 1, 0); PG8_LDB(B1, 1, 1); PG8_SCHED; PG8_LDA(At, 1, 0); PG8_STAGE_A(PG8_SA(0, 1), a2, 1);
            PG8_WAIT_V(8); PG8_WAIT_L(0); PG8_BAR; PG8_MMA(0, 0, At, B0); PG8_MMA(0, 1, At, B1); PG8_BAR; PG8_SCHED;
            PG8_LDA(At, 1, 1); PG8_STAGE_B(PG8_SB(1, 0), b3); PG8_STAGE_B(PG8_SB(1, 1), b3 + hsB); PG8_STAGE_A(PG8_SA(1, 0), a3, 0);
            PG8_WAIT_V(8); PG8_WAIT_L(0); PG8_BAR; PG8_MMA(1, 0, At, B0); PG8_MMA(1, 1, At, B1); PG8_BAR; PG8_SCHED;
        }
        if (wr == 0) PG8_BAR;
        if (MK_KREP != 1) {
#pragma unroll
            for (int a = 0; a < 2; ++a)
#pragma unroll
                for (int b = 0; b < 2; ++b)
#pragma unroll
                    for (int m = 0; m < 4; ++m)
#pragma unroll
                        for (int n = 0; n < 2; ++n) acc[a][b][m][n] *= (1.0f / MK_KREP);
        }
        E(acc, cur, wr, wc, fr, fq);
        if (!has_next) break;
#pragma unroll
        for (int a = 0; a < 2; ++a)
#pragma unroll
            for (int b = 0; b < 2; ++b)
#pragma unroll
                for (int m = 0; m < 4; ++m)
#pragma unroll
                    for (int n = 0; n < 2; ++n) acc[a][b][m][n] = (f32x4){0.f, 0.f, 0.f, 0.f};
        cur = nxt; cA = nA; cB = nB; ++ui;
        if (wr == 1) PG8_BAR;
    }
    PG8_WAIT_V(0);
    PG8_BAR;
#undef PG8_SA
#undef PG8_SB
#undef PG8_STAGE_A
#undef PG8_STAGE_B
#undef PG8_LOADG
#undef PG8_LDA
#undef PG8_LDB
#undef PG8_MMA
#undef PG8_WAIT_V
#undef PG8_WAIT_L
#undef PG8_BAR
#undef PG8_SCHED
}

typedef f32x4 Acc[2][2][4][2];
#ifndef MK_EPI_SC1
#define MK_EPI_SC1 0
#endif
__device__ __forceinline__ void st16(bf16* p, u32x4 v) {
#if MK_EPI_SC1
    asm volatile("global_store_dwordx4 %0, %1, off sc1\n\ts_nop 1" :: "v"(p), "v"(v) : "memory");
#else
    *(u32x4*)p = v;
#endif
}

struct EpiPlain {
    int ldc;
    __device__ __forceinline__ void operator()(Acc& acc, const Unit& u, int wr, int wc, int fr, int fq) const {
        bf16* base = (bf16*)u.C + (size_t)(wr * 64 + fr) * ldc + wc * 32 + 8 * fq;
#pragma unroll
        for (int ai = 0; ai < 2; ++ai)
#pragma unroll
            for (int m = 0; m < 4; ++m) { bf16* rowp = base + (size_t)(ai * 128 + m * 16) * ldc;
#pragma unroll
                for (int bj = 0; bj < 2; ++bj) st16(rowp + bj * 128, pack8(acc[ai][bj][m][0], acc[ai][bj][m][1])); }
    }
};
struct EpiRes {
    const bf16* hin; bf16* hout; float* ss16;
    __device__ __forceinline__ void operator()(Acc& acc, const Unit& u, int wr, int wc, int fr, int fq) const {
#pragma unroll
        for (int ai = 0; ai < 2; ++ai)
#pragma unroll
            for (int m = 0; m < 4; ++m) { const int row = u.row0 + ai * 128 + wr * 64 + m * 16 + fr; const size_t ro = (size_t)row * 1024 + u.col0 + wc * 32 + 8 * fq; float s = 0.f;
#pragma unroll
                for (int bj = 0; bj < 2; ++bj) { const u32x4 hv = *(const u32x4*)(hin + ro + bj * 128); f32x4 a, b; unpack8(hv, a, b); a += acc[ai][bj][m][0]; b += acc[ai][bj][m][1];
                    s += (a[0] * a[0] + a[1] * a[1]) + (a[2] * a[2] + a[3] * a[3]) + (b[0] * b[0] + b[1] * b[1]) + (b[2] * b[2] + b[3] * b[3]);
                    st16(hout + ro + bj * 128, pack8(a, b)); }
                s += __shfl_xor(s, 16); s += __shfl_xor(s, 32);
                if (fq == 0) ss16[(size_t)row * 16 + (u.col0 >> 8) * 4 + wc] = s; }
    }
};
struct EpiPool {
    const float* x; const float* scale; bf16* hout; float* ss16;
    __device__ __forceinline__ void operator()(Acc& acc, const Unit& u, int wr, int wc, int fr, int fq) const {
        const int cb = u.col0 + wc * 32 + 8 * fq;
        f32x4 sc[2][2];
#pragma unroll
        for (int bj = 0; bj < 2; ++bj) { sc[bj][0] = *(const f32x4*)(scale + cb + bj * 128); sc[bj][1] = *(const f32x4*)(scale + cb + bj * 128 + 4); }
#pragma unroll
        for (int ai = 0; ai < 2; ++ai)
#pragma unroll
            for (int m = 0; m < 4; ++m) { const int row = u.row0 + ai * 128 + wr * 64 + m * 16 + fr; const size_t ro = (size_t)row * 1024 + cb; float s = 0.f;
#pragma unroll
                for (int bj = 0; bj < 2; ++bj) { f32x4 a = *(const f32x4*)(x + ro + bj * 128), b = *(const f32x4*)(x + ro + bj * 128 + 4);
                    a += acc[ai][bj][m][0] * sc[bj][0]; b += acc[ai][bj][m][1] * sc[bj][1];
                    s += (a[0] * a[0] + a[1] * a[1]) + (a[2] * a[2] + a[3] * a[3]) + (b[0] * b[0] + b[1] * b[1]) + (b[2] * b[2] + b[3] * b[3]);
                    st16(hout + ro + bj * 128, pack8(a, b)); }
                s += __shfl_xor(s, 16); s += __shfl_xor(s, 32);
                if (fq == 0) ss16[(size_t)row * 16 + (u.col0 >> 8) * 4 + wc] = s; }
    }
};
struct EpiS {
    bf16* P; const float* ss16; LAS f32x2* xch;
    __device__ __forceinline__ void operator()(Acc& acc, const Unit& u, int wr, int wc, int fr, int fq) const {
        float mxs[2][4];
#pragma unroll
        for (int ai = 0; ai < 2; ++ai)
#pragma unroll
            for (int m = 0; m < 4; ++m) { const int rl = ai * 128 + wr * 64 + m * 16 + fr; const int row = u.row0 + rl;
                const f32x4* sp = (const f32x4*)(ss16 + (size_t)row * 16); const f32x4 q0 = sp[0], q1 = sp[1], q2 = sp[2], q3 = sp[3];
                const f32x4 qs = (q0 + q1) + (q2 + q3); const float ss = (qs[0] + qs[1]) + (qs[2] + qs[3]);
                const float rs = __builtin_amdgcn_rsqf(ss * (1.0f / 1024.0f) + EPS);
                float mx = -3.0e38f;
#pragma unroll
                for (int bj = 0; bj < 2; ++bj)
#pragma unroll
                    for (int n = 0; n < 2; ++n) { f32x4 v = acc[ai][bj][m][n] * rs; acc[ai][bj][m][n] = v; mx = fmaxf(mx, fmaxf(fmaxf(v[0], v[1]), fmaxf(v[2], v[3]))); }
                mx = fmaxf(mx, __shfl_xor(mx, 16)); mx = fmaxf(mx, __shfl_xor(mx, 32));
                float l = 0.f;
#pragma unroll
                for (int bj = 0; bj < 2; ++bj)
#pragma unroll
                    for (int n = 0; n < 2; ++n) { f32x4 v = acc[ai][bj][m][n]; f32x4 e; e[0] = fast_exp2(v[0] - mx); e[1] = fast_exp2(v[1] - mx); e[2] = fast_exp2(v[2] - mx); e[3] = fast_exp2(v[3] - mx);
                        acc[ai][bj][m][n] = e; l += (e[0] + e[1]) + (e[2] + e[3]); }
                l += __shfl_xor(l, 16); l += __shfl_xor(l, 32);
                if (fq == 0) xch[rl * 4 + wc] = (f32x2){mx, l};
                mxs[ai][m] = mx; }
        asm volatile("s_waitcnt lgkmcnt(0)" ::: "memory"); __builtin_amdgcn_s_barrier(); asm volatile("" ::: "memory");
#pragma unroll
        for (int ai = 0; ai < 2; ++ai)
#pragma unroll
            for (int m = 0; m < 4; ++m) { const int rl = ai * 128 + wr * 64 + m * 16 + fr; const int row = u.row0 + rl;
                const f32x2 p0 = xch[rl * 4 + 0], p1 = xch[rl * 4 + 1], p2 = xch[rl * 4 + 2], p3 = xch[rl * 4 + 3];
                const float M = fmaxf(fmaxf(p0.x, p1.x), fmaxf(p2.x, p3.x));
                const float L = (p0.y * fast_exp2(p0.x - M) + p1.y * fast_exp2(p1.x - M)) + (p2.y * fast_exp2(p2.x - M) + p3.y * fast_exp2(p3.x - M));
                const float f = fast_exp2(mxs[ai][m] - M) * fast_rcp(L);
                bf16* rowp = P + (size_t)row * 1024 + u.col0 + wc * 32 + 8 * fq;
#pragma unroll
                for (int bj = 0; bj < 2; ++bj) st16(rowp + bj * 128, pack8(acc[ai][bj][m][0] * f, acc[ai][bj][m][1] * f)); }
    }
};
struct EpiGU {
    bf16* hmid; const LAS float* tab2;
    __device__ __forceinline__ void operator()(Acc& acc, const Unit& u, int wr, int wc, int fr, int fq) const {
        const int ub = (u.aux < MAXU ? u.aux : MAXU - 1) * 256;
#pragma unroll
        for (int ai = 0; ai < 2; ++ai)
#pragma unroll
            for (int m = 0; m < 4; ++m) { const int rl = ai * 128 + wr * 64 + m * 16 + fr; const float rs = tab2[ub + rl];
                f32x4 o[2];
#pragma unroll
                for (int n = 0; n < 2; ++n)
#pragma unroll
                    for (int j = 0; j < 4; ++j) { const float g = acc[ai][0][m][n][j] * rs, uu = acc[ai][1][m][n][j] * rs; o[n][j] = g * sigmoidf_(g) * uu; }
                st16(hmid + (size_t)(u.row0 + rl) * 512 + (u.col0 >> 1) + wc * 32 + 8 * fq, pack8(o[0], o[1])); }
    }
};
struct EpiDown {
    bf16* y; const LAS int* tab; const LAS float* tab2;
    __device__ __forceinline__ void operator()(Acc& acc, const Unit& u, int wr, int wc, int fr, int fq) const {
        const int ub = (u.aux < MAXU ? u.aux : MAXU - 1) * 256;
#pragma unroll
        for (int ai = 0; ai < 2; ++ai)
#pragma unroll
            for (int m = 0; m < 4; ++m) { const int rl = ai * 128 + wr * 64 + m * 16 + fr; const int slot = tab[ub + rl]; const float w = tab2[ub + rl];
                if (slot >= 0) { bf16* rowp = y + (size_t)slot * 1024 + u.col0 + wc * 32 + 8 * fq;
#pragma unroll
                    for (int bj = 0; bj < 2; ++bj) st16(rowp + bj * 128, pack8(acc[ai][bj][m][0] * w, acc[ai][bj][m][1] * w)); } }
    }
};
struct EpiIn {
    bf16* xb; bf16* gate; const float* rstd;
    __device__ __forceinline__ void operator()(Acc& acc, const Unit& u, int wr, int wc, int fr, int fq) const {
        const bool isg = u.col0 >= 1024; bf16* dst = isg ? gate : xb; const int c0 = (u.col0 & 1023) + wc * 32 + 8 * fq;
#pragma unroll
        for (int ai = 0; ai < 2; ++ai)
#pragma unroll
            for (int m = 0; m < 4; ++m) { const int row = u.row0 + ai * 128 + wr * 64 + m * 16 + fr; const float rs = rstd[row];
#pragma unroll
                for (int bj = 0; bj < 2; ++bj) { f32x4 o[2];
#pragma unroll
                    for (int n = 0; n < 2; ++n)
#pragma unroll
                        for (int j = 0; j < 4; ++j) { float v = acc[ai][bj][m][n][j] * rs; if (isg) { const float t = 1.5957691216057308f * (v + 0.044715f * v * v * v); v = v * sigmoidf_(t); } o[n][j] = v; }
                    st16(dst + (size_t)row * 1024 + c0 + bj * 128, pack8(o[0], o[1])); } }
    }
};
struct EpiGates {
    const bf16* xc; bf16* loga; bf16* bt; const float* bgate; const float* spl;
    __device__ __forceinline__ void operator()(Acc& acc, const Unit& u, int wr, int wc, int fr, int fq) const {
        const int ch = u.col0 + wc * 32 + 8 * fq;
        const int hh = u.col0 >> 8, cin = (u.col0 & 255) + wc * 32 + 8 * fq;
        f32x4 br[2], bi[2], sp[2];
#pragma unroll
        for (int n = 0; n < 2; ++n) { br[n] = *(const f32x4*)(bgate + hh * 512 + cin + 4 * n); bi[n] = *(const f32x4*)(bgate + hh * 512 + 256 + cin + 4 * n); sp[n] = *(const f32x4*)(spl + ch + 4 * n); }
#pragma unroll
        for (int ai = 0; ai < 2; ++ai)
#pragma unroll
            for (int m = 0; m < 4; ++m) { const int row = u.row0 + ai * 128 + wr * 64 + m * 16 + fr; const size_t ro = (size_t)row * 1024 + ch;
                const u32x4 xv = *(const u32x4*)(xc + ro); f32x4 x[2]; unpack8(xv, x[0], x[1]);
                f32x4 la[2], bb[2];
#pragma unroll
                for (int n = 0; n < 2; ++n)
#pragma unroll
                    for (int j = 0; j < 4; ++j) { const float er = 1.0f + fast_exp2(fminf(-(acc[ai][0][m][n][j] + br[n][j]) * LOG2E, 60.f)), ei = 1.0f + fast_exp2(fminf(-(acc[ai][1][m][n][j] + bi[n][j]) * LOG2E, 60.f));
                        const float q = fast_rcp(er * ei); const float r = q * ei, ig = q * er;
                        const float l = -8.0f * r * sp[n][j]; const float a2 = fast_exp2(2.0f * LOG2E * l); const float mult = __builtin_sqrtf(fmaxf(1.0f - a2, 0.f));
                        la[n][j] = l; bb[n][j] = mult * ig * x[n][j]; }
                *(u32x4*)(loga + ro) = pack8(la[0], la[1]); *(u32x4*)(bt + ro) = pack8(bb[0], bb[1]); }
    }
};
}

#define XB_TMO      128
#define XB_XCNT(j)  (256  + 64 * (j))
#define XB_XSUB(j)  (1280 + 64 * (j))
#define XB_XGEN(j)  (2304 + 64 * (j))
#define XB_TOP      3328
#define XB_TOPGEN   3392
#define XCD_BAR_WORDS 3456
#define XB_SPIN_CAP (1u << 18)

__device__ __forceinline__ unsigned xb_ld(unsigned* p)              { return __hip_atomic_load(p, __ATOMIC_RELAXED, __HIP_MEMORY_SCOPE_AGENT); }
__device__ __forceinline__ unsigned xb_add(unsigned* p, unsigned v) { return __hip_atomic_fetch_add(p, v, __ATOMIC_RELAXED, __HIP_MEMORY_SCOPE_AGENT); }
__device__ __forceinline__ unsigned xb_xcc_id() { return (unsigned)__builtin_amdgcn_s_getreg((3 << 11) | 20) & 0xFu; }
#define XB_SPIN(cond, bar) do { unsigned _sp = 0; while (cond) { __builtin_amdgcn_s_sleep(1); \
    if ((++_sp & 255u) == 0u) { if (xb_ld(&(bar)[XB_TMO])) break; if (_sp > XB_SPIN_CAP) { atomicAdd(&(bar)[XB_TMO], 1u); break; } } } } while (0)

struct XcdBarrier { unsigned* bar; unsigned x; volatile LAS unsigned* st; };

__device__ __forceinline__ XcdBarrier xcd_barrier_post(unsigned* bar, volatile LAS unsigned* st) {
    XcdBarrier b; b.bar = bar; b.x = xb_xcc_id(); b.st = st;
    if (threadIdx.x == 0) (void)xb_add(&bar[XB_XCNT(b.x)], 1u);
    return b;
}
__device__ __forceinline__ void xcd_barrier_complete(unsigned* bar, unsigned x, unsigned& nloc, unsigned& nx) {
    const unsigned G = gridDim.x * gridDim.y * gridDim.z;
    unsigned sum, cnt, mine, sp = 0u;
    for (;;) {
        sum = 0u; cnt = 0u; mine = 0u;
#pragma unroll
        for (unsigned j = 0; j < 16; ++j) { const unsigned c = xb_ld(&bar[XB_XCNT(j)]); sum += c; cnt += (c > 0u) ? 1u : 0u; mine = (j == x) ? c : mine; }
        if (sum == G) break;
        __builtin_amdgcn_s_sleep(1);
        if ((++sp & 255u) == 0u) { if (xb_ld(&bar[XB_TMO])) break; if (sp > XB_SPIN_CAP) { atomicAdd(&bar[XB_TMO], 1u); break; } }
    }
    nloc = mine > 0u ? mine : 1u; nx = cnt > 0u ? cnt : 1u;
}
__device__ __forceinline__ void xcd_barrier(const XcdBarrier& b) {
    asm volatile("s_waitcnt vmcnt(0)" ::: "memory");
    __syncthreads();
    if (threadIdx.x == 0) {
        unsigned* bar = b.bar;
        __builtin_amdgcn_s_waitcnt(0);
        unsigned nloc = b.st[0], nx = b.st[1];
        if (nloc == 0u) { xcd_barrier_complete(bar, b.x, nloc, nx); b.st[0] = nloc; b.st[1] = nx; }
        const unsigned old = xb_add(&bar[XB_XSUB(b.x)], 1u);
        const unsigned gen = old / nloc;
        if (old + 1u == (gen + 1u) * nloc) {
            __builtin_amdgcn_fence(__ATOMIC_RELEASE, "agent");
            asm volatile("s_waitcnt vmcnt(0)" ::: "memory");
            const unsigned og = xb_add(&bar[XB_TOP], 1u);
            const unsigned tg = og / nx;
            if (og + 1u == (tg + 1u) * nx) xb_add(&bar[XB_TOPGEN], 1u);
            else XB_SPIN(xb_ld(&bar[XB_TOPGEN]) == tg, bar);
            __builtin_amdgcn_fence(__ATOMIC_ACQUIRE, "agent");
            xb_add(&bar[XB_XGEN(b.x)], 1u);
            asm volatile("s_waitcnt vmcnt(0)" ::: "memory");
        } else {
            XB_SPIN(xb_ld(&bar[XB_XGEN(b.x)]) == gen, bar);
            __builtin_amdgcn_fence(__ATOMIC_ACQUIRE, "agent");
            asm volatile("s_waitcnt vmcnt(0)" ::: "memory");
        }
    }
    __syncthreads();
}

struct Args { const float* in[25]; float* out; unsigned char* ws; int ph_lo, ph_hi; unsigned dup, pad; };
struct Frame {
    LAS unsigned char* lds;
    int tid, lane, wave, G, vcu;
    unsigned char* ws; unsigned char* ob;
};
enum { I_X = 0, I_MEM, I_POOL_W, I_POOL_SCALE, I_RG_W_IN, I_RG_CONV_W, I_RG_CONV_B, I_RG_W_GATE, I_RG_B_GATE, I_RG_LAMBDA, I_RG_W_OUT, I_XA_WQ, I_XA_WKV, I_XA_WO,
       I_MOE_WG, I_MOE_BG, I_MOE_WE, I_MOE_BE, I_MOE_W_GU, I_MOE_W_DOWN, I_NORM_MIX, I_NORM_XATTN, I_NORM_MEM, I_NORM_MOE, I_NORM_FINAL };

__device__ __forceinline__ void tr_item(const float* W, int ldw, int k0, int scol0, const float* gain, bf16* out, int ldo, int orow0, LAS float* scr, int lane) {
    f32x4 v[8];
    const int kq = lane >> 3, n4 = (lane & 7) * 4;
#pragma unroll
    for (int i = 0; i < 8; ++i) v[i] = *(const f32x4*)(W + (size_t)(k0 + 8 * i + kq) * ldw + scol0 + n4);
    if (gain) {
#pragma unroll
        for (int i = 0; i < 8; ++i) v[i] *= gain[k0 + 8 * i + kq];
    }
#pragma unroll
    for (int i = 0; i < 8; ++i) { LAS float* d = scr + (8 * i + kq) * 33 + n4; d[0] = v[i][0]; d[1] = v[i][1]; d[2] = v[i][2]; d[3] = v[i][3]; }
    LDS_WAIT(); asm volatile("" ::: "memory");
    const int c = lane & 7;
#pragma unroll
    for (int j = 0; j < 4; ++j) { const int n = (lane >> 3) + 8 * j; const LAS float* s = scr + (8 * c) * 33 + n;
        u32x4 o; o.x = pk2(s[0 * 33], s[1 * 33]); o.y = pk2(s[2 * 33], s[3 * 33]); o.z = pk2(s[4 * 33], s[5 * 33]); o.w = pk2(s[6 * 33], s[7 * 33]);
        *(u32x4*)(out + (size_t)(orow0 + n) * ldo + k0 + 8 * c) = o; }
    LDS_WAIT(); asm volatile("" ::: "memory");
}
__device__ __forceinline__ void tr_job(int q, const float* W, int Kdim, int ldw, int NO, int mapmode, int mapoff, const float* gain, bf16* out, LAS float* scr, int lane) {
    const int nblk = NO / 32, kb = q / nblk, nb = q % nblk, n0 = 32 * nb;
    int sc = n0;
    if (mapmode) { const int tile = n0 >> 8, w = n0 & 255; sc = (w < 128) ? (128 * tile + w) : (mapoff + 128 * tile + (w - 128)); }
    tr_item(W, ldw, 64 * kb, sc, gain, out, Kdim, n0, scr, lane);
}
__device__ __forceinline__ float row_sumsq_f32(const float* row, int lane, f32x4 (&v)[4]) {
    const f32x4* xr = (const f32x4*)row + lane; float s = 0.f;
#pragma unroll
    for (int j = 0; j < 4; ++j) { v[j] = xr[64 * j]; s += (v[j][0] * v[j][0] + v[j][1] * v[j][1]) + (v[j][2] * v[j][2] + v[j][3] * v[j][3]); }
    return wave_sum(s);
}

__device__ __forceinline__ void phase_prologue(Frame& F, const Args& args) {
    LAS float* scr = (LAS float*)(F.lds + RING_OFF + F.wave * 16384);
    const int gw = F.vcu * 8 + F.wave, NGW = F.G * 8, lane = F.lane;
    unsigned char* ws = F.ws;
    const float* nmix = args.in[I_NORM_MIX]; const float* nxat = args.in[I_NORM_XATTN]; const float* nmem = args.in[I_NORM_MEM]; const float* nmoe = args.in[I_NORM_MOE];
    constexpr int J0 = 128, J1 = 1024, J2 = 256, J3 = 512, J4 = 2048, J5 = 1024, J6 = 16384, J7 = 8192;
    constexpr int NITEMS = J0 + J1 + J2 + J3 + J4 + J5 + J6 + J7;
    for (int it = gw; it < NITEMS; it += NGW) {
        int r = it;
        if (r < J0) { const int g = r / 32, q = r % 32; tr_job(q, args.in[I_POOL_W] + (size_t)g * 65536, 256, 256, 256, 0, 0, nullptr, (bf16*)(ws + WS_W_POOL) + (size_t)g * 65536, scr, lane); continue; } r -= J0;
        if (r < J1) { tr_job(r, args.in[I_RG_W_IN], 1024, 2048, 2048, 0, 0, nmix + 1024, (bf16*)(ws + WS_W_IN), scr, lane); continue; } r -= J1;
        if (r < J2) { const int h = r / 64, q = r % 64; tr_job(q, args.in[I_RG_W_GATE] + (size_t)h * 131072, 256, 512, 512, 1, 256, nullptr, (bf16*)(ws + WS_W_GATE) + (size_t)h * 131072, scr, lane); continue; } r -= J2;
        if (r < J3) { tr_job(r, args.in[I_RG_W_OUT], 1024, 1024, 1024, 0, 0, nullptr, (bf16*)(ws + WS_W_OUT), scr, lane); continue; } r -= J3;
        if (r < J4) { const int l = r / 1024, q = r % 1024; tr_job(q, args.in[I_XA_WKV] + (size_t)l * 2097152, 1024, 2048, 2048, 0, 0, nullptr, (bf16*)(ws + WS_W_KV) + (size_t)l * 2097152, scr, lane); continue; } r -= J4;
        if (r < J5) { const int l = r / 512, q = r % 512; tr_job(q, args.in[I_XA_WO] + (size_t)l * 1048576, 1024, 1024, 1024, 0, 0, nullptr, (bf16*)(ws + WS_W_OT) + (size_t)l * 1048576, scr, lane); continue; } r -= J5;
        if (r < J6) { const int le = r / 512, q = r % 512; tr_job(q, args.in[I_MOE_W_GU] + (size_t)le * 1048576, 1024, 1024, 1024, 1, 512, nmoe + (le >> 4) * 1024, (bf16*)(ws + WS_W_GU) + (size_t)le * 1048576, scr, lane); continue; } r -= J6;
        { const int le = r / 256, q = r % 256; tr_job(q, args.in[I_MOE_W_DOWN] + (size_t)le * 524288, 512, 1024, 1024, 0, 0, nullptr, (bf16*)(ws + WS_W_DOWN) + (size_t)le * 524288, scr, lane); }
    }
    constexpr int R_WQ = 2048, R_MEMN = 2 * NMR, R_WRB = 2 * 128, R_SPL = 1;
    constexpr int NROWS = R_WQ + R_MEMN + R_WRB + R_SPL;
    for (int it = gw; it < NROWS; it += NGW) {
        int r = it;
        if (r < R_WQ) {
            const int l = r >> 10, d = r & 1023; const float gsc = nxat[l * 1024 + d] * (LOG2E / 16.0f);
            const f32x4* src = (const f32x4*)(args.in[I_XA_WQ] + (size_t)r * 1024) + lane; u32x2* dst = (u32x2*)((bf16*)(ws + WS_W_Q) + (size_t)r * 1024) + lane;
#pragma unroll
            for (int j = 0; j < 4; ++j) { const f32x4 v = src[64 * j] * gsc; dst[64 * j] = (u32x2){pk2(v[0], v[1]), pk2(v[2], v[3])}; }
            continue; } r -= R_WQ;
        if (r < R_MEMN) {
            const int l = r / NMR, row = r % NMR; f32x4 v[4]; const float ss = row_sumsq_f32(args.in[I_MEM] + (size_t)row * 1024, lane, v);
            const float rs = __builtin_amdgcn_rsqf(ss * (1.0f / 1024.0f) + EPS);
            const f32x4* gp = (const f32x4*)(nmem + l * 1024) + lane; u32x2* dst = (u32x2*)((bf16*)(ws + WS_MEMN) + (size_t)r * 1024) + lane;
#pragma unroll
            for (int j = 0; j < 4; ++j) { const f32x4 o = v[j] * gp[64 * j] * rs; dst[64 * j] = (u32x2){pk2(o[0], o[1]), pk2(o[2], o[3])}; }
            continue; } r -= R_MEMN;
        if (r < R_WRB) {
            const int l = r >> 7, blk = r & 127;
            bf16* dst = (bf16*)(ws + WS_WRB) + (size_t)l * 65536 + blk * 512;
#pragma unroll
            for (int e8 = 0; e8 < 8; ++e8) { const int idx = blk * 512 + e8 * 64 + lane; const int jj = idx & 7, ln = (idx >> 3) & 63, ks = (idx >> 9) & 31, tl = idx >> 14;
                const int col = (tl & 1) * 16 + (ln & 15), d = 32 * ks + 8 * (ln >> 4) + jj;
                float w = 0.f;
                if (col < 4) w = args.in[I_MOE_WG][(size_t)l * 4096 + d * 4 + col];
                else if (col < 20) w = args.in[I_MOE_WE][(((size_t)l * 4 + ((col - 4) >> 2)) * 1024 + d) * 4 + ((col - 4) & 3)];
                w *= nmoe[l * 1024 + d];
                const unsigned hi = f2bf(w); const float lo = w - __builtin_bit_cast(float, hi << 16);
                dst[e8 * 64 + lane] = (bf16)((tl < 2) ? hi : f2bf(lo)); }
            continue; } r -= R_WRB;
        {
#pragma unroll
            for (int j = 0; j < 16; ++j) { const int c = j * 64 + lane; const float lam = args.in[I_RG_LAMBDA][c]; const float z = -lam;
                ((float*)(ws + WS_SPL))[c] = (z > 20.f) ? z : log1pf(expf(z)); }
        }
    }
}

template <int W> __device__ __forceinline__ void pool_step(f32x4 (&hist)[W], f32x4& sum, const f32x4 cur, const int i, const int cnt_s, const f32x4 gm, u32x2* dst) {
    sum += cur; const int cnt = cnt_s < W ? cnt_s : W; const f32x4 p = (sum * (1.0f / (float)cnt) - cur) * gm; *dst = (u32x2){pk2(p[0], p[1]), pk2(p[2], p[3])};
    hist[i % W] = cur; sum -= hist[(i + 1) % W];
}
constexpr int PBR = 2;
__device__ __forceinline__ void pool_loadn(const float* __restrict__ xb, int s, int nrow, f32x4 (&v)[PBR][4]) {
#pragma unroll
    for (int r = 0; r < PBR; ++r) if (r < nrow) {
        if (s + r >= 0) {
#pragma unroll
            for (int g = 0; g < 4; ++g) v[r][g] = *(const f32x4*)(xb + (size_t)(s + r) * D + g * 256);
        } else {
#pragma unroll
            for (int g = 0; g < 4; ++g) v[r][g] = (f32x4){0.f, 0.f, 0.f, 0.f};
        } }
#pragma unroll
    for (int r = 0; r < PBR; ++r) if (r < nrow) { float ss = 0.f;
#pragma unroll
        for (int g = 0; g < 4; ++g) ss += (v[r][g][0] * v[r][g][0] + v[r][g][1] * v[r][g][1]) + (v[r][g][2] * v[r][g][2] + v[r][g][3] * v[r][g][3]);
        const float rs = __builtin_amdgcn_rsqf(wave_sum(ss) * (1.0f / 1024.0f) + EPS);
#pragma unroll
        for (int g = 0; g < 4; ++g) v[r][g] *= rs; }
}
__device__ __forceinline__ void pool_run(const float* __restrict__ xb, bf16* __restrict__ prow, const int s0, const f32x4 (&gm)[4], const int lane) {
    f32x4 h0[2], h1[4], h2[8], h3[16], sum[4];
#pragma unroll
    for (int g = 0; g < 4; ++g) sum[g] = (f32x4){0.f, 0.f, 0.f, 0.f};
#pragma unroll
    for (int jb = 15; jb >= 1; jb -= PBR) { const int nrow = jb >= PBR ? PBR : jb; f32x4 v[PBR][4]; pool_loadn(xb, s0 - jb, nrow, v);
#pragma unroll
        for (int r = 0; r < PBR; ++r) if (r < nrow) { const int j = jb - r;
            if (j < 2) { h0[(16 - j) % 2] = v[r][0]; sum[0] += v[r][0]; }
            if (j < 4) { h1[(16 - j) % 4] = v[r][1]; sum[1] += v[r][1]; }
            if (j < 8) { h2[(16 - j) % 8] = v[r][2]; sum[2] += v[r][2]; }
            { h3[(16 - j) % 16] = v[r][3]; sum[3] += v[r][3]; } } }
#pragma unroll
    for (int ib = 0; ib < 16; ib += PBR) { f32x4 v[PBR][4]; pool_loadn(xb, s0 + ib, PBR, v);
#pragma unroll
        for (int r = 0; r < PBR; ++r) { const int i = ib + r, s = s0 + i; u32x2* dst = (u32x2*)(prow + (size_t)i * D) + lane;
            pool_step<2>(h0, sum[0], v[r][0], i, s + 1, gm[0], dst);
            pool_step<4>(h1, sum[1], v[r][1], i, s + 1, gm[1], dst + 64);
            pool_step<8>(h2, sum[2], v[r][2], i, s + 1, gm[2], dst + 128);
            pool_step<16>(h3, sum[3], v[r][3], i, s + 1, gm[3], dst + 192); } }
}
__device__ __forceinline__ void phase_pool_p(Frame& F, const Args& args) {
    const int gw = F.vcu * 8 + F.wave, NGW = F.G * 8, lane = F.lane;
    bf16* P0 = (bf16*)(F.ob + OB_P0);
    f32x4 gm[4];
#pragma unroll
    for (int g = 0; g < 4; ++g) gm[g] = *(const f32x4*)(args.in[I_NORM_MIX] + g * 256 + 4 * lane);
    for (int it = gw; it < NB * (SEQ / 16); it += NGW) {
        const int b = it >> 7, s0 = (it & 127) * 16;
        pool_run(args.in[I_X] + (size_t)b * SEQ * D + 4 * lane, P0 + ((size_t)b * SEQ + s0) * D, s0, gm, lane);
    }
}

struct SchedKV {
    int G, c; const char* A; const char* B; char* Kb; char* Vb;
    __device__ __forceinline__ bool next(int i, pg8::Unit& u) const { int pm, pn; if (!pg8::tile_of(i, G, c, 32, 8, pm, pn)) return false;
        const int l = pm >> 4; u.A = A + (size_t)pm * 256 * 2048; u.B = B + (size_t)l * 4194304 + (size_t)pn * 256 * 2048;
        u.C = ((pn < 4) ? Kb : Vb) + ((size_t)l * 4096 + (size_t)(pm & 15) * 256) * 2048 + (size_t)(pn & 3) * 512; u.row0 = pm * 256; u.col0 = pn * 256; u.aux = i; return true; }
};
struct SchedMVW {
    int G, c; const char* Kl; const char* Vl; const char* Wq; const char* Wot; char* BS; char* BO;
    __device__ __forceinline__ bool next(int i, pg8::Unit& u) const { int pm, pn; if (!pg8::tile_of(i, G, c, 128, 4, pm, pn)) return false;
        const int kind = pm >> 6, bh = pm & 63, b = bh >> 2, h = bh & 3;
        if (kind == 0) { u.A = Kl + ((size_t)b * 256) * 2048 + h * 512; u.B = Wq + ((size_t)pn * 256) * 2048 + h * 512; u.C = BS + (size_t)b * 2097152 + ((size_t)h * 256) * 2048 + pn * 512; }
        else { u.A = Wot + ((size_t)pn * 256) * 2048 + h * 512; u.B = Vl + ((size_t)b * 256) * 2048 + h * 512; u.C = BO + (size_t)b * 2097152 + ((size_t)pn * 256) * 2048 + h * 512; }
        u.row0 = 0; u.col0 = 0; u.aux = i; return true; }
};
struct SchedDense {
    int G, c, nN; const char* A; size_t apan; size_t acol; int adiv; const char* B; size_t bpn; size_t bbatch; int cmul;
    __device__ __forceinline__ bool next(int i, pg8::Unit& u) const { int pm, pn; if (!pg8::tile_of(i, G, c, NTOK / 256, nN, pm, pn)) return false;
        u.A = A + (size_t)pm * apan + (size_t)(pn / adiv) * acol; u.B = B + (size_t)pn * bpn + (size_t)(pm >> 3) * bbatch; u.C = nullptr; u.row0 = pm * 256; u.col0 = pn * cmul; u.aux = i; return true; }
};
struct SchedMoE {
    int G, c, nT; int tpre[17]; const char* A; size_t atile; const char* B; size_t bexp, bpn;
    __device__ __forceinline__ int expert_of(int tile) const { int e = 0;
#pragma unroll
        for (int k = 1; k < 16; ++k) e += (tile >= tpre[k]) ? 1 : 0;
        return e; }
    __device__ __forceinline__ int first_tile(int e) const { int t = 0;
#pragma unroll
        for (int k = 1; k < 16; ++k) t = (k == e) ? tpre[k] : t;
        return t; }
    __device__ __forceinline__ bool next(int i, pg8::Unit& u) const { int tile, pn; if (!pg8::tile_of(i, G, c, nT, 4, tile, pn)) return false;
        const int e = expert_of(tile);
        u.A = A + (size_t)tile * atile; u.B = B + (size_t)e * bexp + (size_t)pn * bpn; u.C = nullptr; u.row0 = tile * 256; u.col0 = pn * 256; u.aux = i; return true; }
};
__device__ __forceinline__ void moe_sched_init(SchedMoE& S, Frame& F, int l) {
    const unsigned* cnt = (const unsigned*)(F.ws + WS_CTL) + CW_CNT + l * 16 * 64;
    unsigned n[16];
#pragma unroll
    for (int e = 0; e < 16; ++e) n[e] = __hip_atomic_load(cnt + e * 64, __ATOMIC_RELAXED, __HIP_MEMORY_SCOPE_AGENT);
    int acc = 0;
#pragma unroll
    for (int e = 0; e < 16; ++e) { S.tpre[e] = acc; acc += ((int)__builtin_amdgcn_readfirstlane(n[e]) + 255) >> 8; }
    S.tpre[16] = acc; S.nT = acc; S.G = F.G; S.c = (int)blockIdx.x;
}
__device__ __forceinline__ void moe_fill_tables(const SchedMoE& S, Frame& F, int l, int mode) {
    const int* list = (const int*)(F.ws + WS_LIST); const float* rstd = (const float*)(F.ws + WS_RSTD_B); const float* gwv = (const float*)(F.ws + WS_GW);
    LAS int* tab = (LAS int*)(F.lds + TAB_OFF); LAS float* tab2 = (LAS float*)(F.lds + TAB2_OFF);
    const unsigned* cntp = (const unsigned*)(F.ws + WS_CTL) + CW_CNT + l * 16 * 64;
    if (F.tid < 256) {
        unsigned n[16];
#pragma unroll
        for (int e = 0; e < 16; ++e) n[e] = __hip_atomic_load(cntp + e * 64, __ATOMIC_RELAXED, __HIP_MEMORY_SCOPE_AGENT);
        int slot[MAXU]; bool valid[MAXU]; bool have[MAXU]; float aux[MAXU];
#pragma unroll
        for (int j = 0; j < MAXU; ++j) { pg8::Unit u; have[j] = S.next(j, u); slot[j] = 0; valid[j] = false;
            if (have[j]) { const int tile = u.row0 >> 8, e = S.expert_of(tile), tl = tile - S.first_tile(e), pos = tl * 256 + F.tid; int ne = (int)n[0];
#pragma unroll
                for (int k = 1; k < 16; ++k) ne = (k == e) ? (int)n[k] : ne;
                valid[j] = pos < ne;
                slot[j] = list[(size_t)e * NTOK + (valid[j] ? pos : 0)]; } }
#pragma unroll
        for (int j = 0; j < MAXU; ++j) { aux[j] = 0.f; if (have[j]) aux[j] = (mode == 0) ? rstd[slot[j] >> 1] : gwv[slot[j]]; }
#pragma unroll
        for (int j = 0; j < MAXU; ++j) if (have[j]) { tab[j * 256 + F.tid] = (mode == 0) ? (slot[j] >> 1) : (valid[j] ? slot[j] : -1); tab2[j * 256 + F.tid] = aux[j]; }
    }
    __syncthreads();
}

__device__ __forceinline__ void phase_router(Frame& F, const Args& args, int l, const bf16* H) {
    { const u32x4* src = (const u32x4*)(F.ws + WS_WRB + (size_t)l * 131072); LAS u32x4* dst = (LAS u32x4*)(F.lds + RING_OFF);
      u32x4 t[16];
#pragma unroll
      for (int i = 0; i < 16; ++i) t[i] = src[F.tid + 512 * i];
#pragma unroll
      for (int i = 0; i < 16; ++i) dst[F.tid + 512 * i] = t[i]; }
    __syncthreads();
    LAS float* lgs = (LAS float*)(F.lds + TAB_OFF) + F.wave * 336;
    LAS int* sel_e = (LAS int*)(F.lds + XCH_OFF); LAS float* sel_w = (LAS float*)(F.lds + XCH_OFF + 1024);
    LAS int* lcnt = (LAS int*)(F.lds + XCH_OFF + 2048); LAS int* lbase = lcnt + 16; LAS int* rnk = (LAS int*)(F.lds + XCH_OFF + 3072);
    unsigned* gcnt = (unsigned*)(F.ws + WS_CTL) + CW_CNT + l * 16 * 64;
    int* list = (int*)(F.ws + WS_LIST); float* gwv = (float*)(F.ws + WS_GW); float* rstd = (float*)(F.ws + WS_RSTD_B);
    const float* bg = args.in[I_MOE_BG] + l * 4; const float* be = args.in[I_MOE_BE] + l * 16;
    const int lane = F.lane, fr = lane & 15, fq = lane >> 4;
    for (int tb = F.vcu; tb < NTOK / 128; tb += F.G) {
        const int t0 = tb * 128 + F.wave * 16;
        const bf16* hp = H + (size_t)(t0 + fr) * 1024 + 8 * fq;
        f32x4 acc0 = {0.f, 0.f, 0.f, 0.f}, acc1 = {0.f, 0.f, 0.f, 0.f}; float ssq = 0.f;
        if (F.tid < 16) lcnt[F.tid] = 0;
#pragma unroll 16
        for (int ks = 0; ks < 32; ++ks) {
            const u32x4 av = *(const u32x4*)(hp + ks * 32);
            f32x4 x0, x1; unpack8(av, x0, x1); ssq += (x0[0] * x0[0] + x0[1] * x0[1]) + (x0[2] * x0[2] + x0[3] * x0[3]) + (x1[0] * x1[0] + x1[1] * x1[1]) + (x1[2] * x1[2] + x1[3] * x1[3]);
            const bf16x8 a = __builtin_bit_cast(bf16x8, av);
            const LAS bf16x8* bp = (const LAS bf16x8*)(F.lds + RING_OFF) + ks * 64 + lane;
            const bf16x8 b0 = bp[0], b1 = bp[2048], b2 = bp[4096], b3 = bp[6144];
            acc0 = __builtin_amdgcn_mfma_f32_16x16x32_bf16(a, b0, acc0, 0, 0, 0); acc0 = __builtin_amdgcn_mfma_f32_16x16x32_bf16(a, b2, acc0, 0, 0, 0);
            acc1 = __builtin_amdgcn_mfma_f32_16x16x32_bf16(a, b1, acc1, 0, 0, 0); acc1 = __builtin_amdgcn_mfma_f32_16x16x32_bf16(a, b3, acc1, 0, 0, 0);
        }
        ssq += __shfl_xor(ssq, 16); ssq += __shfl_xor(ssq, 32);
#pragma unroll
        for (int rg = 0; rg < 4; ++rg) { lgs[(4 * fq + rg) * 21 + fr] = acc0[rg]; if (fr < 4) lgs[(4 * fq + rg) * 21 + 16 + fr] = acc1[rg]; }
        LDS_WAIT(); asm volatile("" ::: "memory");
        if (lane < 16) {
            const float rs = __builtin_amdgcn_rsqf(ssq * (1.0f / 1024.0f) + EPS);
            const LAS float* lg = lgs + lane * 21;
            float g0 = lg[0] * rs + bg[0], g1 = lg[1] * rs + bg[1], g2 = lg[2] * rs + bg[2], g3 = lg[3] * rs + bg[3];
            int g = 0; float gm = g0; if (g1 > gm) { gm = g1; g = 1; } if (g2 > gm) { gm = g2; g = 2; } if (g3 > gm) { gm = g3; g = 3; }
            const float gp = 1.0f / (expf(g0 - gm) + expf(g1 - gm) + expf(g2 - gm) + expf(g3 - gm));
            float le[4];
#pragma unroll
            for (int k = 0; k < 4; ++k) le[k] = lg[4 + 4 * g + k] * rs + be[4 * g + k];
            int e1 = 0; float m1 = le[0];
#pragma unroll
            for (int k = 1; k < 4; ++k) if (le[k] > m1) { m1 = le[k]; e1 = k; }
            int e2 = -1; float m2 = -3.0e38f;
#pragma unroll
            for (int k = 0; k < 4; ++k) if (k != e1 && le[k] > m2) { m2 = le[k]; e2 = k; }
            const float z = expf(m2 - m1); const float q1 = 1.0f / (1.0f + z), q2 = z * q1;
            const int tl = F.wave * 16 + lane;
            sel_e[2 * tl] = 4 * g + e1; sel_e[2 * tl + 1] = 4 * g + e2; sel_w[2 * tl] = gp * q1; sel_w[2 * tl + 1] = gp * q2;
            rstd[t0 + lane] = rs;
        }
        __syncthreads();
        int my_e = 0;
        if (F.tid < 256) { my_e = sel_e[F.tid]; rnk[F.tid] = __hip_atomic_fetch_add(&lcnt[my_e], 1, __ATOMIC_RELAXED, __HIP_MEMORY_SCOPE_WORKGROUP); }
        __syncthreads();
        if (F.tid < 16) { const int n = lcnt[F.tid]; lbase[F.tid] = n ? (int)__hip_atomic_fetch_add(gcnt + F.tid * 64, (unsigned)n, __ATOMIC_RELAXED, __HIP_MEMORY_SCOPE_AGENT) : 0; }
        __syncthreads();
        if (F.tid < 256) { const int pos = lbase[my_e] + rnk[F.tid]; const int slot = tb * 256 + F.tid; list[(size_t)my_e * NTOK + pos] = slot; gwv[slot] = sel_w[F.tid]; }
        __syncthreads();
    }
}

__device__ __forceinline__ void phase_combine(Frame& F, const Args& args, int mode, const bf16* H, bf16* Hout, float* outf) {
    const int gw = F.vcu * 8 + F.wave, NGW = F.G * 8, lane = F.lane;
    const bf16* Y = (const bf16*)(F.ws + WS_Y); float* rstd = (float*)(F.ws + WS_RSTD_A);
    f32x4 gf[4];
    if (mode == 1) {
#pragma unroll
        for (int hf = 0; hf < 2; ++hf) { gf[2 * hf] = *(const f32x4*)(args.in[I_NORM_FINAL] + hf * 512 + 8 * lane); gf[2 * hf + 1] = *(const f32x4*)(args.in[I_NORM_FINAL] + hf * 512 + 8 * lane + 4); }
    }
    for (int t = gw; t < NTOK; t += NGW) {
        f32x4 v[4]; float ss = 0.f;
#pragma unroll
        for (int hf = 0; hf < 2; ++hf) { const size_t off = hf * 512 + 8 * lane;
            const u32x4 hv = *(const u32x4*)(H + (size_t)t * 1024 + off), y0 = *(const u32x4*)(Y + (size_t)(2 * t) * 1024 + off), y1 = *(const u32x4*)(Y + (size_t)(2 * t + 1) * 1024 + off);
            f32x4 a, b, c, d, e, f; unpack8(hv, a, b); unpack8(y0, c, d); unpack8(y1, e, f); a += c + e; b += d + f; v[2 * hf] = a; v[2 * hf + 1] = b;
            ss += (a[0] * a[0] + a[1] * a[1]) + (a[2] * a[2] + a[3] * a[3]) + (b[0] * b[0] + b[1] * b[1]) + (b[2] * b[2] + b[3] * b[3]); }
        ss = wave_sum(ss);
        const float rs = __builtin_amdgcn_rsqf(ss * (1.0f / 1024.0f) + EPS);
        if (mode == 0) {
#pragma unroll
            for (int hf = 0; hf < 2; ++hf) *(u32x4*)(Hout + (size_t)t * 1024 + hf * 512 + 8 * lane) = pack8(v[2 * hf], v[2 * hf + 1]);
            if (lane == 0) rstd[t] = rs;
        } else {
#pragma unroll
            for (int hf = 0; hf < 2; ++hf) { float* op = outf + (size_t)t * 1024 + hf * 512 + 8 * lane; *(f32x4*)op = v[2 * hf] * gf[2 * hf] * rs; *(f32x4*)(op + 4) = v[2 * hf + 1] * gf[2 * hf + 1] * rs; }
        }
    }
}

__device__ __forceinline__ void phase_conv(Frame& F, const Args& args, const bf16* XB, bf16* XC) {
    const int gw = F.vcu * 8 + F.wave, NGW = F.G * 8, lane = F.lane;
    const float* cw = args.in[I_RG_CONV_W]; const float* cbv = args.in[I_RG_CONV_B];
    for (int hf = 0; hf < 2; ++hf) {
        const int c0 = hf * 512 + 8 * lane;
        f32x4 w[4][2], cb[2];
#pragma unroll
        for (int k = 0; k < 4; ++k) { w[k][0] = *(const f32x4*)(cw + k * 1024 + c0); w[k][1] = *(const f32x4*)(cw + k * 1024 + c0 + 4); }
        cb[0] = *(const f32x4*)(cbv + c0); cb[1] = *(const f32x4*)(cbv + c0 + 4);
        for (int it = gw; it < NB * (SEQ / 16); it += NGW) {
            const int b = it >> 7, s0 = (it & 127) * 16; const bf16* xp = XB + (size_t)b * SEQ * D + c0; bf16* op = XC + (size_t)b * SEQ * D + c0;
            f32x4 xm[3][2];
#pragma unroll
            for (int j = 0; j < 3; ++j) { const int s = s0 - 3 + j; if (s >= 0) { const u32x4 v = *(const u32x4*)(xp + (size_t)s * D); unpack8(v, xm[j][0], xm[j][1]); } else { xm[j][0] = (f32x4){0.f, 0.f, 0.f, 0.f}; xm[j][1] = xm[j][0]; } }
#pragma unroll 4
            for (int s = s0; s < s0 + 16; ++s) { const u32x4 v = *(const u32x4*)(xp + (size_t)s * D); f32x4 x0, x1; unpack8(v, x0, x1);
                const f32x4 o0 = cb[0] + w[0][0] * xm[0][0] + w[1][0] * xm[1][0] + w[2][0] * xm[2][0] + w[3][0] * x0;
                const f32x4 o1 = cb[1] + w[0][1] * xm[0][1] + w[1][1] * xm[1][1] + w[2][1] * xm[2][1] + w[3][1] * x1;
                *(u32x4*)(op + (size_t)s * D) = pack8(o0, o1);
                xm[0][0] = xm[1][0]; xm[0][1] = xm[1][1]; xm[1][0] = xm[2][0]; xm[1][1] = xm[2][1]; xm[2][0] = x0; xm[2][1] = x1; }
        }
    }
}

constexpr int NSEG = 16, SEGL = SEQ / NSEG;
__device__ __forceinline__ void phase_scan1(Frame& F) {
    const int gw = F.vcu * 8 + F.wave, NGW = F.G * 8, lane = F.lane;
    const bf16* LA = (const bf16*)(F.ob + OB_LOGA); const bf16* BT = (const bf16*)(F.ob + OB_BT);
    float* AGS = (float*)(F.ws + WS_AGS); float* AGB = (float*)(F.ws + WS_AGB);
    for (int it = gw; it < NB * NSEG * 8; it += NGW) {
        const int cg = it & 7, sg = (it >> 3) & (NSEG - 1), b = it >> 7; const int ch = cg * 128 + 2 * lane;
        const size_t r0 = ((size_t)b * SEQ + sg * SEGL) * D + ch;
        float h0 = 0.f, h1 = 0.f, s0 = 0.f, s1 = 0.f;
#pragma unroll 16
        for (int s = 0; s < SEGL; ++s) { const unsigned lv = *(const unsigned*)(LA + r0 + (size_t)s * D), bv = *(const unsigned*)(BT + r0 + (size_t)s * D);
            const float l0 = bflo(lv), l1 = bfhi(lv); s0 += l0; s1 += l1;
            h0 = fast_exp2(l0 * LOG2E) * h0 + bflo(bv); h1 = fast_exp2(l1 * LOG2E) * h1 + bfhi(bv); }
        const size_t ao = ((size_t)b * NSEG + sg) * 1024 + ch;
        *(f32x2*)(AGS + ao) = (f32x2){s0, s1}; *(f32x2*)(AGB + ao) = (f32x2){h0, h1};
    }
}
__device__ __forceinline__ void scan2_item(const bf16* __restrict__ LA, const bf16* __restrict__ BT, const bf16* __restrict__ GATE, bf16* __restrict__ YRG, const float* __restrict__ AGS, const float* __restrict__ AGB, int it, int lane) {
    const int cg = it & 7, sg = (it >> 3) & (NSEG - 1), b = it >> 7; const int ch = cg * 128 + 2 * lane;
    f32x2 as[NSEG - 1], ab[NSEG - 1];
#pragma unroll
    for (int c = 0; c < NSEG - 1; ++c) { const size_t ao = ((size_t)b * NSEG + c) * 1024 + ch; as[c] = *(const f32x2*)(AGS + ao); ab[c] = *(const f32x2*)(AGB + ao); }
    float h0 = 0.f, h1 = 0.f;
#pragma unroll
    for (int c = 0; c < NSEG - 1; ++c) if (c < sg) { h0 = fast_exp2(as[c].x * LOG2E) * h0 + ab[c].x; h1 = fast_exp2(as[c].y * LOG2E) * h1 + ab[c].y; }
    const size_t r0 = ((size_t)b * SEQ + sg * SEGL) * D + ch;
#pragma nounroll
    for (int sb = 0; sb < SEGL; sb += 16) {
        unsigned lv[16], bv[16], gv[16];
#pragma unroll
        for (int k = 0; k < 16; ++k) { const size_t o = r0 + (size_t)(sb + k) * D; lv[k] = *(const unsigned*)(LA + o); bv[k] = *(const unsigned*)(BT + o); gv[k] = *(const unsigned*)(GATE + o); }
#pragma unroll
        for (int k = 0; k < 16; ++k) { h0 = fast_exp2(bflo(lv[k]) * LOG2E) * h0 + bflo(bv[k]); h1 = fast_exp2(bfhi(lv[k]) * LOG2E) * h1 + bfhi(bv[k]);
            *(unsigned*)(YRG + r0 + (size_t)(sb + k) * D) = cvt_pk_bf16(h0 * bflo(gv[k]), h1 * bfhi(gv[k])); }
    }
}
__device__ __forceinline__ void phase_scan2(Frame& F, const bf16* GATE, bf16* YRG) {
    const int gw = F.vcu * 8 + F.wave, NGW = F.G * 8;
    for (int it = gw; it < NB * NSEG * 8; it += NGW)
        scan2_item((const bf16*)(F.ob + OB_LOGA), (const bf16*)(F.ob + OB_BT), GATE, YRG, (const float*)(F.ws + WS_AGS), (const float*)(F.ws + WS_AGB), it, F.lane);
}

#if MK_PER_PHASE
#define GRID_BAR() do { } while (0)
#else
#define GRID_BAR() xcd_barrier(bar)
#endif
#ifndef MK_MASK
#define MK_MASK 0x1fffffu
#endif
#define IN(k) ((((MK_MASK) >> (k)) & 1u) && lo <= (k) && (k) < hi)
#define SEAM(k) do { if (lo <= (k) + 1 && (k) + 1 < hi) GRID_BAR(); } while (0)
#ifndef MK_DUP
#define MK_DUP 0u
#endif

template <int L>
__device__ __forceinline__ void mvw_gemm(Frame& F) {
    unsigned char* ws = F.ws;
    SchedMVW S{F.G, (int)blockIdx.x, (const char*)(ws + WS_K) + (size_t)L * 8388608, (const char*)(ws + WS_V) + (size_t)L * 8388608,
               (const char*)(ws + WS_W_Q) + (size_t)L * 2097152, (const char*)(ws + WS_W_OT) + (size_t)L * 2097152, (char*)(ws + WS_BS), (char*)(ws + WS_BO)};
    pg8::EpiPlain E{1024};
    pg8::gemm_phase<pg8::EpiPlain, SchedMVW, false>(F.lds + RING_OFF, 256, 2048u, 2048u, S, E, (LAS int*)(F.lds + TAB_OFF));
}
template <int L>
__device__ __forceinline__ void layer_phases(Frame& F, const Args& args, const XcdBarrier& bar, const int lo, const int hi) {
    unsigned char* ws = F.ws;
    LAS int* tab = (LAS int*)(F.lds + TAB_OFF); LAS float* tab2 = (LAS float*)(F.lds + TAB2_OFF);
    float* ss16 = (float*)(ws + WS_SS16);
    constexpr int ps = (L == 0) ? 3 : 15;
    if constexpr (L == 0) {
        if (IN(2)) {
            mvw_gemm<0>(F);
            SchedDense S{F.G, (int)blockIdx.x, 4, (const char*)(F.ob + OB_P0), (size_t)256 * 2048, (size_t)512, 1, (const char*)(ws + WS_W_POOL), (size_t)131072, 0, 256};
            pg8::EpiPool E{args.in[I_X], args.in[I_POOL_SCALE], (bf16*)(ws + WS_HA), ss16};
            pg8::gemm_phase<pg8::EpiPool, SchedDense, false>(F.lds + RING_OFF, 256, 2048u, 512u, S, E, tab);
            SEAM(2);
        }
    } else {
        const bf16* h3 = (const bf16*)(ws + WS_HA);
        bf16* XB = (bf16*)(ws + WS_HB); bf16* GATE = (bf16*)(ws + WS_Y); bf16* XC = (bf16*)(ws + WS_Y + 64 * MiB); bf16* YRG = (bf16*)(ws + WS_HB); bf16* HC = (bf16*)(ws + WS_Y);
        if (IN(9)) {
            SchedDense S{F.G, (int)blockIdx.x, 8, (const char*)h3, (size_t)256 * 2048, 0, 1, (const char*)(ws + WS_W_IN), (size_t)256 * 2048, 0, 256};
            pg8::EpiIn E{XB, GATE, (const float*)(ws + WS_RSTD_A)};
            pg8::gemm_phase<pg8::EpiIn, SchedDense, false>(F.lds + RING_OFF, 1024, 2048u, 2048u, S, E, tab);
            SEAM(9);
        }
        if (IN(10)) { phase_conv(F, args, XB, XC); SEAM(10); }
        if (IN(11)) {
            SchedDense S{F.G, (int)blockIdx.x, 8, (const char*)XC, (size_t)256 * 2048, (size_t)512, 2, (const char*)(ws + WS_W_GATE), (size_t)131072, 0, 128};
            pg8::EpiGates E{XC, (bf16*)(F.ob + OB_LOGA), (bf16*)(F.ob + OB_BT), args.in[I_RG_B_GATE], (const float*)(ws + WS_SPL)};
            pg8::gemm_phase<pg8::EpiGates, SchedDense, false>(F.lds + RING_OFF, 256, 2048u, 512u, S, E, tab);
            SEAM(11);
        }
        if (IN(12)) { phase_scan1(F); SEAM(12); }
        if (IN(13)) { phase_scan2(F, GATE, YRG); SEAM(13); }
        if (IN(14)) {
            SchedDense S{F.G, (int)blockIdx.x, 4, (const char*)YRG, (size_t)256 * 2048, 0, 1, (const char*)(ws + WS_W_OUT), (size_t)256 * 2048, 0, 256};
            pg8::EpiRes E{h3, HC, ss16};
            pg8::gemm_phase<pg8::EpiRes, SchedDense, false>(F.lds + RING_OFF, 1024, 2048u, 2048u, S, E, tab);
            SEAM(14);
        }
    }
    const bf16* hmix = (L == 0) ? (const bf16*)(ws + WS_HA) : (const bf16*)(ws + WS_Y);
    bf16* hatt = (L == 0) ? (bf16*)(ws + WS_HB) : (bf16*)(ws + WS_HA);
    bf16* PATT = (bf16*)(F.ob + OB_PATT);
    if (IN(ps)) {
        SchedDense S{F.G, (int)blockIdx.x, 4, (const char*)hmix, (size_t)256 * 2048, 0, 1, (const char*)(ws + WS_BS), (size_t)256 * 2048, (size_t)2097152, 256};
        pg8::EpiS E{PATT, ss16, (LAS f32x2*)(F.lds + XCH_OFF)};
        pg8::gemm_phase<pg8::EpiS, SchedDense, false>(F.lds + RING_OFF, 1024, 2048u, 2048u, S, E, tab);
        SEAM(ps);
    }
    if (IN(ps + 1)) {
        SchedDense S{F.G, (int)blockIdx.x, 4, (const char*)PATT, (size_t)256 * 2048, 0, 1, (const char*)(ws + WS_BO), (size_t)256 * 2048, (size_t)2097152, 256};
        pg8::EpiRes E{hmix, hatt, ss16};
        pg8::gemm_phase<pg8::EpiRes, SchedDense, false>(F.lds + RING_OFF, 1024, 2048u, 2048u, S, E, tab);
        SEAM(ps + 1);
    }
    if (IN(ps + 2)) {
        phase_router(F, args, L, hatt);
        if constexpr (L == 0) { __syncthreads(); mvw_gemm<1>(F); }
        SEAM(ps + 2);
    }
    if (IN(ps + 3)) {
        SchedMoE S; moe_sched_init(S, F, L); S.A = (const char*)hatt; S.atile = 0; S.B = (const char*)(ws + WS_W_GU) + (size_t)L * 33554432; S.bexp = 2097152; S.bpn = (size_t)256 * 2048;
        moe_fill_tables(S, F, L, 0);
        pg8::EpiGU E{(bf16*)(F.ob + OB_HMID), tab2};
        pg8::gemm_phase<pg8::EpiGU, SchedMoE, true>(F.lds + RING_OFF, 1024, 2048u, 2048u, S, E, tab);
        SEAM(ps + 3);
    }
    if (IN(ps + 4)) {
        SchedMoE S; moe_sched_init(S, F, L); S.A = (const char*)(F.ob + OB_HMID); S.atile = (size_t)256 * 1024; S.B = (const char*)(ws + WS_W_DOWN) + (size_t)L * 16777216; S.bexp = 1048576; S.bpn = (size_t)256 * 1024;
        moe_fill_tables(S, F, L, 1);
        pg8::EpiDown E{(bf16*)(ws + WS_Y), tab, tab2};
        pg8::gemm_phase<pg8::EpiDown, SchedMoE, false>(F.lds + RING_OFF, 512, 1024u, 1024u, S, E, tab);
        SEAM(ps + 4);
    }
    if (IN(ps + 5)) {
        if constexpr (L == 0) { phase_combine(F, args, 0, hatt, (bf16*)(ws + WS_HA), nullptr); SEAM(ps + 5); }
        else phase_combine(F, args, 1, hatt, nullptr, args.out);
    }
}

__global__ void __launch_bounds__(512, 2) hybrid_fwd(Args args) {
    extern __shared__ __attribute__((aligned(16))) unsigned char lds[];
    Frame F;
    F.lds = (LAS unsigned char*)lds;
    F.tid = threadIdx.x; F.lane = F.tid & 63; F.wave = __builtin_amdgcn_readfirstlane(F.tid >> 6);
    F.G = gridDim.x; { const int bx = blockIdx.x; F.vcu = (F.G % 8 == 0) ? (bx % 8) * (F.G / 8) + bx / 8 : bx; }
    F.ws = args.ws; F.ob = (unsigned char*)args.out;
    volatile LAS unsigned* MISC = (volatile LAS unsigned*)(F.lds + MISC_OFF);
    for (int u = F.tid; u < (LDS_BYTES - MISC_OFF) / 4; u += 512) ((LAS unsigned*)(F.lds + MISC_OFF))[u] = 0u;
    __syncthreads();
    unsigned* ctl = (unsigned*)(F.ws + WS_CTL);
#if MK_PER_PHASE
    XcdBarrier bar; bar.bar = ctl + CW_BAR; bar.x = 0; bar.st = nullptr;
#else
    XcdBarrier bar = xcd_barrier_post(ctl + CW_BAR, MISC + 8);
#endif
    const int lo = args.ph_lo, hi = args.ph_hi;
    unsigned char* ws = F.ws;
    LAS int* tab = (LAS int*)(F.lds + TAB_OFF);

    if (IN(0)) { phase_prologue(F, args); SEAM(0); }
    if (IN(1)) {
        phase_pool_p(F, args);
        __syncthreads();
        SchedKV S{F.G, (int)blockIdx.x, (const char*)(ws + WS_MEMN), (const char*)(ws + WS_W_KV), (char*)(ws + WS_K), (char*)(ws + WS_V)};
        pg8::EpiPlain E{1024};
        pg8::gemm_phase<pg8::EpiPlain, SchedKV, false>(F.lds + RING_OFF, 1024, 2048u, 2048u, S, E, tab);
        SEAM(1);
    }
    layer_phases<0>(F, args, bar, lo, hi);
    layer_phases<1>(F, args, bar, lo, hi);
}
#undef IN
#undef SEAM

extern "C" void kernel_launch(void* const* d_in, const int* in_sizes, int n_in, void* d_out, int out_size, void* d_ws, size_t ws_size, hipStream_t stream) {
    static int grid = 0;
    if (grid == 0) {
        if (n_in != 25 || out_size != NTOK * D || ws_size < WS_END) { fprintf(stderr, "kernel_launch: unexpected shapes (n_in %d, out %d, ws %zu)\n", n_in, out_size, ws_size); grid = -1; return; }
        int dev = 0, cus = 0, per_cu = 0;
        if (hipGetDevice(&dev) != hipSuccess || hipDeviceGetAttribute(&cus, hipDeviceAttributeMultiprocessorCount, dev) != hipSuccess) { grid = -1; return; }
        if (hipFuncSetAttribute((const void*)hybrid_fwd, hipFuncAttributeMaxDynamicSharedMemorySize, LDS_BYTES) != hipSuccess) { fprintf(stderr, "kernel_launch: hipFuncSetAttribute failed\n"); grid = -1; return; }
        if (hipOccupancyMaxActiveBlocksPerMultiprocessor(&per_cu, (const void*)hybrid_fwd, 512, LDS_BYTES) != hipSuccess || per_cu < 1) fprintf(stderr, "kernel_launch: occupancy query reports %d\n", per_cu);
        (void)hipGetLastError();
        grid = cus;
    }
    if (grid < 0) return;
    (void)hipMemsetAsync((char*)d_ws + WS_CTL, 0, CTL_ZERO_BYTES, stream);
    Args a{};
    for (int i = 0; i < 25; ++i) a.in[i] = (const float*)d_in[i];
    a.out = (float*)d_out; a.ws = (unsigned char*)d_ws; a.dup = 0; a.pad = 0;
#if MK_PER_PHASE
    for (int p = 0; p < NPH; ++p) for (int r = 0; r < ((((MK_DUP) >> p) & 1u) ? 2 : 1); ++r) {
        if (r == 1 && (p == 5 || p == 17)) (void)hipMemsetAsync((char*)d_ws + WS_CTL + (size_t)(CW_CNT + (p == 17 ? 1 : 0) * 16 * 64) * 4, 0, 16 * 64 * 4, stream);
        a.ph_lo = p; a.ph_hi = p + 1; hipLaunchKernelGGL(hybrid_fwd, dim3(grid), dim3(512), LDS_BYTES, stream, a); }
#else
    a.ph_lo = 0; a.ph_hi = NPH; hipLaunchKernelGGL(hybrid_fwd, dim3(grid), dim3(512), LDS_BYTES, stream, a);
#endif
}
```

```cpp
#include <hip/hip_runtime.h>
#include <cstdio>
#include <cstdint>

#ifndef MK_KREP
#define MK_KREP 1
#endif
#ifndef MK_TSEL
#define MK_TSEL -1
#endif
#ifndef MK_TBLK
#define MK_TBLK 0
#endif
#ifndef MK_TAMP
#define MK_TAMP 8
#endif
#ifndef MK_TWAIT
#define MK_TWAIT 0
#endif
#ifndef MK_GMODE
#define MK_GMODE 0
#endif
#ifndef MK_PER_PHASE
#define MK_PER_PHASE 0
#endif

#define GAS __attribute__((address_space(1)))
#define LAS __attribute__((address_space(3)))
typedef unsigned short bf16;
typedef short bf16x8 __attribute__((ext_vector_type(8)));
typedef float f32x4 __attribute__((ext_vector_type(4)));
typedef float f32x2 __attribute__((ext_vector_type(2)));
typedef unsigned u32x4 __attribute__((ext_vector_type(4)));
typedef unsigned u32x2 __attribute__((ext_vector_type(2)));

constexpr int NB = 16, SEQ = 2048, D = 1024, NTOK = NB * SEQ, MEML = 256, NMR = NB * MEML;
constexpr int NEXP = 16, DE = 512;
constexpr float EPS = 1e-6f;
constexpr float LOG2E = 1.4426950408889634f;
constexpr int NPH = 21;
constexpr float W8_GU_SCALE = 32.0f, W8_DOWN_SCALE = 16.0f, H8_MID_SCALE = 4.0f;

constexpr size_t MiB = 1u << 20;
constexpr size_t WS_CTL = 0, CTL_ZERO_BYTES = 1 * MiB;
constexpr int CW_BAR = 4096;
constexpr int CW_CNT = 16384;
constexpr size_t WS_RSTD_A = 1 * MiB;
constexpr size_t WS_RSTD_B = 1 * MiB + 128 * 1024;
constexpr size_t WS_RSTD_X = 1 * MiB + 256 * 1024;
constexpr size_t WS_SS16 = 2 * MiB;
constexpr size_t WS_WRB = 4 * MiB;
constexpr size_t WS_SPL = 4 * MiB + 256 * 1024;
constexpr size_t WS_GW = 5 * MiB;
constexpr size_t WS_LIST = 6 * MiB;
constexpr size_t WS_W_POOL = 8 * MiB;
constexpr size_t WS_W_GATE = 8 * MiB + 512 * 1024;
constexpr size_t WS_W_OUT = 10 * MiB;
constexpr size_t WS_W_IN = 12 * MiB;
constexpr size_t WS_W_Q = 16 * MiB;
constexpr size_t WS_W_OT = 20 * MiB;
constexpr size_t WS_W_KV = 24 * MiB;
constexpr size_t WS_W_DOWN = 32 * MiB;
constexpr size_t WS_W_GU = 64 * MiB;
constexpr size_t WS_K = 128 * MiB;
constexpr size_t WS_V = 144 * MiB;
constexpr size_t WS_BS = 160 * MiB;
constexpr size_t WS_BO = 192 * MiB;
constexpr size_t WS_HA = 224 * MiB;
constexpr size_t WS_HB = 288 * MiB;
constexpr size_t WS_MEMN = 352 * MiB;
constexpr size_t WS_AGS = 368 * MiB;
constexpr size_t WS_AGB = 372 * MiB;
constexpr size_t WS_Y = 384 * MiB;
constexpr size_t WS_END = 512 * MiB;
constexpr size_t OB_P0 = 0, OB_PATT = 64 * MiB, OB_HMID = 0, OB_LOGA = 0, OB_BT = 64 * MiB;
constexpr size_t WS_H8 = WS_Y + 64 * MiB;

constexpr int RING_OFF = 0, RING_BYTES = 131072;
constexpr int XCH_OFF = 131072;
constexpr int TAB_OFF = 139264;
constexpr int TAB2_OFF = 147456;
constexpr int MISC_OFF = 155648;
constexpr int LDS_BYTES = 155904;
constexpr int MAXU = 8;

#define LDS_WAIT() asm volatile("s_waitcnt lgkmcnt(0)" ::: "memory")
#define VM_WAIT() asm volatile("s_waitcnt vmcnt(0)" ::: "memory")

__device__ __forceinline__ unsigned f2bf(float f) { unsigned u = __builtin_bit_cast(unsigned, f); return (u + 0x7fffu + ((u >> 16) & 1u)) >> 16; }
__device__ __forceinline__ unsigned pk2(float lo, float hi) { return f2bf(lo) | (f2bf(hi) << 16); }
__device__ __forceinline__ float bflo(unsigned w) { return __builtin_bit_cast(float, w << 16); }
__device__ __forceinline__ float bfhi(unsigned w) { return __builtin_bit_cast(float, w & 0xffff0000u); }
__device__ __forceinline__ unsigned cvt_pk_bf16(float lo, float hi) { unsigned r; asm volatile("v_cvt_pk_bf16_f32 %0, %1, %2" : "=v"(r) : "v"(lo), "v"(hi)); return r; }
__device__ __forceinline__ u32x4 pack8(f32x4 a, f32x4 b) { u32x4 w; w.x = cvt_pk_bf16(a[0], a[1]); w.y = cvt_pk_bf16(a[2], a[3]); w.z = cvt_pk_bf16(b[0], b[1]); w.w = cvt_pk_bf16(b[2], b[3]); return w; }
__device__ __forceinline__ void unpack8(u32x4 w, f32x4& a, f32x4& b) { a[0] = bflo(w.x); a[1] = bfhi(w.x); a[2] = bflo(w.y); a[3] = bfhi(w.y); b[0] = bflo(w.z); b[1] = bfhi(w.z); b[2] = bflo(w.w); b[3] = bfhi(w.w); }
__device__ __forceinline__ u32x2 pack8_fp8(f32x4 a, f32x4 b) {
#pragma unroll
    for (int j = 0; j < 4; ++j) { a[j] = __builtin_amdgcn_fmed3f(a[j], -384.0f, 384.0f); b[j] = __builtin_amdgcn_fmed3f(b[j], -384.0f, 384.0f); }
    int lo = 0, hi = 0;
    lo = __builtin_amdgcn_cvt_pk_fp8_f32(a[0], a[1], lo, false); lo = __builtin_amdgcn_cvt_pk_fp8_f32(a[2], a[3], lo, true);
    hi = __builtin_amdgcn_cvt_pk_fp8_f32(b[0], b[1], hi, false); hi = __builtin_amdgcn_cvt_pk_fp8_f32(b[2], b[3], hi, true);
    return (u32x2){(unsigned)lo, (unsigned)hi};
}
__device__ __forceinline__ float wave_sum(float v) {
#pragma unroll
    for (int o = 1; o < 64; o <<= 1) v += __shfl_xor(v, o);
    return v;
}
__device__ __forceinline__ float fast_exp2(float x) { return __builtin_amdgcn_exp2f(x); }
__device__ __forceinline__ float fast_rcp(float x) { return __builtin_amdgcn_rcpf(x); }
__device__ __forceinline__ float sigmoidf_(float x) { return fast_rcp(1.0f + fast_exp2(-x * LOG2E)); }

namespace pg8 {
constexpr int BM = 256, BK = 64, HALF = 128, HTB = HALF * BK * 2, STAGE_BYTES = 8 * HTB, NXCD = 8, WGM = 8;
__host__ __device__ __forceinline__ int lds_byte(int r, int c) { const int st = (r >> 4) * 2 + (c >> 5), rr = r & 15, cc = c & 31, ob = rr * 64 + cc * 2; return st * 1024 + (ob ^ (((ob >> 9) & 1) << 5)); }
__host__ __device__ __forceinline__ void stage_rc(int b, int& R, int& C) { const int st = b / 1024, sb = b % 1024, swz = sb ^ (((sb >> 9) & 1) << 5); R = (st >> 1) * 16 + swz / 64; C = (st & 1) * 32 + (swz % 64) / 2; }
__host__ __device__ __forceinline__ int perm32(int rho) { const int n = rho >> 4, i = rho & 15; return 8 * (i >> 2) + 4 * n + (i & 3); }

struct Unit { const char* A; const char* B; char* C; int row0, col0, aux; };

__device__ __forceinline__ bool tile_of(int i, int G, int c, int nM, int nN, int& pm, int& pn) {
    const int nwg = nM * nN; const long L = (long)i * G + c; if (L >= nwg) return false;
    int wgid = (int)L; { const int q = nwg / NXCD, r = nwg % NXCD, xcd = wgid % NXCD, off = wgid / NXCD; wgid = (xcd < r ? xcd * (q + 1) : r * (q + 1) + (xcd - r) * q) + off; }
    const int nig = WGM * nN, gid = wgid / nig, fm = gid * WGM, gsz = (nM - fm) < WGM ? (nM - fm) : WGM;
    pm = fm + ((wgid % nig) % gsz); pn = (wgid % nig) / gsz; return true;
}

typedef int i32x8 __attribute__((ext_vector_type(8)));
template <class Epi, class Sched, bool GATHER, bool F8 = false>
__device__ __forceinline__ void gemm_phase(LAS unsigned char* lds, const int K, const unsigned lda, const unsigned ldb, const Sched& S, const Epi& E, const LAS int* tab) {
    const int tid = threadIdx.x, wid = __builtin_amdgcn_readfirstlane(tid >> 6), lane = tid & 63, wr = wid >> 2, wc = wid & 3, fr = lane & 15, fq = lane >> 4;
    const int nt = F8 ? K / 128 : K / BK;
    unsigned vA[2], vB[2], vG[2][2]; int rA[2]; unsigned cA2[2];
#pragma unroll
    for (int i = 0; i < 2; ++i) { int R, C; stage_rc(tid * 16 + i * 8192, R, C); const int Rb = (R & ~31) + perm32(R & 31);
        vA[i] = (unsigned)R * lda + (unsigned)C * 2u; vB[i] = (unsigned)Rb * ldb + (unsigned)C * 2u; rA[i] = R; cA2[i] = (unsigned)C * 2u; vG[0][i] = 0; vG[1][i] = 0; }
    const size_t kstep = (size_t)(BK * 2);
    const size_t hsA = (size_t)HALF * lda, hsB = (size_t)HALF * ldb;
    const unsigned ldsw = (unsigned)wid * 1024u;
    const int aoff = lds_byte(wr * 64 + fr, fq * (F8 ? 16 : 8)), boff = lds_byte(wc * 32 + fr, fq * (F8 ? 16 : 8));
#define PG8_SA(b, h) (((b) * 2 + (h)) * HTB)
#define PG8_SB(b, h) ((4 + (b) * 2 + (h)) * HTB)
#define PG8_STAGE_B(bufoff, gbase) do { _Pragma("unroll") for (int _i = 0; _i < 2; ++_i) \
        __builtin_amdgcn_global_load_lds((const unsigned*)((const char*)(gbase) + vB[_i]), (LAS unsigned*)(lds + (bufoff) + ldsw + _i * 8192), 16, 0, 0); } while (0)
#define PG8_STAGE_A(bufoff, gbase, h) do { _Pragma("unroll") for (int _i = 0; _i < 2; ++_i) { \
        if constexpr (GATHER) __builtin_amdgcn_global_load_lds((const unsigned*)((const char*)(gbase) + vG[h][_i]), (LAS unsigned*)(lds + (bufoff) + ldsw + _i * 8192), 16, 0, 0); \
        else __builtin_amdgcn_global_load_lds((const unsigned*)((const char*)(gbase) + (h) * hsA + vA[_i]), (LAS unsigned*)(lds + (bufoff) + ldsw + _i * 8192), 16, 0, 0); } } while (0)
#define PG8_LOADG(ui_) do { const int _u = ((ui_) < MAXU ? (ui_) : (MAXU - 1)) * 256; _Pragma("unroll") for (int _h = 0; _h < 2; ++_h) _Pragma("unroll") for (int _i = 0; _i < 2; ++_i) \
        vG[_h][_i] = (unsigned)tab[_u + rA[_i] + 128 * _h] * lda + cA2[_i]; } while (0)
#define PG8_LDA(dst, b, h) do { if constexpr (F8) { _Pragma("unroll") for (int m = 0; m < 4; ++m) dst##8[m] = *(const LAS i32x8*)(lds + PG8_SA(b, h) + aoff + m * 2048); } \
        else { _Pragma("unroll") for (int m = 0; m < 4; ++m) _Pragma("unroll") for (int k = 0; k < 2; ++k) dst[m][k] = *(const LAS bf16x8*)(lds + PG8_SA(b, h) + aoff + m * 2048 + k * 1024); } } while (0)
#define PG8_LDB(dst, b, h) do { if constexpr (F8) { _Pragma("unroll") for (int n = 0; n < 2; ++n) dst##8[n] = *(const LAS i32x8*)(lds + PG8_SB(b, h) + boff + n * 2048); } \
        else { _Pragma("unroll") for (int n = 0; n < 2; ++n) _Pragma("unroll") for (int k = 0; k < 2; ++k) dst[n][k] = *(const LAS bf16x8*)(lds + PG8_SB(b, h) + boff + n * 2048 + k * 1024); } } while (0)
#define PG8_MMA(ai, bj, At, Bt) do { __builtin_amdgcn_s_setprio(1); _Pragma("unroll") for (int m = 0; m < 4; ++m) _Pragma("unroll") for (int n = 0; n < 2; ++n) { \
        if constexpr (F8) { asm volatile("v_mfma_f32_16x16x128_f8f6f4 %0, %1, %2, %0" : "+v"(acc[ai][bj][m][n]) : "v"(Bt##8[n]), "v"(At##8[m])); } \
        else { _Pragma("unroll") for (int k = 0; k < 2; ++k) acc[ai][bj][m][n] = __builtin_amdgcn_mfma_f32_16x16x32_bf16(Bt[n][k], At[m][k], acc[ai][bj][m][n], 0, 0, 0); } } \
        __builtin_amdgcn_s_setprio(0); } while (0)
#define PG8_WAIT_V(n) asm volatile("s_waitcnt vmcnt(" #n ")" ::: "memory")
#define PG8_WAIT_L(n) asm volatile("s_waitcnt lgkmcnt(" #n ")" ::: "memory")
#define PG8_BAR __builtin_amdgcn_s_barrier()
#define PG8_SCHED __builtin_amdgcn_sched_barrier(0)
#if MK_GMODE
    volatile LAS unsigned* _gm = (volatile LAS unsigned*)(lds + 155648);
    const bool _gsel = (threadIdx.x == 0) && ((int)_gm[16] == MK_TSEL);
    unsigned _gt = (unsigned)__builtin_amdgcn_s_memrealtime(); unsigned _gacc = 0;
#define PG8_GSTAMP(mode_) do { if (_gsel) { const unsigned _n = (unsigned)__builtin_amdgcn_s_memrealtime(); if (MK_GMODE == (mode_)) _gacc += _n - _gt; _gt = _n; } } while (0)
#else
#define PG8_GSTAMP(mode_) do { } while (0)
#endif
    Unit cur, nxt; int ui = 0;
    if (!S.next(0, cur)) return;
    f32x4 acc[2][2][4][2];
#pragma unroll
    for (int a = 0; a < 2; ++a)
#pragma unroll
        for (int b = 0; b < 2; ++b)
#pragma unroll
            for (int m = 0; m < 4; ++m)
#pragma unroll
                for (int n = 0; n < 2; ++n) acc[a][b][m][n] = (f32x4){0.f, 0.f, 0.f, 0.f};
    bf16x8 At[4][2], B0[2][2], B1[2][2]; i32x8 At8[4], B08[2], B18[2];
    const char* cA = cur.A; const char* cB = cur.B;
    if constexpr (GATHER) { PG8_LOADG(0); }
    PG8_STAGE_B(PG8_SB(0, 0), cB); PG8_STAGE_B(PG8_SB(0, 1), cB + hsB); PG8_STAGE_A(PG8_SA(0, 0), cA, 0); PG8_STAGE_A(PG8_SA(0, 1), cA, 1);
    if (wr == 1) PG8_BAR;
    PG8_WAIT_V(2); PG8_BAR;
    PG8_STAGE_B(PG8_SB(1, 0), cB + kstep); PG8_STAGE_A(PG8_SA(1, 0), cA + kstep, 0); PG8_STAGE_B(PG8_SB(1, 1), cB + hsB + kstep);
    PG8_WAIT_V(6); PG8_BAR;
    PG8_GSTAMP(1);
    for (;;) {
        const bool has_next = S.next(ui + 1, nxt);
        const char* nA = has_next ? nxt.A : cA; const char* nB = has_next ? nxt.B : cB;
#pragma nounroll
        for (int t = 0; t < nt * MK_KREP; t += 2) {
            const bool last = (t == nt * MK_KREP - 2);
            const char* a1 = cA + (size_t)(MK_KREP == 1 ? (t + 1) : ((t + 1) % nt)) * kstep;
            const int t2 = (MK_KREP == 1) ? (t + 2) : ((t + 2) % nt);
            const char* a2 = last ? nA : cA + (size_t)t2 * kstep; const char* b2 = last ? nB : cB + (size_t)t2 * kstep;
            const char* a3 = a2 + kstep; const char* b3 = b2 + kstep;
            PG8_LDB(B0, 0, 0); PG8_LDB(B1, 0, 1); PG8_SCHED; PG8_LDA(At, 0, 0); PG8_STAGE_A(PG8_SA(1, 1), a1, 1);
            PG8_WAIT_V(8); PG8_WAIT_L(0); PG8_BAR; PG8_MMA(0, 0, At, B0); PG8_MMA(0, 1, At, B1); PG8_BAR; PG8_SCHED;
            if constexpr (GATHER) { if (last && has_next) { PG8_LOADG(ui + 1); } }
            PG8_LDA(At, 0, 1); PG8_STAGE_B(PG8_SB(0, 0), b2); PG8_STAGE_B(PG8_SB(0, 1), b2 + hsB); PG8_STAGE_A(PG8_SA(0, 0), a2, 0);
            PG8_WAIT_V(8); PG8_WAIT_L(0); PG8_BAR; PG8_MMA(1, 0, At, B0); PG8_MMA(1, 1, At, B1); PG8_BAR; PG8_SCHED;
            PG8_LDB(B0, 1, 0); PG8_LDB(B1, 1, 1); PG8_SCHED; PG8_LDA(At, 1, 0); PG8_STAGE_A(PG8_SA(0, 1), a2, 1);
            PG8_WAIT_V(8); PG8_WAIT_L(0); PG8_BAR; PG8_MMA(0, 0, At, B0); PG8_MMA(0, 1, At, B1); PG8_BAR; PG8_SCHED;
            PG8_LDA(At, 1, 1); PG8_STAGE_B(PG8_SB(1, 0), b3); PG8_STAGE_B(PG8_SB(1, 1), b3 + hsB); PG8_STAGE_A(PG8_SA(1, 0), a3, 0);
            PG8_WAIT_V(8); PG8_WAIT_L(0); PG8_BAR; PG8_MMA(1, 0, At, B0); PG8_MMA(1, 1, At, B1); PG8_BAR; PG8_SCHED;
        }
        if (wr == 0) PG8_BAR;
        PG8_GSTAMP(4);
        if constexpr (F8) asm volatile("s_nop 15\n\ts_nop 15\n\ts_nop 15\n\ts_nop 15" ::: "memory");
        if (MK_KREP != 1) {
#pragma unroll
            for (int a = 0; a < 2; ++a)
#pragma unroll
                for (int b = 0; b < 2; ++b)
#pragma unroll
                    for (int m = 0; m < 4; ++m)
#pragma unroll
                        for (int n = 0; n < 2; ++n) acc[a][b][m][n] *= (1.0f / MK_KREP);
        }
        E(acc, cur, wr, wc, fr, fq);
        PG8_GSTAMP(2);
        if (!has_next) break;
#pragma unroll
        for (int a = 0; a < 2; ++a)
#pragma unroll
            for (int b = 0; b < 2; ++b)
#pragma unroll
                for (int m = 0; m < 4; ++m)
#pragma unroll
                    for (int n = 0; n < 2; ++n) acc[a][b][m][n] = (f32x4){0.f, 0.f, 0.f, 0.f};
        cur = nxt; cA = nA; cB = nB; ++ui;
        if (wr == 1) PG8_BAR;
    }
    PG8_WAIT_V(0);
    PG8_BAR;
    PG8_GSTAMP(3);
#if MK_GMODE
    if (_gsel) _gm[18] = _gacc;
#endif
#undef PG8_GSTAMP
#undef PG8_SA
#undef PG8_SB
#undef PG8_STAGE_A
#undef PG8_STAGE_B
#undef PG8_LOADG
#undef PG8_LDA
#undef PG8_LDB
#undef PG8_MMA
#undef PG8_WAIT_V
#undef PG8_WAIT_L
#undef PG8_BAR
#undef PG8_SCHED
}

typedef f32x4 Acc[2][2][4][2];
#ifndef MK_EPI_SC1
#define MK_EPI_SC1 0
#endif
__device__ __forceinline__ void st16(bf16* p, u32x4 v) {
#if MK_EPI_SC1
    asm volatile("global_store_dwordx4 %0, %1, off sc1\n\ts_nop 1" :: "v"(p), "v"(v) : "memory");
#else
    *(u32x4*)p = v;
#endif
}

struct EpiPlain {
    int ldc;
    __device__ __forceinline__ void operator()(Acc& acc, const Unit& u, int wr, int wc, int fr, int fq) const {
        bf16* base = (bf16*)u.C + (size_t)(wr * 64 + fr) * ldc + wc * 32 + 8 * fq;
#pragma unroll
        for (int ai = 0; ai < 2; ++ai)
#pragma unroll
            for (int m = 0; m < 4; ++m) { bf16* rowp = base + (size_t)(ai * 128 + m * 16) * ldc;
#pragma unroll
                for (int bj = 0; bj < 2; ++bj) st16(rowp + bj * 128, pack8(acc[ai][bj][m][0], acc[ai][bj][m][1])); }
    }
};
template <bool STATS> struct EpiRes {
    const bf16* hin; bf16* hout; float* ss16; unsigned char* h8;
    __device__ __forceinline__ void operator()(Acc& acc, const Unit& u, int wr, int wc, int fr, int fq) const {
        const size_t ro0 = (size_t)(u.row0 + wr * 64 + fr) * 1024 + u.col0 + wc * 32 + 8 * fq;
        u32x4 hv[2][4][2];
#pragma unroll
        for (int ai = 0; ai < 2; ++ai)
#pragma unroll
            for (int m = 0; m < 4; ++m)
#pragma unroll
                for (int bj = 0; bj < 2; ++bj) hv[ai][m][bj] = *(const u32x4*)(hin + ro0 + (size_t)(ai * 128 + m * 16) * 1024 + bj * 128);
#pragma unroll
        for (int ai = 0; ai < 2; ++ai)
#pragma unroll
            for (int m = 0; m < 4; ++m) { const int row = u.row0 + ai * 128 + wr * 64 + m * 16 + fr; const size_t ro = ro0 + (size_t)(ai * 128 + m * 16) * 1024; float s = 0.f;
#pragma unroll
                for (int bj = 0; bj < 2; ++bj) { f32x4 a, b; unpack8(hv[ai][m][bj], a, b); a += acc[ai][bj][m][0]; b += acc[ai][bj][m][1];
                    if constexpr (STATS) s += (a[0] * a[0] + a[1] * a[1]) + (a[2] * a[2] + a[3] * a[3]) + (b[0] * b[0] + b[1] * b[1]) + (b[2] * b[2] + b[3] * b[3]);
                    st16(hout + ro + bj * 128, pack8(a, b)); if (h8) *(u32x2*)(h8 + ro + bj * 128) = pack8_fp8(a, b); }
                if constexpr (STATS) { s += __shfl_xor(s, 16); s += __shfl_xor(s, 32);
                    if (fq == 0) ss16[(size_t)row * 16 + (u.col0 >> 8) * 4 + wc] = s; } }
    }
};
struct EpiPool {
    const float* x; const float* scale; bf16* hout; float* ss16;
    __device__ __forceinline__ void operator()(Acc& acc, const Unit& u, int wr, int wc, int fr, int fq) const {
        const int cb = u.col0 + wc * 32 + 8 * fq;
        f32x4 sc[2][2];
#pragma unroll
        for (int bj = 0; bj < 2; ++bj) { sc[bj][0] = *(const f32x4*)(scale + cb + bj * 128); sc[bj][1] = *(const f32x4*)(scale + cb + bj * 128 + 4); }
        float ssum[2][4];
#pragma unroll
        for (int ai = 0; ai < 2; ++ai) {
            f32x4 xv[4][2][2];
#pragma unroll
            for (int m = 0; m < 4; ++m)
#pragma unroll
                for (int bj = 0; bj < 2; ++bj) { const float* xp = x + (size_t)(u.row0 + ai * 128 + wr * 64 + m * 16 + fr) * 1024 + cb + bj * 128; xv[m][bj][0] = *(const f32x4*)xp; xv[m][bj][1] = *(const f32x4*)(xp + 4); }
#pragma unroll
            for (int m = 0; m < 4; ++m) { const int row = u.row0 + ai * 128 + wr * 64 + m * 16 + fr; const size_t ro = (size_t)row * 1024 + cb; float s = 0.f;
#pragma unroll
                for (int bj = 0; bj < 2; ++bj) { f32x4 a = xv[m][bj][0], b = xv[m][bj][1];
                    a += acc[ai][bj][m][0] * sc[bj][0]; b += acc[ai][bj][m][1] * sc[bj][1];
                    s += (a[0] * a[0] + a[1] * a[1]) + (a[2] * a[2] + a[3] * a[3]) + (b[0] * b[0] + b[1] * b[1]) + (b[2] * b[2] + b[3] * b[3]);
                    st16(hout + ro + bj * 128, pack8(a, b)); }
                s += __shfl_xor(s, 16); s += __shfl_xor(s, 32); ssum[ai][m] = s; }
        }
        if (fq == 0) {
#pragma unroll
            for (int ai = 0; ai < 2; ++ai)
#pragma unroll
                for (int m = 0; m < 4; ++m) ss16[(size_t)(u.row0 + ai * 128 + wr * 64 + m * 16 + fr) * 16 + (u.col0 >> 8) * 4 + wc] = ssum[ai][m];
        }
    }
};
struct EpiS {
    bf16* P; const LAS float* tab2; LAS f32x2* xch;
    __device__ __forceinline__ void operator()(Acc& acc, const Unit& u, int wr, int wc, int fr, int fq) const {
        float mxs[2][4];
#pragma unroll
        for (int ai = 0; ai < 2; ++ai)
#pragma unroll
            for (int m = 0; m < 4; ++m) { const int rl = ai * 128 + wr * 64 + m * 16 + fr; const int row = u.row0 + rl;
                const float rs = tab2[(u.aux < MAXU ? u.aux : MAXU - 1) * 256 + rl];
                float mx = -3.0e38f;
#pragma unroll
                for (int bj = 0; bj < 2; ++bj)
#pragma unroll
                    for (int n = 0; n < 2; ++n) { f32x4 v = acc[ai][bj][m][n] * rs; acc[ai][bj][m][n] = v; mx = fmaxf(mx, fmaxf(fmaxf(v[0], v[1]), fmaxf(v[2], v[3]))); }
                mx = fmaxf(mx, __shfl_xor(mx, 16)); mx = fmaxf(mx, __shfl_xor(mx, 32));
                float l = 0.f;
#pragma unroll
                for (int bj = 0; bj < 2; ++bj)
#pragma unroll
                    for (int n = 0; n < 2; ++n) { f32x4 v = acc[ai][bj][m][n]; f32x4 e; e[0] = fast_exp2(v[0] - mx); e[1] = fast_exp2(v[1] - mx); e[2] = fast_exp2(v[2] - mx); e[3] = fast_exp2(v[3] - mx);
                        acc[ai][bj][m][n] = e; l += (e[0] + e[1]) + (e[2] + e[3]); }
                l += __shfl_xor(l, 16); l += __shfl_xor(l, 32);
                if (fq == 0) xch[rl * 4 + wc] = (f32x2){mx, l};
                mxs[ai][m] = mx; }
        asm volatile("s_waitcnt lgkmcnt(0)" ::: "memory"); __builtin_amdgcn_s_barrier(); asm volatile("" ::: "memory");
#pragma unroll
        for (int ai = 0; ai < 2; ++ai)
#pragma unroll
            for (int m = 0; m < 4; ++m) { const int rl = ai * 128 + wr * 64 + m * 16 + fr; const int row = u.row0 + rl;
                const f32x2 p0 = xch[rl * 4 + 0], p1 = xch[rl * 4 + 1], p2 = xch[rl * 4 + 2], p3 = xch[rl * 4 + 3];
                const float M = fmaxf(fmaxf(p0.x, p1.x), fmaxf(p2.x, p3.x));
                const float L = (p0.y * fast_exp2(p0.x - M) + p1.y * fast_exp2(p1.x - M)) + (p2.y * fast_exp2(p2.x - M) + p3.y * fast_exp2(p3.x - M));
                const float f = fast_exp2(mxs[ai][m] - M) * fast_rcp(L);
                bf16* rowp = P + (size_t)row * 1024 + u.col0 + wc * 32 + 8 * fq;
#pragma unroll
                for (int bj = 0; bj < 2; ++bj) st16(rowp + bj * 128, pack8(acc[ai][bj][m][0] * f, acc[ai][bj][m][1] * f)); }
    }
};
struct EpiGU {
    unsigned char* hmid; const LAS float* tab2;
    __device__ __forceinline__ void operator()(Acc& acc, const Unit& u, int wr, int wc, int fr, int fq) const {
        const int ub = (u.aux < MAXU ? u.aux : MAXU - 1) * 256;
#pragma unroll
        for (int ai = 0; ai < 2; ++ai)
#pragma unroll
            for (int m = 0; m < 4; ++m) { const int rl = ai * 128 + wr * 64 + m * 16 + fr; const float rs = tab2[ub + rl] * (1.0f / W8_GU_SCALE);
                f32x4 o[2];
#pragma unroll
                for (int n = 0; n < 2; ++n)
#pragma unroll
                    for (int j = 0; j < 4; ++j) { const float g = acc[ai][0][m][n][j] * rs, uu = acc[ai][1][m][n][j] * rs; o[n][j] = g * sigmoidf_(g) * uu * H8_MID_SCALE; }
                *(u32x2*)(hmid + (size_t)(u.row0 + rl) * 512 + (u.col0 >> 1) + wc * 32 + 8 * fq) = pack8_fp8(o[0], o[1]); }
    }
};
struct EpiDown {
    bf16* y; const LAS int* tab; const LAS float* tab2;
    __device__ __forceinline__ void operator()(Acc& acc, const Unit& u, int wr, int wc, int fr, int fq) const {
        const int ub = (u.aux < MAXU ? u.aux : MAXU - 1) * 256;
#pragma unroll
        for (int ai = 0; ai < 2; ++ai)
#pragma unroll
            for (int m = 0; m < 4; ++m) { const int rl = ai * 128 + wr * 64 + m * 16 + fr; const int slot = tab[ub + rl]; const float w = tab2[ub + rl] * (1.0f / (W8_DOWN_SCALE * H8_MID_SCALE));
                if (slot >= 0) { bf16* rowp = y + (size_t)slot * 1024 + u.col0 + wc * 32 + 8 * fq;
#pragma unroll
                    for (int bj = 0; bj < 2; ++bj) st16(rowp + bj * 128, pack8(acc[ai][bj][m][0] * w, acc[ai][bj][m][1] * w)); } }
    }
};
struct EpiIn {
    bf16* xb; bf16* gate; const LAS float* tab2;
    __device__ __forceinline__ void operator()(Acc& acc, const Unit& u, int wr, int wc, int fr, int fq) const {
        const bool isg = u.col0 >= 1024; bf16* dst = isg ? gate : xb; const int c0 = (u.col0 & 1023) + wc * 32 + 8 * fq;
#pragma unroll
        for (int ai = 0; ai < 2; ++ai)
#pragma unroll
            for (int m = 0; m < 4; ++m) { const int rl = ai * 128 + wr * 64 + m * 16 + fr; const int row = u.row0 + rl; const float rs = tab2[(u.aux < MAXU ? u.aux : MAXU - 1) * 256 + rl];
#pragma unroll
                for (int bj = 0; bj < 2; ++bj) { f32x4 o[2];
#pragma unroll
                    for (int n = 0; n < 2; ++n)
#pragma unroll
                        for (int j = 0; j < 4; ++j) { float v = acc[ai][bj][m][n][j] * rs; if (isg) { const float t = 1.5957691216057308f * (v + 0.044715f * v * v * v); v = v * sigmoidf_(t); } o[n][j] = v; }
                    st16(dst + (size_t)row * 1024 + c0 + bj * 128, pack8(o[0], o[1])); } }
    }
};
struct EpiGates {
    const bf16* xc; bf16* loga; bf16* bt; const float* bgate; const float* spl;
    __device__ __forceinline__ void operator()(Acc& acc, const Unit& u, int wr, int wc, int fr, int fq) const {
        const int ch = u.col0 + wc * 32 + 8 * fq;
        const int hh = u.col0 >> 8, cin = (u.col0 & 255) + wc * 32 + 8 * fq;
        f32x4 br[2], bi[2], sp[2];
#pragma unroll
        for (int n = 0; n < 2; ++n) { br[n] = *(const f32x4*)(bgate + hh * 512 + cin + 4 * n); bi[n] = *(const f32x4*)(bgate + hh * 512 + 256 + cin + 4 * n); sp[n] = *(const f32x4*)(spl + ch + 4 * n); }
        u32x4 xv[2][4];
#pragma unroll
        for (int ai = 0; ai < 2; ++ai)
#pragma unroll
            for (int m = 0; m < 4; ++m) xv[ai][m] = *(const u32x4*)(xc + (size_t)(u.row0 + ai * 128 + wr * 64 + m * 16 + fr) * 1024 + ch);
#pragma unroll
        for (int ai = 0; ai < 2; ++ai)
#pragma unroll
            for (int m = 0; m < 4; ++m) { const int row = u.row0 + ai * 128 + wr * 64 + m * 16 + fr; const size_t ro = (size_t)row * 1024 + ch;
                f32x4 x[2]; unpack8(xv[ai][m], x[0], x[1]);
                f32x4 la[2], bb[2];
#pragma unroll
                for (int n = 0; n < 2; ++n)
#pragma unroll
                    for (int j = 0; j < 4; ++j) { const float er = 1.0f + fast_exp2(fminf(-(acc[ai][0][m][n][j] + br[n][j]) * LOG2E, 60.f)), ei = 1.0f + fast_exp2(fminf(-(acc[ai][1][m][n][j] + bi[n][j]) * LOG2E, 60.f));
                        const float q = fast_rcp(er * ei); const float r = q * ei, ig = q * er;
                        const float l = -8.0f * r * sp[n][j]; const float a2 = fast_exp2(2.0f * LOG2E * l); const float mult = __builtin_amdgcn_sqrtf(fmaxf(1.0f - a2, 0.f));
                        la[n][j] = l; bb[n][j] = mult * ig * x[n][j]; }
                *(u32x4*)(loga + ro) = pack8(la[0], la[1]); *(u32x4*)(bt + ro) = pack8(bb[0], bb[1]); }
    }
};
}

#define XB_TMO      128
#define XB_XCNT(j)  (256  + 64 * (j))
#define XB_XSUB(j)  (1280 + 64 * (j))
#define XB_XGEN(j)  (2304 + 64 * (j))
#define XB_TOP      3328
#define XB_TOPGEN   3392
#define XCD_BAR_WORDS 3456
#define XB_SPIN_CAP (1u << 18)

__device__ __forceinline__ unsigned xb_ld(unsigned* p)              { return __hip_atomic_load(p, __ATOMIC_RELAXED, __HIP_MEMORY_SCOPE_AGENT); }
__device__ __forceinline__ unsigned xb_add(unsigned* p, unsigned v) { return __hip_atomic_fetch_add(p, v, __ATOMIC_RELAXED, __HIP_MEMORY_SCOPE_AGENT); }
__device__ __forceinline__ unsigned xb_xcc_id() { return (unsigned)__builtin_amdgcn_s_getreg((3 << 11) | 20) & 0xFu; }
#define XB_SPIN(cond, bar) do { unsigned _sp = 0; while (cond) { __builtin_amdgcn_s_sleep(1); \
    if ((++_sp & 255u) == 0u) { if (xb_ld(&(bar)[XB_TMO])) break; if (_sp > XB_SPIN_CAP) { atomicAdd(&(bar)[XB_TMO], 1u); break; } } } } while (0)

struct XcdBarrier { unsigned* bar; unsigned x; volatile LAS unsigned* st; };

__device__ __forceinline__ XcdBarrier xcd_barrier_post(unsigned* bar, volatile LAS unsigned* st) {
    XcdBarrier b; b.bar = bar; b.x = xb_xcc_id(); b.st = st;
    if (threadIdx.x == 0) (void)xb_add(&bar[XB_XCNT(b.x)], 1u);
    return b;
}
__device__ __forceinline__ void xcd_barrier_complete(unsigned* bar, unsigned x, unsigned& nloc, unsigned& nx) {
    const unsigned G = gridDim.x * gridDim.y * gridDim.z;
    unsigned sum, cnt, mine, sp = 0u;
    for (;;) {
        sum = 0u; cnt = 0u; mine = 0u;
#pragma unroll
        for (unsigned j = 0; j < 16; ++j) { const unsigned c = xb_ld(&bar[XB_XCNT(j)]); sum += c; cnt += (c > 0u) ? 1u : 0u; mine = (j == x) ? c : mine; }
        if (sum == G) break;
        __builtin_amdgcn_s_sleep(1);
        if ((++sp & 255u) == 0u) { if (xb_ld(&bar[XB_TMO])) break; if (sp > XB_SPIN_CAP) { atomicAdd(&bar[XB_TMO], 1u); break; } }
    }
    nloc = mine > 0u ? mine : 1u; nx = cnt > 0u ? cnt : 1u;
}
__device__ __forceinline__ void xcd_barrier(const XcdBarrier& b) {
    asm volatile("s_waitcnt vmcnt(0)" ::: "memory");
    __syncthreads();
    if (threadIdx.x == 0) {
        unsigned* bar = b.bar;
        __builtin_amdgcn_s_waitcnt(0);
        unsigned nloc = b.st[0], nx = b.st[1];
        if (nloc == 0u) { xcd_barrier_complete(bar, b.x, nloc, nx); b.st[0] = nloc; b.st[1] = nx; }
        const unsigned old = xb_add(&bar[XB_XSUB(b.x)], 1u);
        const unsigned gen = old / nloc;
        if (old + 1u == (gen + 1u) * nloc) {
            __builtin_amdgcn_fence(__ATOMIC_RELEASE, "agent");
            asm volatile("s_waitcnt vmcnt(0)" ::: "memory");
            const unsigned og = xb_add(&bar[XB_TOP], 1u);
            const unsigned tg = og / nx;
            if (og + 1u == (tg + 1u) * nx) xb_add(&bar[XB_TOPGEN], 1u);
            else XB_SPIN(xb_ld(&bar[XB_TOPGEN]) == tg, bar);
            __builtin_amdgcn_fence(__ATOMIC_ACQUIRE, "agent");
            xb_add(&bar[XB_XGEN(b.x)], 1u);
            asm volatile("s_waitcnt vmcnt(0)" ::: "memory");
        } else {
            XB_SPIN(xb_ld(&bar[XB_XGEN(b.x)]) == gen, bar);
            __builtin_amdgcn_fence(__ATOMIC_ACQUIRE, "agent");
            asm volatile("s_waitcnt vmcnt(0)" ::: "memory");
        }
    }
    __syncthreads();
}

struct Args { const float* in[25]; float* out; unsigned char* ws; int ph_lo, ph_hi; unsigned dup, pad; };
struct Frame {
    LAS unsigned char* lds;
    int tid, lane, wave, G, vcu;
    unsigned char* ws; unsigned char* ob;
};
enum { I_X = 0, I_MEM, I_POOL_W, I_POOL_SCALE, I_RG_W_IN, I_RG_CONV_W, I_RG_CONV_B, I_RG_W_GATE, I_RG_B_GATE, I_RG_LAMBDA, I_RG_W_OUT, I_XA_WQ, I_XA_WKV, I_XA_WO,
       I_MOE_WG, I_MOE_BG, I_MOE_WE, I_MOE_BE, I_MOE_W_GU, I_MOE_W_DOWN, I_NORM_MIX, I_NORM_XATTN, I_NORM_MEM, I_NORM_MOE, I_NORM_FINAL };

__device__ __forceinline__ void tr_item(const float* W, int ldw, int k0, int scol0, const float* gain, void* out, int ldo, int orow0, LAS float* scr, int lane, int f8 = 0, float scl = 1.0f) {
    f32x4 v[8];
    const int kq = lane >> 3, n4 = (lane & 7) * 4;
#pragma unroll
    for (int i = 0; i < 8; ++i) v[i] = *(const f32x4*)(W + (size_t)(k0 + 8 * i + kq) * ldw + scol0 + n4);
    if (gain) {
#pragma unroll
        for (int i = 0; i < 8; ++i) v[i] *= gain[k0 + 8 * i + kq] * scl;
    } else if (f8) {
#pragma unroll
        for (int i = 0; i < 8; ++i) v[i] *= scl;
    }
#pragma unroll
    for (int i = 0; i < 8; ++i) { LAS float* d = scr + (8 * i + kq) * 33 + n4; d[0] = v[i][0]; d[1] = v[i][1]; d[2] = v[i][2]; d[3] = v[i][3]; }
    LDS_WAIT(); asm volatile("" ::: "memory");
    const int c = lane & 7;
#pragma unroll
    for (int j = 0; j < 4; ++j) { const int n = (lane >> 3) + 8 * j; const LAS float* s = scr + (8 * c) * 33 + n;
        if (f8) { *(u32x2*)((unsigned char*)out + (size_t)(orow0 + n) * ldo + k0 + 8 * c) = pack8_fp8((f32x4){s[0 * 33], s[1 * 33], s[2 * 33], s[3 * 33]}, (f32x4){s[4 * 33], s[5 * 33], s[6 * 33], s[7 * 33]}); }
        else { u32x4 o; o.x = pk2(s[0 * 33], s[1 * 33]); o.y = pk2(s[2 * 33], s[3 * 33]); o.z = pk2(s[4 * 33], s[5 * 33]); o.w = pk2(s[6 * 33], s[7 * 33]);
            *(u32x4*)((bf16*)out + (size_t)(orow0 + n) * ldo + k0 + 8 * c) = o; } }
    LDS_WAIT(); asm volatile("" ::: "memory");
}
__device__ __forceinline__ void tr_job(int q, const float* W, int Kdim, int ldw, int NO, int mapmode, int mapoff, const float* gain, void* out, LAS float* scr, int lane, int f8 = 0, float scl = 1.0f) {
    const int nblk = NO / 32, kb = q / nblk, nb = q % nblk, n0 = 32 * nb;
    int sc = n0;
    if (mapmode) { const int tile = n0 >> 8, w = n0 & 255; sc = (w < 128) ? (128 * tile + w) : (mapoff + 128 * tile + (w - 128)); }
    tr_item(W, ldw, 64 * kb, sc, gain, out, Kdim, n0, scr, lane, f8, scl);
}
__device__ __forceinline__ float row_sumsq_f32(const float* row, int lane, f32x4 (&v)[4]) {
    const f32x4* xr = (const f32x4*)row + lane; float s = 0.f;
#pragma unroll
    for (int j = 0; j < 4; ++j) { v[j] = xr[64 * j]; s += (v[j][0] * v[j][0] + v[j][1] * v[j][1]) + (v[j][2] * v[j][2] + v[j][3] * v[j][3]); }
    return wave_sum(s);
}

__device__ __forceinline__ void phase_prologue(Frame& F, const Args& args) {
    LAS float* scr = (LAS float*)(F.lds + RING_OFF + F.wave * 16384);
    const int gw = F.vcu * 8 + F.wave, NGW = F.G * 8, lane = F.lane;
    unsigned char* ws = F.ws;
    const float* nmix = args.in[I_NORM_MIX]; const float* nxat = args.in[I_NORM_XATTN]; const float* nmem = args.in[I_NORM_MEM]; const float* nmoe = args.in[I_NORM_MOE];
    constexpr int J0 = 128, J1 = 1024, J2 = 256, J3 = 512, J4 = 2048, J5 = 1024, J6 = 16384, J7 = 8192;
    constexpr int NITEMS = J0 + J1 + J2 + J3 + J4 + J5 + J6 + J7;
    for (int it = gw; it < NITEMS; it += NGW) {
        int r = it;
        if (r < J0) { const int g = r / 32, q = r % 32; tr_job(q, args.in[I_POOL_W] + (size_t)g * 65536, 256, 256, 256, 0, 0, nullptr, (bf16*)(ws + WS_W_POOL) + (size_t)g * 65536, scr, lane); continue; } r -= J0;
        if (r < J1) { tr_job(r, args.in[I_RG_W_IN], 1024, 2048, 2048, 0, 0, nmix + 1024, (bf16*)(ws + WS_W_IN), scr, lane); continue; } r -= J1;
        if (r < J2) { const int h = r / 64, q = r % 64; tr_job(q, args.in[I_RG_W_GATE] + (size_t)h * 131072, 256, 512, 512, 1, 256, nullptr, (bf16*)(ws + WS_W_GATE) + (size_t)h * 131072, scr, lane); continue; } r -= J2;
        if (r < J3) { tr_job(r, args.in[I_RG_W_OUT], 1024, 1024, 1024, 0, 0, nullptr, (bf16*)(ws + WS_W_OUT), scr, lane); continue; } r -= J3;
        if (r < J4) { const int l = r / 1024, q = r % 1024; tr_job(q, args.in[I_XA_WKV] + (size_t)l * 2097152, 1024, 2048, 2048, 0, 0, nullptr, (bf16*)(ws + WS_W_KV) + (size_t)l * 2097152, scr, lane); continue; } r -= J4;
        if (r < J5) { const int l = r / 512, q = r % 512; tr_job(q, args.in[I_XA_WO] + (size_t)l * 1048576, 1024, 1024, 1024, 0, 0, nullptr, (bf16*)(ws + WS_W_OT) + (size_t)l * 1048576, scr, lane); continue; } r -= J5;
        if (r < J6) { const int le = r / 512, q = r % 512; tr_job(q, args.in[I_MOE_W_GU] + (size_t)le * 1048576, 1024, 1024, 1024, 1, 512, nmoe + (le >> 4) * 1024, (unsigned char*)(ws + WS_W_GU) + (size_t)le * 1048576, scr, lane, 1, W8_GU_SCALE); continue; } r -= J6;
        { const int le = r / 256, q = r % 256; tr_job(q, args.in[I_MOE_W_DOWN] + (size_t)le * 524288, 512, 1024, 1024, 0, 0, nullptr, (unsigned char*)(ws + WS_W_DOWN) + (size_t)le * 524288, scr, lane, 1, W8_DOWN_SCALE); }
    }
    constexpr int R_WQ = 2048, R_MEMN = 2 * NMR, R_WRB = 2 * 128, R_SPL = 1;
    constexpr int NROWS = R_WQ + R_MEMN + R_WRB + R_SPL;
    for (int it = gw; it < NROWS; it += NGW) {
        int r = it;
        if (r < R_WQ) {
            const int l = r >> 10, d = r & 1023; const float gsc = nxat[l * 1024 + d] * (LOG2E / 16.0f);
            const f32x4* src = (const f32x4*)(args.in[I_XA_WQ] + (size_t)r * 1024) + lane; u32x2* dst = (u32x2*)((bf16*)(ws + WS_W_Q) + (size_t)r * 1024) + lane;
#pragma unroll
            for (int j = 0; j < 4; ++j) { const f32x4 v = src[64 * j] * gsc; dst[64 * j] = (u32x2){pk2(v[0], v[1]), pk2(v[2], v[3])}; }
            continue; } r -= R_WQ;
        if (r < R_MEMN) {
            const int l = r / NMR, row = r % NMR; f32x4 v[4]; const float ss = row_sumsq_f32(args.in[I_MEM] + (size_t)row * 1024, lane, v);
            const float rs = __builtin_amdgcn_rsqf(ss * (1.0f / 1024.0f) + EPS);
            const f32x4* gp = (const f32x4*)(nmem + l * 1024) + lane; u32x2* dst = (u32x2*)((bf16*)(ws + WS_MEMN) + (size_t)r * 1024) + lane;
#pragma unroll
            for (int j = 0; j < 4; ++j) { const f32x4 o = v[j] * gp[64 * j] * rs; dst[64 * j] = (u32x2){pk2(o[0], o[1]), pk2(o[2], o[3])}; }
            continue; } r -= R_MEMN;
        if (r < R_WRB) {
            const int l = r >> 7, blk = r & 127;
            bf16* dst = (bf16*)(ws + WS_WRB) + (size_t)l * 65536 + blk * 512;
#pragma unroll
            for (int e8 = 0; e8 < 8; ++e8) { const int idx = blk * 512 + e8 * 64 + lane; const int jj = idx & 7, ln = (idx >> 3) & 63, ks = (idx >> 9) & 31, tl = idx >> 14;
                const int col = (tl & 1) * 16 + (ln & 15), d = 32 * ks + 8 * (ln >> 4) + jj;
                float w = 0.f;
                if (col < 4) w = args.in[I_MOE_WG][(size_t)l * 4096 + d * 4 + col];
                else if (col < 20) w = args.in[I_MOE_WE][(((size_t)l * 4 + ((col - 4) >> 2)) * 1024 + d) * 4 + ((col - 4) & 3)];
                w *= nmoe[l * 1024 + d];
                const unsigned hi = f2bf(w); const float lo = w - __builtin_bit_cast(float, hi << 16);
                dst[e8 * 64 + lane] = (bf16)((tl < 2) ? hi : f2bf(lo)); }
            continue; } r -= R_WRB;
        {
#pragma unroll
            for (int j = 0; j < 16; ++j) { const int c = j * 64 + lane; const float lam = args.in[I_RG_LAMBDA][c]; const float z = -lam;
                ((float*)(ws + WS_SPL))[c] = (z > 20.f) ? z : log1pf(expf(z)); }
        }
    }
}

template <int W> __device__ __forceinline__ void pool_step(f32x4 (&hist)[W], f32x4& sum, const f32x4 cur, const int i, const int cnt_s, const f32x4 gm, u32x2* dst) {
    sum += cur; const int cnt = cnt_s < W ? cnt_s : W; const f32x4 p = (sum * (1.0f / (float)cnt) - cur) * gm; *dst = (u32x2){pk2(p[0], p[1]), pk2(p[2], p[3])};
    hist[i % W] = cur; sum -= hist[(i + 1) % W];
}
constexpr int PBR = 2;
__device__ __forceinline__ void pool_loadn(const float* __restrict__ xb, int s, int nrow, f32x4 (&v)[PBR][4]) {
#pragma unroll
    for (int r = 0; r < PBR; ++r) if (r < nrow) {
        if (s + r >= 0) {
#pragma unroll
            for (int g = 0; g < 4; ++g) v[r][g] = *(const f32x4*)(xb + (size_t)(s + r) * D + g * 256);
        } else {
#pragma unroll
            for (int g = 0; g < 4; ++g) v[r][g] = (f32x4){0.f, 0.f, 0.f, 0.f};
        } }
#pragma unroll
    for (int r = 0; r < PBR; ++r) if (r < nrow) { float ss = 0.f;
#pragma unroll
        for (int g = 0; g < 4; ++g) ss += (v[r][g][0] * v[r][g][0] + v[r][g][1] * v[r][g][1]) + (v[r][g][2] * v[r][g][2] + v[r][g][3] * v[r][g][3]);
        const float rs = __builtin_amdgcn_rsqf(wave_sum(ss) * (1.0f / 1024.0f) + EPS);
#pragma unroll
        for (int g = 0; g < 4; ++g) v[r][g] *= rs; }
}
__device__ __forceinline__ void pool_run(const float* __restrict__ xb, bf16* __restrict__ prow, const int s0, const f32x4 (&gm)[4], const int lane) {
    f32x4 h0[2], h1[4], h2[8], h3[16], sum[4];
#pragma unroll
    for (int g = 0; g < 4; ++g) sum[g] = (f32x4){0.f, 0.f, 0.f, 0.f};
#pragma unroll
    for (int jb = 15; jb >= 1; jb -= PBR) { const int nrow = jb >= PBR ? PBR : jb; f32x4 v[PBR][4]; pool_loadn(xb, s0 - jb, nrow, v);
#pragma unroll
        for (int r = 0; r < PBR; ++r) if (r < nrow) { const int j = jb - r;
            if (j < 2) { h0[(16 - j) % 2] = v[r][0]; sum[0] += v[r][0]; }
            if (j < 4) { h1[(16 - j) % 4] = v[r][1]; sum[1] += v[r][1]; }
            if (j < 8) { h2[(16 - j) % 8] = v[r][2]; sum[2] += v[r][2]; }
            { h3[(16 - j) % 16] = v[r][3]; sum[3] += v[r][3]; } } }
#pragma unroll
    for (int ib = 0; ib < 16; ib += PBR) { f32x4 v[PBR][4]; pool_loadn(xb, s0 + ib, PBR, v);
#pragma unroll
        for (int r = 0; r < PBR; ++r) { const int i = ib + r, s = s0 + i; u32x2* dst = (u32x2*)(prow + (size_t)i * D) + lane;
            pool_step<2>(h0, sum[0], v[r][0], i, s + 1, gm[0], dst);
            pool_step<4>(h1, sum[1], v[r][1], i, s + 1, gm[1], dst + 64);
            pool_step<8>(h2, sum[2], v[r][2], i, s + 1, gm[2], dst + 128);
            pool_step<16>(h3, sum[3], v[r][3], i, s + 1, gm[3], dst + 192); } }
}
__device__ __forceinline__ void phase_pool_p(Frame& F, const Args& args) {
    const int gw = F.vcu * 8 + F.wave, NGW = F.G * 8, lane = F.lane;
    bf16* P0 = (bf16*)(F.ob + OB_P0);
    f32x4 gm[4];
#pragma unroll
    for (int g = 0; g < 4; ++g) gm[g] = *(const f32x4*)(args.in[I_NORM_MIX] + g * 256 + 4 * lane);
    for (int it = gw; it < NB * (SEQ / 16); it += NGW) {
        const int b = it >> 7, s0 = (it & 127) * 16;
        pool_run(args.in[I_X] + (size_t)b * SEQ * D + 4 * lane, P0 + ((size_t)b * SEQ + s0) * D, s0, gm, lane);
    }
}

struct SchedKV {
    int G, c; const char* A; const char* B; char* Kb; char* Vb;
    __device__ __forceinline__ bool next(int i, pg8::Unit& u) const { int pm, pn; if (!pg8::tile_of(i, G, c, 32, 8, pm, pn)) return false;
        const int l = pm >> 4; u.A = A + (size_t)pm * 256 * 2048; u.B = B + (size_t)l * 4194304 + (size_t)pn * 256 * 2048;
        u.C = ((pn < 4) ? Kb : Vb) + ((size_t)l * 4096 + (size_t)(pm & 15) * 256) * 2048 + (size_t)(pn & 3) * 512; u.row0 = pm * 256; u.col0 = pn * 256; u.aux = i; return true; }
};
struct SchedMVW {
    int G, c; const char* Kl; const char* Vl; const char* Wq; const char* Wot; char* BS; char* BO;
    __device__ __forceinline__ bool next(int i, pg8::Unit& u) const { int pm, pn; if (!pg8::tile_of(i, G, c, 128, 4, pm, pn)) return false;
        const int kind = pm >> 6, bh = pm & 63, b = bh >> 2, h = bh & 3;
        if (kind == 0) { u.A = Kl + ((size_t)b * 256) * 2048 + h * 512; u.B = Wq + ((size_t)pn * 256) * 2048 + h * 512; u.C = BS + (size_t)b * 2097152 + ((size_t)h * 256) * 2048 + pn * 512; }
        else { u.A = Wot + ((size_t)pn * 256) * 2048 + h * 512; u.B = Vl + ((size_t)b * 256) * 2048 + h * 512; u.C = BO + (size_t)b * 2097152 + ((size_t)pn * 256) * 2048 + h * 512; }
        u.row0 = 0; u.col0 = 0; u.aux = i; return true; }
};
struct SchedDense {
    int G, c, nN; const char* A; size_t apan; size_t acol; int adiv; const char* B; size_t bpn; size_t bbatch; int cmul;
    __device__ __forceinline__ bool next(int i, pg8::Unit& u) const { int pm, pn; if (!pg8::tile_of(i, G, c, NTOK / 256, nN, pm, pn)) return false;
        u.A = A + (size_t)pm * apan + (size_t)(pn / adiv) * acol; u.B = B + (size_t)pn * bpn + (size_t)(pm >> 3) * bbatch; u.C = nullptr; u.row0 = pm * 256; u.col0 = pn * cmul; u.aux = i; return true; }
};
struct SchedMoE {
    int G, c, nT; int tpre[17]; const char* A; size_t atile; const char* B; size_t bexp, bpn;
    __device__ __forceinline__ int expert_of(int tile) const { int e = 0;
#pragma unroll
        for (int k = 1; k < 16; ++k) e += (tile >= tpre[k]) ? 1 : 0;
        return e; }
    __device__ __forceinline__ int first_tile(int e) const { int t = 0;
#pragma unroll
        for (int k = 1; k < 16; ++k) t = (k == e) ? tpre[k] : t;
        return t; }
    __device__ __forceinline__ bool next(int i, pg8::Unit& u) const { int tile, pn; if (!pg8::tile_of(i, G, c, nT, 4, tile, pn)) return false;
        const int e = expert_of(tile);
        u.A = A + (size_t)tile * atile; u.B = B + (size_t)e * bexp + (size_t)pn * bpn; u.C = nullptr; u.row0 = tile * 256; u.col0 = pn * 256; u.aux = i; return true; }
};
__device__ __forceinline__ void moe_sched_init(SchedMoE& S, Frame& F, int l) {
    const unsigned* cnt = (const unsigned*)(F.ws + WS_CTL) + CW_CNT + l * 16 * 64;
    unsigned n[16];
#pragma unroll
    for (int e = 0; e < 16; ++e) n[e] = __hip_atomic_load(cnt + e * 64, __ATOMIC_RELAXED, __HIP_MEMORY_SCOPE_AGENT);
    int acc = 0;
#pragma unroll
    for (int e = 0; e < 16; ++e) { S.tpre[e] = acc; acc += ((int)__builtin_amdgcn_readfirstlane(n[e]) + 255) >> 8; }
    S.tpre[16] = acc; S.nT = acc; S.G = F.G; S.c = (int)blockIdx.x;
}
__device__ __forceinline__ void moe_fill_tables(const SchedMoE& S, Frame& F, int l, int mode) {
    const int* list = (const int*)(F.ws + WS_LIST); const float* rstd = (const float*)(F.ws + WS_RSTD_B); const float* gwv = (const float*)(F.ws + WS_GW);
    LAS int* tab = (LAS int*)(F.lds + TAB_OFF); LAS float* tab2 = (LAS float*)(F.lds + TAB2_OFF);
    const unsigned* cntp = (const unsigned*)(F.ws + WS_CTL) + CW_CNT + l * 16 * 64;
    if (F.tid < 256) {
        unsigned n[16];
#pragma unroll
        for (int e = 0; e < 16; ++e) n[e] = __hip_atomic_load(cntp + e * 64, __ATOMIC_RELAXED, __HIP_MEMORY_SCOPE_AGENT);
        int slot[MAXU]; bool valid[MAXU]; bool have[MAXU]; float aux[MAXU];
#pragma unroll
        for (int j = 0; j < MAXU; ++j) { pg8::Unit u; have[j] = S.next(j, u); slot[j] = 0; valid[j] = false;
            if (have[j]) { const int tile = u.row0 >> 8, e = S.expert_of(tile), tl = tile - S.first_tile(e), pos = tl * 256 + F.tid; int ne = (int)n[0];
#pragma unroll
                for (int k = 1; k < 16; ++k) ne = (k == e) ? (int)n[k] : ne;
                valid[j] = pos < ne;
                slot[j] = list[(size_t)e * NTOK + (valid[j] ? pos : 0)]; } }
#pragma unroll
        for (int j = 0; j < MAXU; ++j) { aux[j] = 0.f; if (have[j]) aux[j] = (mode == 0) ? rstd[slot[j] >> 1] : gwv[slot[j]]; }
#pragma unroll
        for (int j = 0; j < MAXU; ++j) if (have[j]) { tab[j * 256 + F.tid] = (mode == 0) ? (slot[j] >> 1) : (valid[j] ? slot[j] : -1); tab2[j * 256 + F.tid] = aux[j]; }
    }
    __syncthreads();
}

template <class Sched> __device__ __forceinline__ void fill_row_scale(const Sched& S, Frame& F, const float* src, int mode) {
    LAS float* tab2 = (LAS float*)(F.lds + TAB2_OFF);
    if (F.tid < 256) {
#pragma unroll
        for (int j = 0; j < MAXU; ++j) { pg8::Unit u; if (S.next(j, u)) { const int row = u.row0 + F.tid; float r;
            if (mode == 0) { const f32x4* sp = (const f32x4*)(src + (size_t)row * 16); const f32x4 qs = (sp[0] + sp[1]) + (sp[2] + sp[3]); r = __builtin_amdgcn_rsqf(((qs[0] + qs[1]) + (qs[2] + qs[3])) * (1.0f / 1024.0f) + EPS); }
            else r = src[row];
            tab2[j * 256 + F.tid] = r; } }
    }
    __syncthreads();
}

__device__ __forceinline__ void phase_router(Frame& F, const Args& args, int l, const bf16* H) {
    { const u32x4* src = (const u32x4*)(F.ws + WS_WRB + (size_t)l * 131072); LAS u32x4* dst = (LAS u32x4*)(F.lds + RING_OFF);
      u32x4 t[16];
#pragma unroll
      for (int i = 0; i < 16; ++i) t[i] = src[F.tid + 512 * i];
#pragma unroll
      for (int i = 0; i < 16; ++i) dst[F.tid + 512 * i] = t[i]; }
    __syncthreads();
    LAS float* lgs = (LAS float*)(F.lds + TAB_OFF) + F.wave * 336;
    LAS int* sel_e = (LAS int*)(F.lds + XCH_OFF); LAS float* sel_w = (LAS float*)(F.lds + XCH_OFF + 1024);
    LAS int* lcnt = (LAS int*)(F.lds + XCH_OFF + 2048); LAS int* lbase = lcnt + 16; LAS int* rnk = (LAS int*)(F.lds + XCH_OFF + 3072);
    unsigned* gcnt = (unsigned*)(F.ws + WS_CTL) + CW_CNT + l * 16 * 64;
    int* list = (int*)(F.ws + WS_LIST); float* gwv = (float*)(F.ws + WS_GW); float* rstd = (float*)(F.ws + WS_RSTD_B);
    const float* bg = args.in[I_MOE_BG] + l * 4; const float* be = args.in[I_MOE_BE] + l * 16;
    const int lane = F.lane, fr = lane & 15, fq = lane >> 4;
    for (int tb = F.vcu; tb < NTOK / 128; tb += F.G) {
        const int t0 = tb * 128 + F.wave * 16;
        const bf16* hp = H + (size_t)(t0 + fr) * 1024 + 8 * fq;
        f32x4 acc0 = {0.f, 0.f, 0.f, 0.f}, acc1 = {0.f, 0.f, 0.f, 0.f}; float ssq = 0.f;
        if (F.tid < 16) lcnt[F.tid] = 0;
#pragma unroll 16
        for (int ks = 0; ks < 32; ++ks) {
            const u32x4 av = *(const u32x4*)(hp + ks * 32);
            f32x4 x0, x1; unpack8(av, x0, x1); ssq += (x0[0] * x0[0] + x0[1] * x0[1]) + (x0[2] * x0[2] + x0[3] * x0[3]) + (x1[0] * x1[0] + x1[1] * x1[1]) + (x1[2] * x1[2] + x1[3] * x1[3]);
            const bf16x8 a = __builtin_bit_cast(bf16x8, av);
            const LAS bf16x8* bp = (const LAS bf16x8*)(F.lds + RING_OFF) + ks * 64 + lane;
            const bf16x8 b0 = bp[0], b1 = bp[2048], b2 = bp[4096], b3 = bp[6144];
            acc0 = __builtin_amdgcn_mfma_f32_16x16x32_bf16(a, b0, acc0, 0, 0, 0); acc0 = __builtin_amdgcn_mfma_f32_16x16x32_bf16(a, b2, acc0, 0, 0, 0);
            acc1 = __builtin_amdgcn_mfma_f32_16x16x32_bf16(a, b1, acc1, 0, 0, 0); acc1 = __builtin_amdgcn_mfma_f32_16x16x32_bf16(a, b3, acc1, 0, 0, 0);
        }
        ssq += __shfl_xor(ssq, 16); ssq += __shfl_xor(ssq, 32);
#pragma unroll
        for (int rg = 0; rg < 4; ++rg) { lgs[(4 * fq + rg) * 21 + fr] = acc0[rg]; if (fr < 4) lgs[(4 * fq + rg) * 21 + 16 + fr] = acc1[rg]; }
        LDS_WAIT(); asm volatile("" ::: "memory");
        if (lane < 16) {
            const float rs = __builtin_amdgcn_rsqf(ssq * (1.0f / 1024.0f) + EPS);
            const LAS float* lg = lgs + lane * 21;
            float g0 = lg[0] * rs + bg[0], g1 = lg[1] * rs + bg[1], g2 = lg[2] * rs + bg[2], g3 = lg[3] * rs + bg[3];
            int g = 0; float gm = g0; if (g1 > gm) { gm = g1; g = 1; } if (g2 > gm) { gm = g2; g = 2; } if (g3 > gm) { gm = g3; g = 3; }
            const float gp = 1.0f / (expf(g0 - gm) + expf(g1 - gm) + expf(g2 - gm) + expf(g3 - gm));
            float le[4];
#pragma unroll
            for (int k = 0; k < 4; ++k) le[k] = lg[4 + 4 * g + k] * rs + be[4 * g + k];
            int e1 = 0; float m1 = le[0];
#pragma unroll
            for (int k = 1; k < 4; ++k) if (le[k] > m1) { m1 = le[k]; e1 = k; }
            int e2 = -1; float m2 = -3.0e38f;
#pragma unroll
            for (int k = 0; k < 4; ++k) if (k != e1 && le[k] > m2) { m2 = le[k]; e2 = k; }
            const float z = expf(m2 - m1); const float q1 = 1.0f / (1.0f + z), q2 = z * q1;
            const int tl = F.wave * 16 + lane;
            sel_e[2 * tl] = 4 * g + e1; sel_e[2 * tl + 1] = 4 * g + e2; sel_w[2 * tl] = gp * q1; sel_w[2 * tl + 1] = gp * q2;
            rstd[t0 + lane] = rs;
        }
        __syncthreads();
        int my_e = 0;
        if (F.tid < 256) { my_e = sel_e[F.tid]; rnk[F.tid] = __hip_atomic_fetch_add(&lcnt[my_e], 1, __ATOMIC_RELAXED, __HIP_MEMORY_SCOPE_WORKGROUP); }
        __syncthreads();
        if (F.tid < 16) { const int n = lcnt[F.tid]; lbase[F.tid] = n ? (int)__hip_atomic_fetch_add(gcnt + F.tid * 64, (unsigned)n, __ATOMIC_RELAXED, __HIP_MEMORY_SCOPE_AGENT) : 0; }
        __syncthreads();
        if (F.tid < 256) { const int pos = lbase[my_e] + rnk[F.tid]; const int slot = tb * 256 + F.tid; list[(size_t)my_e * NTOK + pos] = slot; gwv[slot] = sel_w[F.tid]; }
        __syncthreads();
    }
}

__device__ __forceinline__ void phase_combine(Frame& F, const Args& args, int mode, const bf16* H, bf16* Hout, float* outf) {
    const int gw = F.vcu * 8 + F.wave, NGW = F.G * 8, lane = F.lane;
    const bf16* Y = (const bf16*)(F.ws + WS_Y); float* rstd = (float*)(F.ws + WS_RSTD_A);
    f32x4 gf[4];
    if (mode == 1) {
#pragma unroll
        for (int hf = 0; hf < 2; ++hf) { gf[2 * hf] = *(const f32x4*)(args.in[I_NORM_FINAL] + hf * 512 + 8 * lane); gf[2 * hf + 1] = *(const f32x4*)(args.in[I_NORM_FINAL] + hf * 512 + 8 * lane + 4); }
    }
    for (int t0 = gw; t0 < NTOK; t0 += 2 * NGW) {
        u32x4 hv[2][2], y0[2][2], y1[2][2];
#pragma unroll
        for (int q = 0; q < 2; ++q) { const int t = (t0 + q * NGW < NTOK) ? t0 + q * NGW : t0;
#pragma unroll
            for (int hf = 0; hf < 2; ++hf) { const size_t off = hf * 512 + 8 * lane;
                hv[q][hf] = *(const u32x4*)(H + (size_t)t * 1024 + off); y0[q][hf] = *(const u32x4*)(Y + (size_t)(2 * t) * 1024 + off); y1[q][hf] = *(const u32x4*)(Y + (size_t)(2 * t + 1) * 1024 + off); } }
#pragma unroll
        for (int q = 0; q < 2; ++q) { const int t = t0 + q * NGW; if (t >= NTOK) break;
            f32x4 v[4]; float ss = 0.f;
#pragma unroll
            for (int hf = 0; hf < 2; ++hf) {
                f32x4 a, b, c, d, e, f; unpack8(hv[q][hf], a, b); unpack8(y0[q][hf], c, d); unpack8(y1[q][hf], e, f); a += c + e; b += d + f; v[2 * hf] = a; v[2 * hf + 1] = b;
                ss += (a[0] * a[0] + a[1] * a[1]) + (a[2] * a[2] + a[3] * a[3]) + (b[0] * b[0] + b[1] * b[1]) + (b[2] * b[2] + b[3] * b[3]); }
            ss = wave_sum(ss);
            const float rs = __builtin_amdgcn_rsqf(ss * (1.0f / 1024.0f) + EPS);
            if (mode == 0) {
#pragma unroll
                for (int hf = 0; hf < 2; ++hf) *(u32x4*)(Hout + (size_t)t * 1024 + hf * 512 + 8 * lane) = pack8(v[2 * hf], v[2 * hf + 1]);
                if (lane == 0) rstd[t] = rs;
            } else {
#pragma unroll
                for (int hf = 0; hf < 2; ++hf) { float* op = outf + (size_t)t * 1024 + hf * 512 + 8 * lane; *(f32x4*)op = v[2 * hf] * gf[2 * hf] * rs; *(f32x4*)(op + 4) = v[2 * hf + 1] * gf[2 * hf + 1] * rs; }
            }
        }
    }
}

__device__ __forceinline__ void phase_conv(Frame& F, const Args& args, const bf16* XB, bf16* XC) {
    const int gw = F.vcu * 8 + F.wave, NGW = F.G * 8, lane = F.lane;
    const float* cw = args.in[I_RG_CONV_W]; const float* cbv = args.in[I_RG_CONV_B];
    for (int hf = 0; hf < 2; ++hf) {
        const int c0 = hf * 512 + 8 * lane;
        f32x4 w[4][2], cb[2];
#pragma unroll
        for (int k = 0; k < 4; ++k) { w[k][0] = *(const f32x4*)(cw + k * 1024 + c0); w[k][1] = *(const f32x4*)(cw + k * 1024 + c0 + 4); }
        cb[0] = *(const f32x4*)(cbv + c0); cb[1] = *(const f32x4*)(cbv + c0 + 4);
        for (int it = gw; it < NB * (SEQ / 16); it += NGW) {
            const int b = it >> 7, s0 = (it & 127) * 16; const bf16* xp = XB + (size_t)b * SEQ * D + c0; bf16* op = XC + (size_t)b * SEQ * D + c0;
            f32x4 xm[3][2];
#pragma unroll
            for (int j = 0; j < 3; ++j) { const int s = s0 - 3 + j; if (s >= 0) { const u32x4 v = *(const u32x4*)(xp + (size_t)s * D); unpack8(v, xm[j][0], xm[j][1]); } else { xm[j][0] = (f32x4){0.f, 0.f, 0.f, 0.f}; xm[j][1] = xm[j][0]; } }
#pragma unroll 4
            for (int s = s0; s < s0 + 16; ++s) { const u32x4 v = *(const u32x4*)(xp + (size_t)s * D); f32x4 x0, x1; unpack8(v, x0, x1);
                const f32x4 o0 = cb[0] + w[0][0] * xm[0][0] + w[1][0] * xm[1][0] + w[2][0] * xm[2][0] + w[3][0] * x0;
                const f32x4 o1 = cb[1] + w[0][1] * xm[0][1] + w[1][1] * xm[1][1] + w[2][1] * xm[2][1] + w[3][1] * x1;
                *(u32x4*)(op + (size_t)s * D) = pack8(o0, o1);
                xm[0][0] = xm[1][0]; xm[0][1] = xm[1][1]; xm[1][0] = xm[2][0]; xm[1][1] = xm[2][1]; xm[2][0] = x0; xm[2][1] = x1; }
        }
    }
}

constexpr int NSEG = 16, SEGL = SEQ / NSEG;
__device__ __forceinline__ void phase_scan1(Frame& F) {
    const int gw = F.vcu * 8 + F.wave, NGW = F.G * 8, lane = F.lane;
    const bf16* LA = (const bf16*)(F.ob + OB_LOGA); const bf16* BT = (const bf16*)(F.ob + OB_BT);
    float* AGS = (float*)(F.ws + WS_AGS); float* AGB = (float*)(F.ws + WS_AGB);
    for (int it = gw; it < NB * NSEG * 8; it += NGW) {
        const int cg = it & 7, sg = (it >> 3) & (NSEG - 1), b = it >> 7; const int ch = cg * 128 + 2 * lane;
        const size_t r0 = ((size_t)b * SEQ + sg * SEGL) * D + ch;
        float h0 = 0.f, h1 = 0.f, s0 = 0.f, s1 = 0.f;
#pragma unroll 16
        for (int s = 0; s < SEGL; ++s) { const unsigned lv = *(const unsigned*)(LA + r0 + (size_t)s * D), bv = *(const unsigned*)(BT + r0 + (size_t)s * D);
            const float l0 = bflo(lv), l1 = bfhi(lv); s0 += l0; s1 += l1;
            h0 = fast_exp2(l0 * LOG2E) * h0 + bflo(bv); h1 = fast_exp2(l1 * LOG2E) * h1 + bfhi(bv); }
        const size_t ao = ((size_t)b * NSEG + sg) * 1024 + ch;
        *(f32x2*)(AGS + ao) = (f32x2){s0, s1}; *(f32x2*)(AGB + ao) = (f32x2){h0, h1};
    }
}
__device__ __forceinline__ void scan2_item(const bf16* __restrict__ LA, const bf16* __restrict__ BT, const bf16* __restrict__ GATE, bf16* __restrict__ YRG, const float* __restrict__ AGS, const float* __restrict__ AGB, int it, int lane) {
    const int cg = it & 7, sg = (it >> 3) & (NSEG - 1), b = it >> 7; const int ch = cg * 128 + 2 * lane;
    f32x2 as[NSEG - 1], ab[NSEG - 1];
#pragma unroll
    for (int c = 0; c < NSEG - 1; ++c) { const size_t ao = ((size_t)b * NSEG + c) * 1024 + ch; as[c] = *(const f32x2*)(AGS + ao); ab[c] = *(const f32x2*)(AGB + ao); }
    float h0 = 0.f, h1 = 0.f;
#pragma unroll
    for (int c = 0; c < NSEG - 1; ++c) if (c < sg) { h0 = fast_exp2(as[c].x * LOG2E) * h0 + ab[c].x; h1 = fast_exp2(as[c].y * LOG2E) * h1 + ab[c].y; }
    const size_t r0 = ((size_t)b * SEQ + sg * SEGL) * D + ch;
#pragma nounroll
    for (int sb = 0; sb < SEGL; sb += 16) {
        unsigned lv[16], bv[16], gv[16];
#pragma unroll
        for (int k = 0; k < 16; ++k) { const size_t o = r0 + (size_t)(sb + k) * D; lv[k] = *(const unsigned*)(LA + o); bv[k] = *(const unsigned*)(BT + o); gv[k] = *(const unsigned*)(GATE + o); }
#pragma unroll
        for (int k = 0; k < 16; ++k) { h0 = fast_exp2(bflo(lv[k]) * LOG2E) * h0 + bflo(bv[k]); h1 = fast_exp2(bfhi(lv[k]) * LOG2E) * h1 + bfhi(bv[k]);
            *(unsigned*)(YRG + r0 + (size_t)(sb + k) * D) = cvt_pk_bf16(h0 * bflo(gv[k]), h1 * bfhi(gv[k])); }
    }
}
__device__ __forceinline__ void phase_scan2(Frame& F, const bf16* GATE, bf16* YRG) {
    const int gw = F.vcu * 8 + F.wave, NGW = F.G * 8;
    for (int it = gw; it < NB * NSEG * 8; it += NGW)
        scan2_item((const bf16*)(F.ob + OB_LOGA), (const bf16*)(F.ob + OB_BT), GATE, YRG, (const float*)(F.ws + WS_AGS), (const float*)(F.ws + WS_AGB), it, F.lane);
}

#if MK_PER_PHASE
#define GRID_BAR() do { } while (0)
#else
#if MK_TSEL >= 0
#define GRID_BAR() do { volatile LAS unsigned* _m = (volatile LAS unsigned*)(F.lds + MISC_OFF); const unsigned _t0 = (unsigned)__builtin_amdgcn_s_memrealtime(); xcd_barrier(bar); \
    if (threadIdx.x == 0) { const unsigned _k = _m[16]; const unsigned _t1 = (unsigned)__builtin_amdgcn_s_memrealtime(); if ((int)_k == MK_TSEL && !MK_GMODE) _m[18] = MK_TWAIT ? (_t1 - _t0) : (_t0 - _m[17]); _m[17] = _t1; _m[16] = _k + 1u; } } while (0)
#else
#define GRID_BAR() xcd_barrier(bar)
#endif
#endif
#ifndef MK_MASK
#define MK_MASK 0x1fffffu
#endif
#define IN(k) ((((MK_MASK) >> (k)) & 1u) && lo <= (k) && (k) < hi)
#define SEAM(k) do { if (lo <= (k) + 1 && (k) + 1 < hi) GRID_BAR(); } while (0)
#ifndef MK_DUP
#define MK_DUP 0u
#endif

template <int L>
__device__ __forceinline__ void mvw_gemm(Frame& F) {
    unsigned char* ws = F.ws;
    SchedMVW S{F.G, (int)blockIdx.x, (const char*)(ws + WS_K) + (size_t)L * 8388608, (const char*)(ws + WS_V) + (size_t)L * 8388608,
               (const char*)(ws + WS_W_Q) + (size_t)L * 2097152, (const char*)(ws + WS_W_OT) + (size_t)L * 2097152, (char*)(ws + WS_BS), (char*)(ws + WS_BO)};
    pg8::EpiPlain E{1024};
    pg8::gemm_phase<pg8::EpiPlain, SchedMVW, false>(F.lds + RING_OFF, 256, 2048u, 2048u, S, E, (LAS int*)(F.lds + TAB_OFF));
}
template <int L>
__device__ __forceinline__ void layer_phases(Frame& F, const Args& args, const XcdBarrier& bar, const int lo, const int hi) {
    unsigned char* ws = F.ws;
    LAS int* tab = (LAS int*)(F.lds + TAB_OFF); LAS float* tab2 = (LAS float*)(F.lds + TAB2_OFF);
    float* ss16 = (float*)(ws + WS_SS16);
    constexpr int ps = (L == 0) ? 3 : 15;
    if constexpr (L == 0) {
        if (IN(2)) {
            mvw_gemm<0>(F);
            SchedDense S{F.G, (int)blockIdx.x, 4, (const char*)(F.ob + OB_P0), (size_t)256 * 2048, (size_t)512, 1, (const char*)(ws + WS_W_POOL), (size_t)131072, 0, 256};
            pg8::EpiPool E{args.in[I_X], args.in[I_POOL_SCALE], (bf16*)(ws + WS_HA), ss16};
            pg8::gemm_phase<pg8::EpiPool, SchedDense, false>(F.lds + RING_OFF, 256, 2048u, 512u, S, E, tab);
            SEAM(2);
        }
    } else {
        const bf16* h3 = (const bf16*)(ws + WS_HA);
        bf16* XB = (bf16*)(ws + WS_HB); bf16* GATE = (bf16*)(ws + WS_Y); bf16* XC = (bf16*)(ws + WS_Y + 64 * MiB); bf16* YRG = (bf16*)(ws + WS_HB); bf16* HC = (bf16*)(ws + WS_Y);
        if (IN(9)) {
            SchedDense S{F.G, (int)blockIdx.x, 8, (const char*)h3, (size_t)256 * 2048, 0, 1, (const char*)(ws + WS_W_IN), (size_t)256 * 2048, 0, 256};
            fill_row_scale(S, F, (const float*)(ws + WS_RSTD_A), 1);
            pg8::EpiIn E{XB, GATE, tab2};
            pg8::gemm_phase<pg8::EpiIn, SchedDense, false>(F.lds + RING_OFF, 1024, 2048u, 2048u, S, E, tab);
            SEAM(9);
        }
        if (IN(10)) { phase_conv(F, args, XB, XC); SEAM(10); }
        if (IN(11)) {
            SchedDense S{F.G, (int)blockIdx.x, 8, (const char*)XC, (size_t)256 * 2048, (size_t)512, 2, (const char*)(ws + WS_W_GATE), (size_t)131072, 0, 128};
            pg8::EpiGates E{XC, (bf16*)(F.ob + OB_LOGA), (bf16*)(F.ob + OB_BT), args.in[I_RG_B_GATE], (const float*)(ws + WS_SPL)};
            pg8::gemm_phase<pg8::EpiGates, SchedDense, false>(F.lds + RING_OFF, 256, 2048u, 512u, S, E, tab);
            SEAM(11);
        }
        if (IN(12)) { phase_scan1(F); SEAM(12); }
        if (IN(13)) { phase_scan2(F, GATE, YRG); SEAM(13); }
        if (IN(14)) {
            SchedDense S{F.G, (int)blockIdx.x, 4, (const char*)YRG, (size_t)256 * 2048, 0, 1, (const char*)(ws + WS_W_OUT), (size_t)256 * 2048, 0, 256};
            pg8::EpiRes<true> E{h3, HC, ss16, nullptr};
            pg8::gemm_phase<pg8::EpiRes<true>, SchedDense, false>(F.lds + RING_OFF, 1024, 2048u, 2048u, S, E, tab);
            SEAM(14);
        }
    }
    const bf16* hmix = (L == 0) ? (const bf16*)(ws + WS_HA) : (const bf16*)(ws + WS_Y);
    bf16* hatt = (L == 0) ? (bf16*)(ws + WS_HB) : (bf16*)(ws + WS_HA);
    bf16* PATT = (bf16*)(F.ob + OB_PATT);
    if (IN(ps)) {
        SchedDense S{F.G, (int)blockIdx.x, 4, (const char*)hmix, (size_t)256 * 2048, 0, 1, (const char*)(ws + WS_BS), (size_t)256 * 2048, (size_t)2097152, 256};
        fill_row_scale(S, F, ss16, 0);
        pg8::EpiS E{PATT, tab2, (LAS f32x2*)(F.lds + XCH_OFF)};
        pg8::gemm_phase<pg8::EpiS, SchedDense, false>(F.lds + RING_OFF, 1024, 2048u, 2048u, S, E, tab);
        SEAM(ps);
    }
    if (IN(ps + 1)) {
        SchedDense S{F.G, (int)blockIdx.x, 4, (const char*)PATT, (size_t)256 * 2048, 0, 1, (const char*)(ws + WS_BO), (size_t)256 * 2048, (size_t)2097152, 256};
        pg8::EpiRes<false> E{hmix, hatt, ss16, (unsigned char*)(ws + WS_H8)};
        pg8::gemm_phase<pg8::EpiRes<false>, SchedDense, false>(F.lds + RING_OFF, 1024, 2048u, 2048u, S, E, tab);
        SEAM(ps + 1);
    }
    if (IN(ps + 2)) {
        phase_router(F, args, L, hatt);
        if constexpr (L == 0) { __syncthreads(); mvw_gemm<1>(F); }
        SEAM(ps + 2);
    }
    if (IN(ps + 3)) {
        SchedMoE S; moe_sched_init(S, F, L); S.A = (const char*)(ws + WS_H8); S.atile = 0; S.B = (const char*)(ws + WS_W_GU) + (size_t)L * 16777216; S.bexp = 1048576; S.bpn = (size_t)256 * 1024;
        moe_fill_tables(S, F, L, 0);
        pg8::EpiGU E{(unsigned char*)(F.ob + OB_HMID), tab2};
        pg8::gemm_phase<pg8::EpiGU, SchedMoE, true, true>(F.lds + RING_OFF, 1024, 1024u, 1024u, S, E, tab);
        SEAM(ps + 3);
    }
    if (IN(ps + 4)) {
        SchedMoE S; moe_sched_init(S, F, L); S.A = (const char*)(F.ob + OB_HMID); S.atile = (size_t)256 * 512; S.B = (const char*)(ws + WS_W_DOWN) + (size_t)L * 8388608; S.bexp = 524288; S.bpn = (size_t)256 * 512;
        moe_fill_tables(S, F, L, 1);
        pg8::EpiDown E{(bf16*)(ws + WS_Y), tab, tab2};
        pg8::gemm_phase<pg8::EpiDown, SchedMoE, false, true>(F.lds + RING_OFF, 512, 512u, 512u, S, E, tab);
        SEAM(ps + 4);
    }
    if (IN(ps + 5)) {
        if constexpr (L == 0) { phase_combine(F, args, 0, hatt, (bf16*)(ws + WS_HA), nullptr); SEAM(ps + 5); }
        else phase_combine(F, args, 1, hatt, nullptr, args.out);
    }
}

__global__ void __launch_bounds__(512, 2) hybrid_fwd(Args args) {
    extern __shared__ __attribute__((aligned(16))) unsigned char lds[];
    Frame F;
    F.lds = (LAS unsigned char*)lds;
    F.tid = threadIdx.x; F.lane = F.tid & 63; F.wave = __builtin_amdgcn_readfirstlane(F.tid >> 6);
    F.G = gridDim.x; { const int bx = blockIdx.x; F.vcu = (F.G % 8 == 0) ? (bx % 8) * (F.G / 8) + bx / 8 : bx; }
    F.ws = args.ws; F.ob = (unsigned char*)args.out;
    volatile LAS unsigned* MISC = (volatile LAS unsigned*)(F.lds + MISC_OFF);
    for (int u = F.tid; u < (LDS_BYTES - MISC_OFF) / 4; u += 512) ((LAS unsigned*)(F.lds + MISC_OFF))[u] = 0u;
    __syncthreads();
    unsigned* ctl = (unsigned*)(F.ws + WS_CTL);
#if MK_PER_PHASE
    XcdBarrier bar; bar.bar = ctl + CW_BAR; bar.x = 0; bar.st = nullptr;
#else
    XcdBarrier bar = xcd_barrier_post(ctl + CW_BAR, MISC + 8);
#endif
    const int lo = args.ph_lo, hi = args.ph_hi;
    unsigned char* ws = F.ws;
    LAS int* tab = (LAS int*)(F.lds + TAB_OFF);
#if MK_TSEL >= 0
    if (threadIdx.x == 0) MISC[17] = (unsigned)__builtin_amdgcn_s_memrealtime();
#endif

    if (IN(0)) { phase_prologue(F, args); SEAM(0); }
    if (IN(1)) {
        phase_pool_p(F, args);
        __syncthreads();
        SchedKV S{F.G, (int)blockIdx.x, (const char*)(ws + WS_MEMN), (const char*)(ws + WS_W_KV), (char*)(ws + WS_K), (char*)(ws + WS_V)};
        pg8::EpiPlain E{1024};
        pg8::gemm_phase<pg8::EpiPlain, SchedKV, false>(F.lds + RING_OFF, 1024, 2048u, 2048u, S, E, tab);
        SEAM(1);
    }
    layer_phases<0>(F, args, bar, lo, hi);
    layer_phases<1>(F, args, bar, lo, hi);
#if MK_TSEL >= 0
    if ((int)blockIdx.x == MK_TBLK && threadIdx.x == 0) { const unsigned long long w = (unsigned long long)MISC[18] * MK_TAMP, t0 = __builtin_amdgcn_s_memrealtime();
        while (__builtin_amdgcn_s_memrealtime() - t0 < w) __builtin_amdgcn_s_sleep(8); }
#endif
}
#undef IN
#undef SEAM

extern "C" void kernel_launch(void* const* d_in, const int* in_sizes, int n_in, void* d_out, int out_size, void* d_ws, size_t ws_size, hipStream_t stream) {
    static int grid = 0;
    if (grid == 0) {
        if (n_in != 25 || out_size != NTOK * D || ws_size < WS_END) { fprintf(stderr, "kernel_launch: unexpected shapes (n_in %d, out %d, ws %zu)\n", n_in, out_size, ws_size); grid = -1; return; }
        int dev = 0, cus = 0, per_cu = 0;
        if (hipGetDevice(&dev) != hipSuccess || hipDeviceGetAttribute(&cus, hipDeviceAttributeMultiprocessorCount, dev) != hipSuccess) { grid = -1; return; }
        if (hipFuncSetAttribute((const void*)hybrid_fwd, hipFuncAttributeMaxDynamicSharedMemorySize, LDS_BYTES) != hipSuccess) { fprintf(stderr, "kernel_launch: hipFuncSetAttribute failed\n"); grid = -1; return; }
        if (hipOccupancyMaxActiveBlocksPerMultiprocessor(&per_cu, (const void*)hybrid_fwd, 512, LDS_BYTES) != hipSuccess || per_cu < 1) fprintf(stderr, "kernel_launch: occupancy query reports %d\n", per_cu);
        (void)hipGetLastError();
        grid = cus;
    }
    if (grid < 0) return;
    (void)hipMemsetAsync((char*)d_ws + WS_CTL, 0, CTL_ZERO_BYTES, stream);
    Args a{};
    for (int i = 0; i < 25; ++i) a.in[i] = (const float*)d_in[i];
    a.out = (float*)d_out; a.ws = (unsigned char*)d_ws; a.dup = 0; a.pad = 0;
#if MK_PER_PHASE
    for (int p = 0; p < NPH; ++p) for (int r = 0; r < ((((MK_DUP) >> p) & 1u) ? 2 : 1); ++r) {
        if (r == 1 && (p == 5 || p == 17)) (void)hipMemsetAsync((char*)d_ws + WS_CTL + (size_t)(CW_CNT + (p == 17 ? 1 : 0) * 16 * 64) * 4, 0, 16 * 64 * 4, stream);
        a.ph_lo = p; a.ph_hi = p + 1; hipLaunchKernelGGL(hybrid_fwd, dim3(grid), dim3(512), LDS_BYTES, stream, a); }
#else
    a.ph_lo = 0; a.ph_hi = NPH; hipLaunchKernelGGL(hybrid_fwd, dim3(grid), dim3(512), LDS_BYTES, stream, a);
#endif
}
```

```cpp
#include <hip/hip_runtime.h>
#include <cstdio>
#include <cstdint>

#ifndef MK_KREP
#define MK_KREP 1
#endif
#ifndef MK_TSEL
#define MK_TSEL -1
#endif
#ifndef MK_TBLK
#define MK_TBLK 0
#endif
#ifndef MK_TAMP
#define MK_TAMP 8
#endif
#ifndef MK_TWAIT
#define MK_TWAIT 0
#endif
#ifndef MK_GMODE
#define MK_GMODE 0
#endif
#ifndef MK_PER_PHASE
#define MK_PER_PHASE 0
#endif

#define GAS __attribute__((address_space(1)))
#define LAS __attribute__((address_space(3)))
typedef unsigned short bf16;
typedef short bf16x8 __attribute__((ext_vector_type(8)));
typedef float f32x4 __attribute__((ext_vector_type(4)));
typedef float f32x2 __attribute__((ext_vector_type(2)));
typedef unsigned u32x4 __attribute__((ext_vector_type(4)));
typedef unsigned u32x2 __attribute__((ext_vector_type(2)));

constexpr int NB = 16, SEQ = 2048, D = 1024, NTOK = NB * SEQ, MEML = 256, NMR = NB * MEML;
constexpr int NEXP = 16, DE = 512;
constexpr float EPS = 1e-6f;
constexpr float LOG2E = 1.4426950408889634f;
constexpr int NPH = 21;
constexpr float W8_GU_SCALE = 32.0f, W8_DOWN_SCALE = 16.0f, H8_MID_SCALE = 4.0f;

constexpr size_t MiB = 1u << 20;
constexpr size_t WS_CTL = 0, CTL_ZERO_BYTES = 1 * MiB;
constexpr int CW_BAR = 4096;
constexpr int CW_CNT = 16384;
constexpr size_t WS_RSTD_A = 1 * MiB;
constexpr size_t WS_RSTD_B = 1 * MiB + 128 * 1024;
constexpr size_t WS_RSTD_X = 1 * MiB + 256 * 1024;
constexpr size_t WS_SS16 = 2 * MiB;
constexpr size_t WS_WRB = 4 * MiB;
constexpr size_t WS_SPL = 4 * MiB + 256 * 1024;
constexpr size_t WS_GW = 5 * MiB;
constexpr size_t WS_LIST = 6 * MiB;
constexpr size_t WS_W_POOL = 8 * MiB;
constexpr size_t WS_W_GATE = 8 * MiB + 512 * 1024;
constexpr size_t WS_W_OUT = 10 * MiB;
constexpr size_t WS_W_IN = 12 * MiB;
constexpr size_t WS_W_Q = 16 * MiB;
constexpr size_t WS_W_OT = 20 * MiB;
constexpr size_t WS_W_KV = 24 * MiB;
constexpr size_t WS_W_DOWN = 32 * MiB;
constexpr size_t WS_W_GU = 64 * MiB;
constexpr size_t WS_K = 128 * MiB;
constexpr size_t WS_V = 144 * MiB;
constexpr size_t WS_BS = 160 * MiB;
constexpr size_t WS_BO = 192 * MiB;
constexpr size_t WS_HA = 224 * MiB;
constexpr size_t WS_HB = 288 * MiB;
constexpr size_t WS_MEMN = 352 * MiB;
constexpr size_t WS_AGS = 368 * MiB;
constexpr size_t WS_AGB = 372 * MiB;
constexpr size_t WS_Y = 384 * MiB;
constexpr size_t WS_END = 512 * MiB;
constexpr size_t OB_P0 = 0, OB_PATT = 64 * MiB, OB_HMID = 0, OB_LOGA = 0, OB_BT = 64 * MiB;
constexpr size_t WS_H8 = WS_Y + 64 * MiB;

constexpr int RING_OFF = 0, RING_BYTES = 131072;
constexpr int XCH_OFF = 131072;
constexpr int TAB_OFF = 139264;
constexpr int TAB2_OFF = 147456;
constexpr int MISC_OFF = 155648;
constexpr int LDS_BYTES = 155904;
constexpr int MAXU = 8;

#define LDS_WAIT() asm volatile("s_waitcnt lgkmcnt(0)" ::: "memory")
#define VM_WAIT() asm volatile("s_waitcnt vmcnt(0)" ::: "memory")

__device__ __forceinline__ unsigned f2bf(float f) { unsigned u = __builtin_bit_cast(unsigned, f); return (u + 0x7fffu + ((u >> 16) & 1u)) >> 16; }
__device__ __forceinline__ unsigned pk2(float lo, float hi) { return f2bf(lo) | (f2bf(hi) << 16); }
__device__ __forceinline__ float bflo(unsigned w) { return __builtin_bit_cast(float, w << 16); }
__device__ __forceinline__ float bfhi(unsigned w) { return __builtin_bit_cast(float, w & 0xffff0000u); }
__device__ __forceinline__ unsigned cvt_pk_bf16(float lo, float hi) { unsigned r; asm volatile("v_cvt_pk_bf16_f32 %0, %1, %2" : "=v"(r) : "v"(lo), "v"(hi)); return r; }
__device__ __forceinline__ u32x4 pack8(f32x4 a, f32x4 b) { u32x4 w; w.x = cvt_pk_bf16(a[0], a[1]); w.y = cvt_pk_bf16(a[2], a[3]); w.z = cvt_pk_bf16(b[0], b[1]); w.w = cvt_pk_bf16(b[2], b[3]); return w; }
__device__ __forceinline__ void unpack8(u32x4 w, f32x4& a, f32x4& b) { a[0] = bflo(w.x); a[1] = bfhi(w.x); a[2] = bflo(w.y); a[3] = bfhi(w.y); b[0] = bflo(w.z); b[1] = bfhi(w.z); b[2] = bflo(w.w); b[3] = bfhi(w.w); }
__device__ __forceinline__ u32x2 pack8_fp8(f32x4 a, f32x4 b) {
#pragma unroll
    for (int j = 0; j < 4; ++j) { a[j] = __builtin_amdgcn_fmed3f(a[j], -384.0f, 384.0f); b[j] = __builtin_amdgcn_fmed3f(b[j], -384.0f, 384.0f); }
    int lo = 0, hi = 0;
    lo = __builtin_amdgcn_cvt_pk_fp8_f32(a[0], a[1], lo, false); lo = __builtin_amdgcn_cvt_pk_fp8_f32(a[2], a[3], lo, true);
    hi = __builtin_amdgcn_cvt_pk_fp8_f32(b[0], b[1], hi, false); hi = __builtin_amdgcn_cvt_pk_fp8_f32(b[2], b[3], hi, true);
    return (u32x2){(unsigned)lo, (unsigned)hi};
}
__device__ __forceinline__ float wave_sum(float v) {
    v += __builtin_bit_cast(float, __builtin_amdgcn_update_dpp(0, __builtin_bit_cast(int, v), 0xB1, 0xF, 0xF, false));
    v += __builtin_bit_cast(float, __builtin_amdgcn_update_dpp(0, __builtin_bit_cast(int, v), 0x4E, 0xF, 0xF, false));
    v += __builtin_bit_cast(float, __builtin_amdgcn_update_dpp(0, __builtin_bit_cast(int, v), 0x141, 0xF, 0xF, false));
    v += __builtin_bit_cast(float, __builtin_amdgcn_update_dpp(0, __builtin_bit_cast(int, v), 0x140, 0xF, 0xF, false));
    v += __shfl_xor(v, 16); v += __shfl_xor(v, 32);
    return v;
}
__device__ __forceinline__ float fast_exp2(float x) { return __builtin_amdgcn_exp2f(x); }
__device__ __forceinline__ float fast_rcp(float x) { return __builtin_amdgcn_rcpf(x); }
__device__ __forceinline__ float sigmoidf_(float x) { return fast_rcp(1.0f + fast_exp2(-x * LOG2E)); }

namespace pg8 {
constexpr int BM = 256, BK = 64, HALF = 128, HTB = HALF * BK * 2, STAGE_BYTES = 8 * HTB, NXCD = 8, WGM = 8;
__host__ __device__ __forceinline__ int lds_byte(int r, int c) { const int st = (r >> 4) * 2 + (c >> 5), rr = r & 15, cc = c & 31, ob = rr * 64 + cc * 2; return st * 1024 + (ob ^ (((ob >> 9) & 1) << 5)); }
__host__ __device__ __forceinline__ void stage_rc(int b, int& R, int& C) { const int st = b / 1024, sb = b % 1024, swz = sb ^ (((sb >> 9) & 1) << 5); R = (st >> 1) * 16 + swz / 64; C = (st & 1) * 32 + (swz % 64) / 2; }
__host__ __device__ __forceinline__ int perm32(int rho) { const int n = rho >> 4, i = rho & 15; return 8 * (i >> 2) + 4 * n + (i & 3); }

struct Unit { const char* A; const char* B; char* C; int row0, col0, aux; };

__device__ __forceinline__ bool tile_of(int i, int G, int c, int nM, int nN, int& pm, int& pn) {
    const int nwg = nM * nN; const long L = (long)i * G + c; if (L >= nwg) return false;
    int wgid = (int)L; { const int q = nwg / NXCD, r = nwg % NXCD, xcd = wgid % NXCD, off = wgid / NXCD; wgid = (xcd < r ? xcd * (q + 1) : r * (q + 1) + (xcd - r) * q) + off; }
    const int nig = WGM * nN, gid = wgid / nig, fm = gid * WGM, gsz = (nM - fm) < WGM ? (nM - fm) : WGM;
    pm = fm + ((wgid % nig) % gsz); pn = (wgid % nig) / gsz; return true;
}

typedef int i32x8 __attribute__((ext_vector_type(8)));
template <class Epi, class Sched, bool GATHER, bool F8 = false>
__device__ __forceinline__ void gemm_phase(LAS unsigned char* lds, const int K, const unsigned lda, const unsigned ldb, const Sched& S, const Epi& E, const LAS int* tab) {
    const int tid = threadIdx.x, wid = __builtin_amdgcn_readfirstlane(tid >> 6), lane = tid & 63, wr = wid >> 2, wc = wid & 3, fr = lane & 15, fq = lane >> 4;
    const int nt = F8 ? K / 128 : K / BK;
    unsigned vA[2], vB[2], vG[2][2]; int rA[2]; unsigned cA2[2];
#pragma unroll
    for (int i = 0; i < 2; ++i) { int R, C; stage_rc(tid * 16 + i * 8192, R, C); const int Rb = (R & ~31) + perm32(R & 31);
        vA[i] = (unsigned)R * lda + (unsigned)C * 2u; vB[i] = (unsigned)Rb * ldb + (unsigned)C * 2u; rA[i] = R; cA2[i] = (unsigned)C * 2u; vG[0][i] = 0; vG[1][i] = 0; }
    const size_t kstep = (size_t)(BK * 2);
    const size_t hsA = (size_t)HALF * lda, hsB = (size_t)HALF * ldb;
    const unsigned ldsw = (unsigned)wid * 1024u;
    const int aoff = lds_byte(wr * 64 + fr, fq * (F8 ? 16 : 8)), boff = lds_byte(wc * 32 + fr, fq * (F8 ? 16 : 8));
#define PG8_SA(b, h) (((b) * 2 + (h)) * HTB)
#define PG8_SB(b, h) ((4 + (b) * 2 + (h)) * HTB)
#define PG8_STAGE_B(bufoff, gbase) do { _Pragma("unroll") for (int _i = 0; _i < 2; ++_i) \
        __builtin_amdgcn_global_load_lds((const unsigned*)((const char*)(gbase) + vB[_i]), (LAS unsigned*)(lds + (bufoff) + ldsw + _i * 8192), 16, 0, 0); } while (0)
#define PG8_STAGE_A(bufoff, gbase, h) do { _Pragma("unroll") for (int _i = 0; _i < 2; ++_i) { \
        if constexpr (GATHER) __builtin_amdgcn_global_load_lds((const unsigned*)((const char*)(gbase) + vG[h][_i]), (LAS unsigned*)(lds + (bufoff) + ldsw + _i * 8192), 16, 0, 0); \
        else __builtin_amdgcn_global_load_lds((const unsigned*)((const char*)(gbase) + (h) * hsA + vA[_i]), (LAS unsigned*)(lds + (bufoff) + ldsw + _i * 8192), 16, 0, 0); } } while (0)
#define PG8_LOADG(ui_) do { const int _u = ((ui_) < MAXU ? (ui_) : (MAXU - 1)) * 256; _Pragma("unroll") for (int _h = 0; _h < 2; ++_h) _Pragma("unroll") for (int _i = 0; _i < 2; ++_i) \
        vG[_h][_i] = (unsigned)tab[_u + rA[_i] + 128 * _h] * lda + cA2[_i]; } while (0)
#define PG8_LDA(dst, b, h) do { if constexpr (F8) { _Pragma("unroll") for (int m = 0; m < 4; ++m) dst##8[m] = *(const LAS i32x8*)(lds + PG8_SA(b, h) + aoff + m * 2048); } \
        else { _Pragma("unroll") for (int m = 0; m < 4; ++m) _Pragma("unroll") for (int k = 0; k < 2; ++k) dst[m][k] = *(const LAS bf16x8*)(lds + PG8_SA(b, h) + aoff + m * 2048 + k * 1024); } } while (0)
#define PG8_LDB(dst, b, h) do { if constexpr (F8) { _Pragma("unroll") for (int n = 0; n < 2; ++n) dst##8[n] = *(const LAS i32x8*)(lds + PG8_SB(b, h) + boff + n * 2048); } \
        else { _Pragma("unroll") for (int n = 0; n < 2; ++n) _Pragma("unroll") for (int k = 0; k < 2; ++k) dst[n][k] = *(const LAS bf16x8*)(lds + PG8_SB(b, h) + boff + n * 2048 + k * 1024); } } while (0)
#define PG8_MMA(ai, bj, At, Bt) do { __builtin_amdgcn_s_setprio(1); _Pragma("unroll") for (int m = 0; m < 4; ++m) _Pragma("unroll") for (int n = 0; n < 2; ++n) { \
        if constexpr (F8) { asm volatile("v_mfma_f32_16x16x128_f8f6f4 %0, %1, %2, %0" : "+v"(acc[ai][bj][m][n]) : "v"(Bt##8[n]), "v"(At##8[m])); } \
        else { _Pragma("unroll") for (int k = 0; k < 2; ++k) acc[ai][bj][m][n] = __builtin_amdgcn_mfma_f32_16x16x32_bf16(Bt[n][k], At[m][k], acc[ai][bj][m][n], 0, 0, 0); } } \
        __builtin_amdgcn_s_setprio(0); } while (0)
#define PG8_WAIT_V(n) asm volatile("s_waitcnt vmcnt(" #n ")" ::: "memory")
#define PG8_WAIT_L(n) asm volatile("s_waitcnt lgkmcnt(" #n ")" ::: "memory")
#define PG8_BAR __builtin_amdgcn_s_barrier()
#define PG8_SCHED __builtin_amdgcn_sched_barrier(0)
#if MK_GMODE
    volatile LAS unsigned* _gm = (volatile LAS unsigned*)(lds + 155648);
    const bool _gsel = (threadIdx.x == 0) && ((int)_gm[16] == MK_TSEL);
    unsigned _gt = (unsigned)__builtin_amdgcn_s_memrealtime(); unsigned _gacc = 0;
#define PG8_GSTAMP(mode_) do { if (_gsel) { const unsigned _n = (unsigned)__builtin_amdgcn_s_memrealtime(); if (MK_GMODE == (mode_)) _gacc += _n - _gt; _gt = _n; } } while (0)
#else
#define PG8_GSTAMP(mode_) do { } while (0)
#endif
    Unit cur, nxt; int ui = 0;
    if (!S.next(0, cur)) return;
    f32x4 acc[2][2][4][2];
#pragma unroll
    for (int a = 0; a < 2; ++a)
#pragma unroll
        for (int b = 0; b < 2; ++b)
#pragma unroll
            for (int m = 0; m < 4; ++m)
#pragma unroll
                for (int n = 0; n < 2; ++n) acc[a][b][m][n] = (f32x4){0.f, 0.f, 0.f, 0.f};
    bf16x8 At[4][2], B0[2][2], B1[2][2]; i32x8 At8[4], B08[2], B18[2];
    const char* cA = cur.A; const char* cB = cur.B;
    if constexpr (GATHER) { PG8_LOADG(0); }
    PG8_STAGE_B(PG8_SB(0, 0), cB); PG8_STAGE_B(PG8_SB(0, 1), cB + hsB); PG8_STAGE_A(PG8_SA(0, 0), cA, 0); PG8_STAGE_A(PG8_SA(0, 1), cA, 1);
    if (wr == 1) PG8_BAR;
    PG8_WAIT_V(2); PG8_BAR;
    PG8_STAGE_B(PG8_SB(1, 0), cB + kstep); PG8_STAGE_A(PG8_SA(1, 0), cA + kstep, 0); PG8_STAGE_B(PG8_SB(1, 1), cB + hsB + kstep);
    PG8_WAIT_V(6); PG8_BAR;
    PG8_GSTAMP(1);
    for (;;) {
        const bool has_next = S.next(ui + 1, nxt);
        const char* nA = has_next ? nxt.A : cA; const char* nB = has_next ? nxt.B : cB;
#pragma nounroll
        for (int t = 0; t < nt * MK_KREP; t += 2) {
            const bool last = (t == nt * MK_KREP - 2);
            const char* a1 = cA + (size_t)(MK_KREP == 1 ? (t + 1) : ((t + 1) % nt)) * kstep;
            const int t2 = (MK_KREP == 1) ? (t + 2) : ((t + 2) % nt);
            const char* a2 = last ? nA : cA + (size_t)t2 * kstep; const char* b2 = last ? nB : cB + (size_t)t2 * kstep;
            const char* a3 = a2 + kstep; const char* b3 = b2 + kstep;
            PG8_LDB(B0, 0, 0); PG8_LDB(B1, 0, 1); PG8_SCHED; PG8_LDA(At, 0, 0); PG8_STAGE_A(PG8_SA(1, 1), a1, 1);
            PG8_WAIT_V(8); PG8_WAIT_L(0); PG8_BAR; PG8_MMA(0, 0, At, B0); PG8_MMA(0, 1, At, B1); PG8_BAR; PG8_SCHED;
            if constexpr (GATHER) { if (last && has_next) { PG8_LOADG(ui + 1); } }
            PG8_LDA(At, 0, 1); PG8_STAGE_B(PG8_SB(0, 0), b2); PG8_STAGE_B(PG8_SB(0, 1), b2 + hsB); PG8_STAGE_A(PG8_SA(0, 0), a2, 0);
            PG8_WAIT_V(8); PG8_WAIT_L(0); PG8_BAR; PG8_MMA(1, 0, At, B0); PG8_MMA(1, 1, At, B1); PG8_BAR; PG8_SCHED;
            PG8_LDB(B0, 1, 0); PG8_LDB(B1, 1, 1); PG8_SCHED; PG8_LDA(At, 1, 0); PG8_STAGE_A(PG8_SA(0, 1), a2, 1);
            PG8_WAIT_V(8); PG8_WAIT_L(0); PG8_BAR; PG8_MMA(0, 0, At, B0); PG8_MMA(0, 1, At, B1); PG8_BAR; PG8_SCHED;
            PG8_LDA(At, 1, 1); PG8_STAGE_B(PG8_SB(1, 0), b3); PG8_STAGE_B(PG8_SB(1, 1), b3 + hsB); PG8_STAGE_A(PG8_SA(1, 0), a3, 0);
            PG8_WAIT_V(8); PG8_WAIT_L(0); PG8_BAR; PG8_MMA(1, 0, At, B0); PG8_MMA(1, 1, At, B1); PG8_BAR; PG8_SCHED;
        }
        if (wr == 0) PG8_BAR;
        PG8_GSTAMP(4);
        if constexpr (F8) asm volatile("s_nop 15\n\ts_nop 15\n\ts_nop 15\n\ts_nop 15" ::: "memory");
        if (MK_KREP != 1) {
#pragma unroll
            for (int a = 0; a < 2; ++a)
#pragma unroll
                for (int b = 0; b < 2; ++b)
#pragma unroll
                    for (int m = 0; m < 4; ++m)
#pragma unroll
                        for (int n = 0; n < 2; ++n) acc[a][b][m][n] *= (1.0f / MK_KREP);
        }
        E(acc, cur, wr, wc, fr, fq);
        PG8_GSTAMP(2);
        if (!has_next) break;
#pragma unroll
        for (int a = 0; a < 2; ++a)
#pragma unroll
            for (int b = 0; b < 2; ++b)
#pragma unroll
                for (int m = 0; m < 4; ++m)
#pragma unroll
                    for (int n = 0; n < 2; ++n) acc[a][b][m][n] = (f32x4){0.f, 0.f, 0.f, 0.f};
        cur = nxt; cA = nA; cB = nB; ++ui;
        if (wr == 1) PG8_BAR;
    }
    PG8_WAIT_V(0);
    PG8_BAR;
    PG8_GSTAMP(3);
#if MK_GMODE
    if (_gsel) _gm[18] = _gacc;
#endif
#undef PG8_GSTAMP
#undef PG8_SA
#undef PG8_SB
#undef PG8_STAGE_A
#undef PG8_STAGE_B
#undef PG8_LOADG
#undef PG8_LDA
#undef PG8_LDB
#undef PG8_MMA
#undef PG8_WAIT_V
#undef PG8_WAIT_L
#undef PG8_BAR
#undef PG8_SCHED
}

typedef f32x4 Acc[2][2][4][2];
#ifndef MK_EPI_SC1
#define MK_EPI_SC1 0
#endif
__device__ __forceinline__ void st16(bf16* p, u32x4 v) {
#if MK_EPI_SC1
    asm volatile("global_store_dwordx4 %0, %1, off sc1\n\ts_nop 1" :: "v"(p), "v"(v) : "memory");
#else
    *(u32x4*)p = v;
#endif
}

struct EpiPlain {
    int ldc;
    __device__ __forceinline__ void operator()(Acc& acc, const Unit& u, int wr, int wc, int fr, int fq) const {
        bf16* base = (bf16*)u.C + (size_t)(wr * 64 + fr) * ldc + wc * 32 + 8 * fq;
#pragma unroll
        for (int ai = 0; ai < 2; ++ai)
#pragma unroll
            for (int m = 0; m < 4; ++m) { bf16* rowp = base + (size_t)(ai * 128 + m * 16) * ldc;
#pragma unroll
                for (int bj = 0; bj < 2; ++bj) st16(rowp + bj * 128, pack8(acc[ai][bj][m][0], acc[ai][bj][m][1])); }
    }
};
template <bool STATS> struct EpiRes {
    const bf16* hin; bf16* hout; float* ss16; unsigned char* h8;
    __device__ __forceinline__ void operator()(Acc& acc, const Unit& u, int wr, int wc, int fr, int fq) const {
        const size_t ro0 = (size_t)(u.row0 + wr * 64 + fr) * 1024 + u.col0 + wc * 32 + 8 * fq;
        u32x4 hv[2][4][2];
#pragma unroll
        for (int ai = 0; ai < 2; ++ai)
#pragma unroll
            for (int m = 0; m < 4; ++m)
#pragma unroll
                for (int bj = 0; bj < 2; ++bj) hv[ai][m][bj] = *(const u32x4*)(hin + ro0 + (size_t)(ai * 128 + m * 16) * 1024 + bj * 128);
#pragma unroll
        for (int ai = 0; ai < 2; ++ai)
#pragma unroll
            for (int m = 0; m < 4; ++m) { const int row = u.row0 + ai * 128 + wr * 64 + m * 16 + fr; const size_t ro = ro0 + (size_t)(ai * 128 + m * 16) * 1024; float s = 0.f;
#pragma unroll
                for (int bj = 0; bj < 2; ++bj) { f32x4 a, b; unpack8(hv[ai][m][bj], a, b); a += acc[ai][bj][m][0]; b += acc[ai][bj][m][1];
                    if constexpr (STATS) s += (a[0] * a[0] + a[1] * a[1]) + (a[2] * a[2] + a[3] * a[3]) + (b[0] * b[0] + b[1] * b[1]) + (b[2] * b[2] + b[3] * b[3]);
                    st16(hout + ro + bj * 128, pack8(a, b)); if (h8) *(u32x2*)(h8 + ro + bj * 128) = pack8_fp8(a, b); }
                if constexpr (STATS) { s += __shfl_xor(s, 16); s += __shfl_xor(s, 32);
                    if (fq == 0) ss16[(size_t)row * 16 + (u.col0 >> 8) * 4 + wc] = s; } }
    }
};
struct EpiPool {
    const float* x; const float* scale; bf16* hout; float* ss16;
    __device__ __forceinline__ void operator()(Acc& acc, const Unit& u, int wr, int wc, int fr, int fq) const {
        const int cb = u.col0 + wc * 32 + 8 * fq;
        f32x4 sc[2][2];
#pragma unroll
        for (int bj = 0; bj < 2; ++bj) { sc[bj][0] = *(const f32x4*)(scale + cb + bj * 128); sc[bj][1] = *(const f32x4*)(scale + cb + bj * 128 + 4); }
        float ssum[2][4];
#pragma unroll
        for (int ai = 0; ai < 2; ++ai) {
            f32x4 xv[4][2][2];
#pragma unroll
            for (int m = 0; m < 4; ++m)
#pragma unroll
                for (int bj = 0; bj < 2; ++bj) { const float* xp = x + (size_t)(u.row0 + ai * 128 + wr * 64 + m * 16 + fr) * 1024 + cb + bj * 128; xv[m][bj][0] = *(const f32x4*)xp; xv[m][bj][1] = *(const f32x4*)(xp + 4); }
#pragma unroll
            for (int m = 0; m < 4; ++m) { const int row = u.row0 + ai * 128 + wr * 64 + m * 16 + fr; const size_t ro = (size_t)row * 1024 + cb; float s = 0.f;
#pragma unroll
                for (int bj = 0; bj < 2; ++bj) { f32x4 a = xv[m][bj][0], b = xv[m][bj][1];
                    a += acc[ai][bj][m][0] * sc[bj][0]; b += acc[ai][bj][m][1] * sc[bj][1];
                    s += (a[0] * a[0] + a[1] * a[1]) + (a[2] * a[2] + a[3] * a[3]) + (b[0] * b[0] + b[1] * b[1]) + (b[2] * b[2] + b[3] * b[3]);
                    st16(hout + ro + bj * 128, pack8(a, b)); }
                s += __shfl_xor(s, 16); s += __shfl_xor(s, 32); ssum[ai][m] = s; }
        }
        if (fq == 0) {
#pragma unroll
            for (int ai = 0; ai < 2; ++ai)
#pragma unroll
                for (int m = 0; m < 4; ++m) ss16[(size_t)(u.row0 + ai * 128 + wr * 64 + m * 16 + fr) * 16 + (u.col0 >> 8) * 4 + wc] = ssum[ai][m];
        }
    }
};
struct EpiS {
    bf16* P; const LAS float* tab2; LAS f32x2* xch;
    __device__ __forceinline__ void operator()(Acc& acc, const Unit& u, int wr, int wc, int fr, int fq) const {
        float mxs[2][4];
#pragma unroll
        for (int ai = 0; ai < 2; ++ai)
#pragma unroll
            for (int m = 0; m < 4; ++m) { const int rl = ai * 128 + wr * 64 + m * 16 + fr; const int row = u.row0 + rl;
                const float rs = tab2[(u.aux < MAXU ? u.aux : MAXU - 1) * 256 + rl];
                float mx = -3.0e38f;
#pragma unroll
                for (int bj = 0; bj < 2; ++bj)
#pragma unroll
                    for (int n = 0; n < 2; ++n) { f32x4 v = acc[ai][bj][m][n] * rs; acc[ai][bj][m][n] = v; mx = fmaxf(mx, fmaxf(fmaxf(v[0], v[1]), fmaxf(v[2], v[3]))); }
                mx = fmaxf(mx, __shfl_xor(mx, 16)); mx = fmaxf(mx, __shfl_xor(mx, 32));
                float l = 0.f;
#pragma unroll
                for (int bj = 0; bj < 2; ++bj)
#pragma unroll
                    for (int n = 0; n < 2; ++n) { f32x4 v = acc[ai][bj][m][n]; f32x4 e; e[0] = fast_exp2(v[0] - mx); e[1] = fast_exp2(v[1] - mx); e[2] = fast_exp2(v[2] - mx); e[3] = fast_exp2(v[3] - mx);
                        acc[ai][bj][m][n] = e; l += (e[0] + e[1]) + (e[2] + e[3]); }
                l += __shfl_xor(l, 16); l += __shfl_xor(l, 32);
                if (fq == 0) xch[rl * 4 + wc] = (f32x2){mx, l};
                mxs[ai][m] = mx; }
        asm volatile("s_waitcnt lgkmcnt(0)" ::: "memory"); __builtin_amdgcn_s_barrier(); asm volatile("" ::: "memory");
#pragma unroll
        for (int ai = 0; ai < 2; ++ai)
#pragma unroll
            for (int m = 0; m < 4; ++m) { const int rl = ai * 128 + wr * 64 + m * 16 + fr; const int row = u.row0 + rl;
                const f32x2 p0 = xch[rl * 4 + 0], p1 = xch[rl * 4 + 1], p2 = xch[rl * 4 + 2], p3 = xch[rl * 4 + 3];
                const float M = fmaxf(fmaxf(p0.x, p1.x), fmaxf(p2.x, p3.x));
                const float L = (p0.y * fast_exp2(p0.x - M) + p1.y * fast_exp2(p1.x - M)) + (p2.y * fast_exp2(p2.x - M) + p3.y * fast_exp2(p3.x - M));
                const float f = fast_exp2(mxs[ai][m] - M) * fast_rcp(L);
                bf16* rowp = P + (size_t)row * 1024 + u.col0 + wc * 32 + 8 * fq;
#pragma unroll
                for (int bj = 0; bj < 2; ++bj) st16(rowp + bj * 128, pack8(acc[ai][bj][m][0] * f, acc[ai][bj][m][1] * f)); }
    }
};
struct EpiGU {
    unsigned char* hmid; const LAS float* tab2;
    __device__ __forceinline__ void operator()(Acc& acc, const Unit& u, int wr, int wc, int fr, int fq) const {
        const int ub = (u.aux < MAXU ? u.aux : MAXU - 1) * 256;
#pragma unroll
        for (int ai = 0; ai < 2; ++ai)
#pragma unroll
            for (int m = 0; m < 4; ++m) { const int rl = ai * 128 + wr * 64 + m * 16 + fr; const float rs = tab2[ub + rl] * (1.0f / W8_GU_SCALE);
                f32x4 o[2];
#pragma unroll
                for (int n = 0; n < 2; ++n)
#pragma unroll
                    for (int j = 0; j < 4; ++j) { const float g = acc[ai][0][m][n][j] * rs, uu = acc[ai][1][m][n][j] * rs; o[n][j] = g * sigmoidf_(g) * uu * H8_MID_SCALE; }
                *(u32x2*)(hmid + (size_t)(u.row0 + rl) * 512 + (u.col0 >> 1) + wc * 32 + 8 * fq) = pack8_fp8(o[0], o[1]); }
    }
};
struct EpiDown {
    bf16* y; const LAS int* tab; const LAS float* tab2;
    __device__ __forceinline__ void operator()(Acc& acc, const Unit& u, int wr, int wc, int fr, int fq) const {
        const int ub = (u.aux < MAXU ? u.aux : MAXU - 1) * 256;
#pragma unroll
        for (int ai = 0; ai < 2; ++ai)
#pragma unroll
            for (int m = 0; m < 4; ++m) { const int rl = ai * 128 + wr * 64 + m * 16 + fr; const int slot = tab[ub + rl]; const float w = tab2[ub + rl] * (1.0f / (W8_DOWN_SCALE * H8_MID_SCALE));
                if (slot >= 0) { bf16* rowp = y + (size_t)slot * 1024 + u.col0 + wc * 32 + 8 * fq;
#pragma unroll
                    for (int bj = 0; bj < 2; ++bj) st16(rowp + bj * 128, pack8(acc[ai][bj][m][0] * w, acc[ai][bj][m][1] * w)); } }
    }
};
struct EpiIn {
    bf16* xb; bf16* gate; const LAS float* tab2;
    __device__ __forceinline__ void operator()(Acc& acc, const Unit& u, int wr, int wc, int fr, int fq) const {
        const bool isg = u.col0 >= 1024; bf16* dst = isg ? gate : xb; const int c0 = (u.col0 & 1023) + wc * 32 + 8 * fq;
#pragma unroll
        for (int ai = 0; ai < 2; ++ai)
#pragma unroll
            for (int m = 0; m < 4; ++m) { const int rl = ai * 128 + wr * 64 + m * 16 + fr; const int row = u.row0 + rl; const float rs = tab2[(u.aux < MAXU ? u.aux : MAXU - 1) * 256 + rl];
#pragma unroll
                for (int bj = 0; bj < 2; ++bj) { f32x4 o[2];
#pragma unroll
                    for (int n = 0; n < 2; ++n)
#pragma unroll
                        for (int j = 0; j < 4; ++j) { float v = acc[ai][bj][m][n][j] * rs; if (isg) { const float t = 1.5957691216057308f * (v + 0.044715f * v * v * v); v = v * sigmoidf_(t); } o[n][j] = v; }
                    st16(dst + (size_t)row * 1024 + c0 + bj * 128, pack8(o[0], o[1])); } }
    }
};
struct EpiGates {
    const bf16* xc; bf16* loga; bf16* bt; const float* bgate; const float* spl;
    __device__ __forceinline__ void operator()(Acc& acc, const Unit& u, int wr, int wc, int fr, int fq) const {
        const int ch = u.col0 + wc * 32 + 8 * fq;
        const int hh = u.col0 >> 8, cin = (u.col0 & 255) + wc * 32 + 8 * fq;
        f32x4 br[2], bi[2], sp[2];
#pragma unroll
        for (int n = 0; n < 2; ++n) { br[n] = *(const f32x4*)(bgate + hh * 512 + cin + 4 * n); bi[n] = *(const f32x4*)(bgate + hh * 512 + 256 + cin + 4 * n); sp[n] = *(const f32x4*)(spl + ch + 4 * n); }
        u32x4 xv[2][4];
#pragma unroll
        for (int ai = 0; ai < 2; ++ai)
#pragma unroll
            for (int m = 0; m < 4; ++m) xv[ai][m] = *(const u32x4*)(xc + (size_t)(u.row0 + ai * 128 + wr * 64 + m * 16 + fr) * 1024 + ch);
#pragma unroll
        for (int ai = 0; ai < 2; ++ai)
#pragma unroll
            for (int m = 0; m < 4; ++m) { const int row = u.row0 + ai * 128 + wr * 64 + m * 16 + fr; const size_t ro = (size_t)row * 1024 + ch;
                f32x4 x[2]; unpack8(xv[ai][m], x[0], x[1]);
                f32x4 la[2], bb[2];
#pragma unroll
                for (int n = 0; n < 2; ++n)
#pragma unroll
                    for (int j = 0; j < 4; ++j) { const float er = 1.0f + fast_exp2(fminf(-(acc[ai][0][m][n][j] + br[n][j]) * LOG2E, 60.f)), ei = 1.0f + fast_exp2(fminf(-(acc[ai][1][m][n][j] + bi[n][j]) * LOG2E, 60.f));
                        const float q = fast_rcp(er * ei); const float r = q * ei, ig = q * er;
                        const float l = -8.0f * r * sp[n][j]; const float a2 = fast_exp2(2.0f * LOG2E * l); const float mult = __builtin_amdgcn_sqrtf(fmaxf(1.0f - a2, 0.f));
                        la[n][j] = l; bb[n][j] = mult * ig * x[n][j]; }
                *(u32x4*)(loga + ro) = pack8(la[0], la[1]); *(u32x4*)(bt + ro) = pack8(bb[0], bb[1]); }
    }
};
}

#define XB_TMO      128
#define XB_XCNT(j)  (256  + 64 * (j))
#define XB_XSUB(j)  (1280 + 64 * (j))
#define XB_XGEN(j)  (2304 + 64 * (j))
#define XB_TOP      3328
#define XB_TOPGEN   3392
#define XCD_BAR_WORDS 3456
#define XB_SPIN_CAP (1u << 18)

__device__ __forceinline__ unsigned xb_ld(unsigned* p)              { return __hip_atomic_load(p, __ATOMIC_RELAXED, __HIP_MEMORY_SCOPE_AGENT); }
__device__ __forceinline__ unsigned xb_add(unsigned* p, unsigned v) { return __hip_atomic_fetch_add(p, v, __ATOMIC_RELAXED, __HIP_MEMORY_SCOPE_AGENT); }
__device__ __forceinline__ unsigned xb_xcc_id() { return (unsigned)__builtin_amdgcn_s_getreg((3 << 11) | 20) & 0xFu; }
#define XB_SPIN(cond, bar) do { unsigned _sp = 0; while (cond) { __builtin_amdgcn_s_sleep(1); \
    if ((++_sp & 255u) == 0u) { if (xb_ld(&(bar)[XB_TMO])) break; if (_sp > XB_SPIN_CAP) { atomicAdd(&(bar)[XB_TMO], 1u); break; } } } } while (0)

struct XcdBarrier { unsigned* bar; unsigned x; volatile LAS unsigned* st; };

__device__ __forceinline__ XcdBarrier xcd_barrier_post(unsigned* bar, volatile LAS unsigned* st) {
    XcdBarrier b; b.bar = bar; b.x = xb_xcc_id(); b.st = st;
    if (threadIdx.x == 0) (void)xb_add(&bar[XB_XCNT(b.x)], 1u);
    return b;
}
__device__ __forceinline__ void xcd_barrier_complete(unsigned* bar, unsigned x, unsigned& nloc, unsigned& nx) {
    const unsigned G = gridDim.x * gridDim.y * gridDim.z;
    unsigned sum, cnt, mine, sp = 0u;
    for (;;) {
        sum = 0u; cnt = 0u; mine = 0u;
#pragma unroll
        for (unsigned j = 0; j < 16; ++j) { const unsigned c = xb_ld(&bar[XB_XCNT(j)]); sum += c; cnt += (c > 0u) ? 1u : 0u; mine = (j == x) ? c : mine; }
        if (sum == G) break;
        __builtin_amdgcn_s_sleep(1);
        if ((++sp & 255u) == 0u) { if (xb_ld(&bar[XB_TMO])) break; if (sp > XB_SPIN_CAP) { atomicAdd(&bar[XB_TMO], 1u); break; } }
    }
    nloc = mine > 0u ? mine : 1u; nx = cnt > 0u ? cnt : 1u;
}
__device__ __forceinline__ void xcd_barrier(const XcdBarrier& b) {
    asm volatile("s_waitcnt vmcnt(0)" ::: "memory");
    __syncthreads();
    if (threadIdx.x == 0) {
        unsigned* bar = b.bar;
        __builtin_amdgcn_s_waitcnt(0);
        unsigned nloc = b.st[0], nx = b.st[1];
        if (nloc == 0u) { xcd_barrier_complete(bar, b.x, nloc, nx); b.st[0] = nloc; b.st[1] = nx; }
        const unsigned old = xb_add(&bar[XB_XSUB(b.x)], 1u);
        const unsigned gen = old / nloc;
        if (old + 1u == (gen + 1u) * nloc) {
            __builtin_amdgcn_fence(__ATOMIC_RELEASE, "agent");
            asm volatile("s_waitcnt vmcnt(0)" ::: "memory");
            const unsigned og = xb_add(&bar[XB_TOP], 1u);
            const unsigned tg = og / nx;
            if (og + 1u == (tg + 1u) * nx) xb_add(&bar[XB_TOPGEN], 1u);
            else XB_SPIN(xb_ld(&bar[XB_TOPGEN]) == tg, bar);
            __builtin_amdgcn_fence(__ATOMIC_ACQUIRE, "agent");
            xb_add(&bar[XB_XGEN(b.x)], 1u);
            asm volatile("s_waitcnt vmcnt(0)" ::: "memory");
        } else {
            XB_SPIN(xb_ld(&bar[XB_XGEN(b.x)]) == gen, bar);
            __builtin_amdgcn_fence(__ATOMIC_ACQUIRE, "agent");
            asm volatile("s_waitcnt vmcnt(0)" ::: "memory");
        }
    }
    __syncthreads();
}

struct Args { const float* in[25]; float* out; unsigned char* ws; int ph_lo, ph_hi; unsigned dup, pad; };
struct Frame {
    LAS unsigned char* lds;
    int tid, lane, wave, G, vcu;
    unsigned char* ws; unsigned char* ob;
};
enum { I_X = 0, I_MEM, I_POOL_W, I_POOL_SCALE, I_RG_W_IN, I_RG_CONV_W, I_RG_CONV_B, I_RG_W_GATE, I_RG_B_GATE, I_RG_LAMBDA, I_RG_W_OUT, I_XA_WQ, I_XA_WKV, I_XA_WO,
       I_MOE_WG, I_MOE_BG, I_MOE_WE, I_MOE_BE, I_MOE_W_GU, I_MOE_W_DOWN, I_NORM_MIX, I_NORM_XATTN, I_NORM_MEM, I_NORM_MOE, I_NORM_FINAL };

__device__ __forceinline__ void tr_item(const float* W, int ldw, int k0, int scol0, const float* gain, void* out, int ldo, int orow0, LAS float* scr, int lane, int f8 = 0, float scl = 1.0f) {
    f32x4 v[8];
    const int kq = lane >> 3, n4 = (lane & 7) * 4;
#pragma unroll
    for (int i = 0; i < 8; ++i) v[i] = *(const f32x4*)(W + (size_t)(k0 + 8 * i + kq) * ldw + scol0 + n4);
    if (gain) {
#pragma unroll
        for (int i = 0; i < 8; ++i) v[i] *= gain[k0 + 8 * i + kq] * scl;
    } else if (f8) {
#pragma unroll
        for (int i = 0; i < 8; ++i) v[i] *= scl;
    }
#pragma unroll
    for (int i = 0; i < 8; ++i) { LAS float* d = scr + (8 * i + kq) * 33 + n4; d[0] = v[i][0]; d[1] = v[i][1]; d[2] = v[i][2]; d[3] = v[i][3]; }
    LDS_WAIT(); asm volatile("" ::: "memory");
    const int c = lane & 7;
#pragma unroll
    for (int j = 0; j < 4; ++j) { const int n = (lane >> 3) + 8 * j; const LAS float* s = scr + (8 * c) * 33 + n;
        if (f8) { *(u32x2*)((unsigned char*)out + (size_t)(orow0 + n) * ldo + k0 + 8 * c) = pack8_fp8((f32x4){s[0 * 33], s[1 * 33], s[2 * 33], s[3 * 33]}, (f32x4){s[4 * 33], s[5 * 33], s[6 * 33], s[7 * 33]}); }
        else { u32x4 o; o.x = pk2(s[0 * 33], s[1 * 33]); o.y = pk2(s[2 * 33], s[3 * 33]); o.z = pk2(s[4 * 33], s[5 * 33]); o.w = pk2(s[6 * 33], s[7 * 33]);
            *(u32x4*)((bf16*)out + (size_t)(orow0 + n) * ldo + k0 + 8 * c) = o; } }
    LDS_WAIT(); asm volatile("" ::: "memory");
}
__device__ __forceinline__ void tr_job(int q, const float* W, int Kdim, int ldw, int NO, int mapmode, int mapoff, const float* gain, void* out, LAS float* scr, int lane, int f8 = 0, float scl = 1.0f) {
    const int nblk = NO / 32, kb = q / nblk, nb = q % nblk, n0 = 32 * nb;
    int sc = n0;
    if (mapmode) { const int tile = n0 >> 8, w = n0 & 255; sc = (w < 128) ? (128 * tile + w) : (mapoff + 128 * tile + (w - 128)); }
    tr_item(W, ldw, 64 * kb, sc, gain, out, Kdim, n0, scr, lane, f8, scl);
}
__device__ __forceinline__ float row_sumsq_f32(const float* row, int lane, f32x4 (&v)[4]) {
    const f32x4* xr = (const f32x4*)row + lane; float s = 0.f;
#pragma unroll
    for (int j = 0; j < 4; ++j) { v[j] = xr[64 * j]; s += (v[j][0] * v[j][0] + v[j][1] * v[j][1]) + (v[j][2] * v[j][2] + v[j][3] * v[j][3]); }
    return wave_sum(s);
}

__device__ __forceinline__ void phase_prologue(Frame& F, const Args& args) {
    LAS float* scr = (LAS float*)(F.lds + RING_OFF + F.wave * 16384);
    const int gw = F.vcu * 8 + F.wave, NGW = F.G * 8, lane = F.lane;
    unsigned char* ws = F.ws;
    const float* nmix = args.in[I_NORM_MIX]; const float* nxat = args.in[I_NORM_XATTN]; const float* nmem = args.in[I_NORM_MEM]; const float* nmoe = args.in[I_NORM_MOE];
    constexpr int J0 = 128, J1 = 1024, J2 = 256, J3 = 512, J4 = 2048, J5 = 1024, J6 = 16384, J7 = 8192;
    constexpr int NITEMS = J0 + J1 + J2 + J3 + J4 + J5 + J6 + J7;
    for (int it = gw; it < NITEMS; it += NGW) {
        int r = it;
        if (r < J0) { const int g = r / 32, q = r % 32; tr_job(q, args.in[I_POOL_W] + (size_t)g * 65536, 256, 256, 256, 0, 0, nullptr, (bf16*)(ws + WS_W_POOL) + (size_t)g * 65536, scr, lane); continue; } r -= J0;
        if (r < J1) { tr_job(r, args.in[I_RG_W_IN], 1024, 2048, 2048, 0, 0, nmix + 1024, (bf16*)(ws + WS_W_IN), scr, lane); continue; } r -= J1;
        if (r < J2) { const int h = r / 64, q = r % 64; tr_job(q, args.in[I_RG_W_GATE] + (size_t)h * 131072, 256, 512, 512, 1, 256, nullptr, (bf16*)(ws + WS_W_GATE) + (size_t)h * 131072, scr, lane); continue; } r -= J2;
        if (r < J3) { tr_job(r, args.in[I_RG_W_OUT], 1024, 1024, 1024, 0, 0, nullptr, (bf16*)(ws + WS_W_OUT), scr, lane); continue; } r -= J3;
        if (r < J4) { const int l = r / 1024, q = r % 1024; tr_job(q, args.in[I_XA_WKV] + (size_t)l * 2097152, 1024, 2048, 2048, 0, 0, nullptr, (bf16*)(ws + WS_W_KV) + (size_t)l * 2097152, scr, lane); continue; } r -= J4;
        if (r < J5) { const int l = r / 512, q = r % 512; tr_job(q, args.in[I_XA_WO] + (size_t)l * 1048576, 1024, 1024, 1024, 0, 0, nullptr, (bf16*)(ws + WS_W_OT) + (size_t)l * 1048576, scr, lane); continue; } r -= J5;
        if (r < J6) { const int le = r / 512, q = r % 512; tr_job(q, args.in[I_MOE_W_GU] + (size_t)le * 1048576, 1024, 1024, 1024, 1, 512, nmoe + (le >> 4) * 1024, (unsigned char*)(ws + WS_W_GU) + (size_t)le * 1048576, scr, lane, 1, W8_GU_SCALE); continue; } r -= J6;
        { const int le = r / 256, q = r % 256; tr_job(q, args.in[I_MOE_W_DOWN] + (size_t)le * 524288, 512, 1024, 1024, 0, 0, nullptr, (unsigned char*)(ws + WS_W_DOWN) + (size_t)le * 524288, scr, lane, 1, W8_DOWN_SCALE); }
    }
    constexpr int R_WQ = 2048, R_MEMN = 2 * NMR, R_WRB = 2 * 128, R_SPL = 1;
    constexpr int NROWS = R_WQ + R_MEMN + R_WRB + R_SPL;
    for (int it = gw; it < NROWS; it += NGW) {
        int r = it;
        if (r < R_WQ) {
            const int l = r >> 10, d = r & 1023; const float gsc = nxat[l * 1024 + d] * (LOG2E / 16.0f);
            const f32x4* src = (const f32x4*)(args.in[I_XA_WQ] + (size_t)r * 1024) + lane; u32x2* dst = (u32x2*)((bf16*)(ws + WS_W_Q) + (size_t)r * 1024) + lane;
#pragma unroll
            for (int j = 0; j < 4; ++j) { const f32x4 v = src[64 * j] * gsc; dst[64 * j] = (u32x2){pk2(v[0], v[1]), pk2(v[2], v[3])}; }
            continue; } r -= R_WQ;
        if (r < R_MEMN) {
            const int l = r / NMR, row = r % NMR; f32x4 v[4]; const float ss = row_sumsq_f32(args.in[I_MEM] + (size_t)row * 1024, lane, v);
            const float rs = __builtin_amdgcn_rsqf(ss * (1.0f / 1024.0f) + EPS);
            const f32x4* gp = (const f32x4*)(nmem + l * 1024) + lane; u32x2* dst = (u32x2*)((bf16*)(ws + WS_MEMN) + (size_t)r * 1024) + lane;
#pragma unroll
            for (int j = 0; j < 4; ++j) { const f32x4 o = v[j] * gp[64 * j] * rs; dst[64 * j] = (u32x2){pk2(o[0], o[1]), pk2(o[2], o[3])}; }
            continue; } r -= R_MEMN;
        if (r < R_WRB) {
            const int l = r >> 7, blk = r & 127;
            bf16* dst = (bf16*)(ws + WS_WRB) + (size_t)l * 65536 + blk * 512;
#pragma unroll
            for (int e8 = 0; e8 < 8; ++e8) { const int idx = blk * 512 + e8 * 64 + lane; const int jj = idx & 7, ln = (idx >> 3) & 63, ks = (idx >> 9) & 31, tl = idx >> 14;
                const int col = (tl & 1) * 16 + (ln & 15), d = 32 * ks + 8 * (ln >> 4) + jj;
                float w = 0.f;
                if (col < 4) w = args.in[I_MOE_WG][(size_t)l * 4096 + d * 4 + col];
                else if (col < 20) w = args.in[I_MOE_WE][(((size_t)l * 4 + ((col - 4) >> 2)) * 1024 + d) * 4 + ((col - 4) & 3)];
                w *= nmoe[l * 1024 + d];
                const unsigned hi = f2bf(w); const float lo = w - __builtin_bit_cast(float, hi << 16);
                dst[e8 * 64 + lane] = (bf16)((tl < 2) ? hi : f2bf(lo)); }
            continue; } r -= R_WRB;
        {
#pragma unroll
            for (int j = 0; j < 16; ++j) { const int c = j * 64 + lane; const float lam = args.in[I_RG_LAMBDA][c]; const float z = -lam;
                ((float*)(ws + WS_SPL))[c] = (z > 20.f) ? z : log1pf(expf(z)); }
        }
    }
}

template <int W> __device__ __forceinline__ void pool_step(f32x4 (&hist)[W], f32x4& sum, const f32x4 cur, const int i, const int cnt_s, const f32x4 gm, u32x2* dst) {
    sum += cur; const int cnt = cnt_s < W ? cnt_s : W; const f32x4 p = (sum * (1.0f / (float)cnt) - cur) * gm; *dst = (u32x2){pk2(p[0], p[1]), pk2(p[2], p[3])};
    hist[i % W] = cur; sum -= hist[(i + 1) % W];
}
constexpr int PBR = 2;
__device__ __forceinline__ void pool_loadn(const float* __restrict__ xb, int s, int nrow, f32x4 (&v)[PBR][4]) {
#pragma unroll
    for (int r = 0; r < PBR; ++r) if (r < nrow) {
        if (s + r >= 0) {
#pragma unroll
            for (int g = 0; g < 4; ++g) v[r][g] = *(const f32x4*)(xb + (size_t)(s + r) * D + g * 256);
        } else {
#pragma unroll
            for (int g = 0; g < 4; ++g) v[r][g] = (f32x4){0.f, 0.f, 0.f, 0.f};
        } }
#pragma unroll
    for (int r = 0; r < PBR; ++r) if (r < nrow) { float ss = 0.f;
#pragma unroll
        for (int g = 0; g < 4; ++g) ss += (v[r][g][0] * v[r][g][0] + v[r][g][1] * v[r][g][1]) + (v[r][g][2] * v[r][g][2] + v[r][g][3] * v[r][g][3]);
        const float rs = __builtin_amdgcn_rsqf(wave_sum(ss) * (1.0f / 1024.0f) + EPS);
#pragma unroll
        for (int g = 0; g < 4; ++g) v[r][g] *= rs; }
}
__device__ __forceinline__ void pool_run(const float* __restrict__ xb, bf16* __restrict__ prow, const int s0, const f32x4 (&gm)[4], const int lane) {
    f32x4 h0[2], h1[4], h2[8], h3[16], sum[4];
#pragma unroll
    for (int g = 0; g < 4; ++g) sum[g] = (f32x4){0.f, 0.f, 0.f, 0.f};
#pragma unroll
    for (int jb = 15; jb >= 1; jb -= PBR) { const int nrow = jb >= PBR ? PBR : jb; f32x4 v[PBR][4]; pool_loadn(xb, s0 - jb, nrow, v);
#pragma unroll
        for (int r = 0; r < PBR; ++r) if (r < nrow) { const int j = jb - r;
            if (j < 2) { h0[(16 - j) % 2] = v[r][0]; sum[0] += v[r][0]; }
            if (j < 4) { h1[(16 - j) % 4] = v[r][1]; sum[1] += v[r][1]; }
            if (j < 8) { h2[(16 - j) % 8] = v[r][2]; sum[2] += v[r][2]; }
            { h3[(16 - j) % 16] = v[r][3]; sum[3] += v[r][3]; } } }
#pragma unroll
    for (int ib = 0; ib < 16; ib += PBR) { f32x4 v[PBR][4]; pool_loadn(xb, s0 + ib, PBR, v);
#pragma unroll
        for (int r = 0; r < PBR; ++r) { const int i = ib + r, s = s0 + i; u32x2* dst = (u32x2*)(prow + (size_t)i * D) + lane;
            pool_step<2>(h0, sum[0], v[r][0], i, s + 1, gm[0], dst);
            pool_step<4>(h1, sum[1], v[r][1], i, s + 1, gm[1], dst + 64);
            pool_step<8>(h2, sum[2], v[r][2], i, s + 1, gm[2], dst + 128);
            pool_step<16>(h3, sum[3], v[r][3], i, s + 1, gm[3], dst + 192); } }
}
__device__ __forceinline__ void phase_pool_p(Frame& F, const Args& args) {
    const int gw = F.vcu * 8 + F.wave, NGW = F.G * 8, lane = F.lane;
    bf16* P0 = (bf16*)(F.ob + OB_P0);
    f32x4 gm[4];
#pragma unroll
    for (int g = 0; g < 4; ++g) gm[g] = *(const f32x4*)(args.in[I_NORM_MIX] + g * 256 + 4 * lane);
    for (int it = gw; it < NB * (SEQ / 16); it += NGW) {
        const int b = it >> 7, s0 = (it & 127) * 16;
        pool_run(args.in[I_X] + (size_t)b * SEQ * D + 4 * lane, P0 + ((size_t)b * SEQ + s0) * D, s0, gm, lane);
    }
}

struct SchedKV {
    int G, c; const char* A; const char* B; char* Kb; char* Vb;
    __device__ __forceinline__ bool next(int i, pg8::Unit& u) const { int pm, pn; if (!pg8::tile_of(i, G, c, 32, 8, pm, pn)) return false;
        const int l = pm >> 4; u.A = A + (size_t)pm * 256 * 2048; u.B = B + (size_t)l * 4194304 + (size_t)pn * 256 * 2048;
        u.C = ((pn < 4) ? Kb : Vb) + ((size_t)l * 4096 + (size_t)(pm & 15) * 256) * 2048 + (size_t)(pn & 3) * 512; u.row0 = pm * 256; u.col0 = pn * 256; u.aux = i; return true; }
};
struct SchedMVW {
    int G, c; const char* Kl; const char* Vl; const char* Wq; const char* Wot; char* BS; char* BO;
    __device__ __forceinline__ bool next(int i, pg8::Unit& u) const { int pm, pn; if (!pg8::tile_of(i, G, c, 128, 4, pm, pn)) return false;
        const int kind = pm >> 6, bh = pm & 63, b = bh >> 2, h = bh & 3;
        if (kind == 0) { u.A = Kl + ((size_t)b * 256) * 2048 + h * 512; u.B = Wq + ((size_t)pn * 256) * 2048 + h * 512; u.C = BS + (size_t)b * 2097152 + ((size_t)h * 256) * 2048 + pn * 512; }
        else { u.A = Wot + ((size_t)pn * 256) * 2048 + h * 512; u.B = Vl + ((size_t)b * 256) * 2048 + h * 512; u.C = BO + (size_t)b * 2097152 + ((size_t)pn * 256) * 2048 + h * 512; }
        u.row0 = 0; u.col0 = 0; u.aux = i; return true; }
};
struct SchedDense {
    int G, c, nN; const char* A; size_t apan; size_t acol; int adiv; const char* B; size_t bpn; size_t bbatch; int cmul;
    __device__ __forceinline__ bool next(int i, pg8::Unit& u) const { int pm, pn; if (!pg8::tile_of(i, G, c, NTOK / 256, nN, pm, pn)) return false;
        u.A = A + (size_t)pm * apan + (size_t)(pn / adiv) * acol; u.B = B + (size_t)pn * bpn + (size_t)(pm >> 3) * bbatch; u.C = nullptr; u.row0 = pm * 256; u.col0 = pn * cmul; u.aux = i; return true; }
};
struct SchedMoE {
    int G, c, nT; int tpre[17]; const char* A; size_t atile; const char* B; size_t bexp, bpn;
    __device__ __forceinline__ int expert_of(int tile) const { int e = 0;
#pragma unroll
        for (int k = 1; k < 16; ++k) e += (tile >= tpre[k]) ? 1 : 0;
        return e; }
    __device__ __forceinline__ int first_tile(int e) const { int t = 0;
#pragma unroll
        for (int k = 1; k < 16; ++k) t = (k == e) ? tpre[k] : t;
        return t; }
    __device__ __forceinline__ bool next(int i, pg8::Unit& u) const { int tile, pn; if (!pg8::tile_of(i, G, c, nT, 4, tile, pn)) return false;
        const int e = expert_of(tile);
        u.A = A + (size_t)tile * atile; u.B = B + (size_t)e * bexp + (size_t)pn * bpn; u.C = nullptr; u.row0 = tile * 256; u.col0 = pn * 256; u.aux = i; return true; }
};
__device__ __forceinline__ void moe_sched_init(SchedMoE& S, Frame& F, int l) {
    const unsigned* cnt = (const unsigned*)(F.ws + WS_CTL) + CW_CNT + l * 16 * 64;
    unsigned n[16];
#pragma unroll
    for (int e = 0; e < 16; ++e) n[e] = __hip_atomic_load(cnt + e * 64, __ATOMIC_RELAXED, __HIP_MEMORY_SCOPE_AGENT);
    int acc = 0;
#pragma unroll
    for (int e = 0; e < 16; ++e) { S.tpre[e] = acc; acc += ((int)__builtin_amdgcn_readfirstlane(n[e]) + 255) >> 8; }
    S.tpre[16] = acc; S.nT = acc; S.G = F.G; S.c = (int)blockIdx.x;
}
__device__ __forceinline__ void moe_fill_tables(const SchedMoE& S, Frame& F, int l, int mode) {
    const int* list = (const int*)(F.ws + WS_LIST); const float* rstd = (const float*)(F.ws + WS_RSTD_B); const float* gwv = (const float*)(F.ws + WS_GW);
    LAS int* tab = (LAS int*)(F.lds + TAB_OFF); LAS float* tab2 = (LAS float*)(F.lds + TAB2_OFF);
    const unsigned* cntp = (const unsigned*)(F.ws + WS_CTL) + CW_CNT + l * 16 * 64;
    if (F.tid < 256) {
        unsigned n[16];
#pragma unroll
        for (int e = 0; e < 16; ++e) n[e] = __hip_atomic_load(cntp + e * 64, __ATOMIC_RELAXED, __HIP_MEMORY_SCOPE_AGENT);
        int slot[MAXU]; bool valid[MAXU]; bool have[MAXU]; float aux[MAXU];
#pragma unroll
        for (int j = 0; j < MAXU; ++j) { pg8::Unit u; have[j] = S.next(j, u); slot[j] = 0; valid[j] = false;
            if (have[j]) { const int tile = u.row0 >> 8, e = S.expert_of(tile), tl = tile - S.first_tile(e), pos = tl * 256 + F.tid; int ne = (int)n[0];
#pragma unroll
                for (int k = 1; k < 16; ++k) ne = (k == e) ? (int)n[k] : ne;
                valid[j] = pos < ne;
                slot[j] = list[(size_t)e * NTOK + (valid[j] ? pos : 0)]; } }
#pragma unroll
        for (int j = 0; j < MAXU; ++j) { aux[j] = 0.f; if (have[j]) aux[j] = (mode == 0) ? rstd[slot[j] >> 1] : gwv[slot[j]]; }
#pragma unroll
        for (int j = 0; j < MAXU; ++j) if (have[j]) { tab[j * 256 + F.tid] = (mode == 0) ? (slot[j] >> 1) : (valid[j] ? slot[j] : -1); tab2[j * 256 + F.tid] = aux[j]; }
    }
    __syncthreads();
}

template <class Sched> __device__ __forceinline__ void fill_row_scale(const Sched& S, Frame& F, const float* src, int mode) {
    LAS float* tab2 = (LAS float*)(F.lds + TAB2_OFF);
    if (F.tid < 256) {
#pragma unroll
        for (int j = 0; j < MAXU; ++j) { pg8::Unit u; if (S.next(j, u)) { const int row = u.row0 + F.tid; float r;
            if (mode == 0) { const f32x4* sp = (const f32x4*)(src + (size_t)row * 16); const f32x4 qs = (sp[0] + sp[1]) + (sp[2] + sp[3]); r = __builtin_amdgcn_rsqf(((qs[0] + qs[1]) + (qs[2] + qs[3])) * (1.0f / 1024.0f) + EPS); }
            else r = src[row];
            tab2[j * 256 + F.tid] = r; } }
    }
    __syncthreads();
}

__device__ __forceinline__ void phase_router(Frame& F, const Args& args, int l, const bf16* H) {
    { const u32x4* src = (const u32x4*)(F.ws + WS_WRB + (size_t)l * 131072); LAS u32x4* dst = (LAS u32x4*)(F.lds + RING_OFF);
      u32x4 t[16];
#pragma unroll
      for (int i = 0; i < 16; ++i) t[i] = src[F.tid + 512 * i];
#pragma unroll
      for (int i = 0; i < 16; ++i) dst[F.tid + 512 * i] = t[i]; }
    __syncthreads();
    LAS float* lgs = (LAS float*)(F.lds + TAB_OFF) + F.wave * 336;
    LAS int* sel_e = (LAS int*)(F.lds + XCH_OFF); LAS float* sel_w = (LAS float*)(F.lds + XCH_OFF + 1024);
    LAS int* lcnt = (LAS int*)(F.lds + XCH_OFF + 2048); LAS int* lbase = lcnt + 16; LAS int* rnk = (LAS int*)(F.lds + XCH_OFF + 3072);
    unsigned* gcnt = (unsigned*)(F.ws + WS_CTL) + CW_CNT + l * 16 * 64;
    int* list = (int*)(F.ws + WS_LIST); float* gwv = (float*)(F.ws + WS_GW); float* rstd = (float*)(F.ws + WS_RSTD_B);
    const float* bg = args.in[I_MOE_BG] + l * 4; const float* be = args.in[I_MOE_BE] + l * 16;
    const int lane = F.lane, fr = lane & 15, fq = lane >> 4;
    for (int tb = F.vcu; tb < NTOK / 128; tb += F.G) {
        const int t0 = tb * 128 + F.wave * 16;
        const bf16* hp = H + (size_t)(t0 + fr) * 1024 + 8 * fq;
        f32x4 acc0 = {0.f, 0.f, 0.f, 0.f}, acc1 = {0.f, 0.f, 0.f, 0.f}; float ssq = 0.f;
        if (F.tid < 16) lcnt[F.tid] = 0;
#pragma unroll 16
        for (int ks = 0; ks < 32; ++ks) {
            const u32x4 av = *(const u32x4*)(hp + ks * 32);
            f32x4 x0, x1; unpack8(av, x0, x1); ssq += (x0[0] * x0[0] + x0[1] * x0[1]) + (x0[2] * x0[2] + x0[3] * x0[3]) + (x1[0] * x1[0] + x1[1] * x1[1]) + (x1[2] * x1[2] + x1[3] * x1[3]);
            const bf16x8 a = __builtin_bit_cast(bf16x8, av);
            const LAS bf16x8* bp = (const LAS bf16x8*)(F.lds + RING_OFF) + ks * 64 + lane;
            const bf16x8 b0 = bp[0], b1 = bp[2048], b2 = bp[4096], b3 = bp[6144];
            acc0 = __builtin_amdgcn_mfma_f32_16x16x32_bf16(a, b0, acc0, 0, 0, 0); acc0 = __builtin_amdgcn_mfma_f32_16x16x32_bf16(a, b2, acc0, 0, 0, 0);
            acc1 = __builtin_amdgcn_mfma_f32_16x16x32_bf16(a, b1, acc1, 0, 0, 0); acc1 = __builtin_amdgcn_mfma_f32_16x16x32_bf16(a, b3, acc1, 0, 0, 0);
        }
        ssq += __shfl_xor(ssq, 16); ssq += __shfl_xor(ssq, 32);
#pragma unroll
        for (int rg = 0; rg < 4; ++rg) { lgs[(4 * fq + rg) * 21 + fr] = acc0[rg]; if (fr < 4) lgs[(4 * fq + rg) * 21 + 16 + fr] = acc1[rg]; }
        LDS_WAIT(); asm volatile("" ::: "memory");
        if (lane < 16) {
            const float rs = __builtin_amdgcn_rsqf(ssq * (1.0f / 1024.0f) + EPS);
            const LAS float* lg = lgs + lane * 21;
            float g0 = lg[0] * rs + bg[0], g1 = lg[1] * rs + bg[1], g2 = lg[2] * rs + bg[2], g3 = lg[3] * rs + bg[3];
            int g = 0; float gm = g0; if (g1 > gm) { gm = g1; g = 1; } if (g2 > gm) { gm = g2; g = 2; } if (g3 > gm) { gm = g3; g = 3; }
            const float gp = 1.0f / (expf(g0 - gm) + expf(g1 - gm) + expf(g2 - gm) + expf(g3 - gm));
            float le[4];
#pragma unroll
            for (int k = 0; k < 4; ++k) le[k] = lg[4 + 4 * g + k] * rs + be[4 * g + k];
            int e1 = 0; float m1 = le[0];
#pragma unroll
            for (int k = 1; k < 4; ++k) if (le[k] > m1) { m1 = le[k]; e1 = k; }
            int e2 = -1; float m2 = -3.0e38f;
#pragma unroll
            for (int k = 0; k < 4; ++k) if (k != e1 && le[k] > m2) { m2 = le[k]; e2 = k; }
            const float z = expf(m2 - m1); const float q1 = 1.0f / (1.0f + z), q2 = z * q1;
            const int tl = F.wave * 16 + lane;
            sel_e[2 * tl] = 4 * g + e1; sel_e[2 * tl + 1] = 4 * g + e2; sel_w[2 * tl] = gp * q1; sel_w[2 * tl + 1] = gp * q2;
            rstd[t0 + lane] = rs;
        }
        __syncthreads();
        int my_e = 0;
        if (F.tid < 256) { my_e = sel_e[F.tid]; rnk[F.tid] = __hip_atomic_fetch_add(&lcnt[my_e], 1, __ATOMIC_RELAXED, __HIP_MEMORY_SCOPE_WORKGROUP); }
        __syncthreads();
        if (F.tid < 16) { const int n = lcnt[F.tid]; lbase[F.tid] = n ? (int)__hip_atomic_fetch_add(gcnt + F.tid * 64, (unsigned)n, __ATOMIC_RELAXED, __HIP_MEMORY_SCOPE_AGENT) : 0; }
        __syncthreads();
        if (F.tid < 256) { const int pos = lbase[my_e] + rnk[F.tid]; const int slot = tb * 256 + F.tid; list[(size_t)my_e * NTOK + pos] = slot; gwv[slot] = sel_w[F.tid]; }
        __syncthreads();
    }
}

__device__ __forceinline__ void phase_combine(Frame& F, const Args& args, int mode, const bf16* H, bf16* Hout, float* outf) {
    const int gw = F.vcu * 8 + F.wave, NGW = F.G * 8, lane = F.lane;
    const bf16* Y = (const bf16*)(F.ws + WS_Y); float* rstd = (float*)(F.ws + WS_RSTD_A);
    f32x4 gf[4];
    if (mode == 1) {
#pragma unroll
        for (int hf = 0; hf < 2; ++hf) { gf[2 * hf] = *(const f32x4*)(args.in[I_NORM_FINAL] + hf * 512 + 8 * lane); gf[2 * hf + 1] = *(const f32x4*)(args.in[I_NORM_FINAL] + hf * 512 + 8 * lane + 4); }
    }
    for (int t0 = gw; t0 < NTOK; t0 += 2 * NGW) {
        u32x4 hv[2][2], y0[2][2], y1[2][2];
#pragma unroll
        for (int q = 0; q < 2; ++q) { const int t = (t0 + q * NGW < NTOK) ? t0 + q * NGW : t0;
#pragma unroll
            for (int hf = 0; hf < 2; ++hf) { const size_t off = hf * 512 + 8 * lane;
                hv[q][hf] = *(const u32x4*)(H + (size_t)t * 1024 + off); y0[q][hf] = *(const u32x4*)(Y + (size_t)(2 * t) * 1024 + off); y1[q][hf] = *(const u32x4*)(Y + (size_t)(2 * t + 1) * 1024 + off); } }
#pragma unroll
        for (int q = 0; q < 2; ++q) { const int t = t0 + q * NGW; if (t >= NTOK) break;
            f32x4 v[4]; float ss = 0.f;
#pragma unroll
            for (int hf = 0; hf < 2; ++hf) {
                f32x4 a, b, c, d, e, f; unpack8(hv[q][hf], a, b); unpack8(y0[q][hf], c, d); unpack8(y1[q][hf], e, f); a += c + e; b += d + f; v[2 * hf] = a; v[2 * hf + 1] = b;
                ss += (a[0] * a[0] + a[1] * a[1]) + (a[2] * a[2] + a[3] * a[3]) + (b[0] * b[0] + b[1] * b[1]) + (b[2] * b[2] + b[3] * b[3]); }
            ss = wave_sum(ss);
            const float rs = __builtin_amdgcn_rsqf(ss * (1.0f / 1024.0f) + EPS);
            if (mode == 0) {
#pragma unroll
                for (int hf = 0; hf < 2; ++hf) *(u32x4*)(Hout + (size_t)t * 1024 + hf * 512 + 8 * lane) = pack8(v[2 * hf], v[2 * hf + 1]);
                if (lane == 0) rstd[t] = rs;
            } else {
#pragma unroll
                for (int hf = 0; hf < 2; ++hf) { float* op = outf + (size_t)t * 1024 + hf * 512 + 8 * lane; *(f32x4*)op = v[2 * hf] * gf[2 * hf] * rs; *(f32x4*)(op + 4) = v[2 * hf + 1] * gf[2 * hf + 1] * rs; }
            }
        }
    }
}

__device__ __forceinline__ void phase_conv(Frame& F, const Args& args, const bf16* XB, bf16* XC) {
    const int gw = F.vcu * 8 + F.wave, NGW = F.G * 8, lane = F.lane;
    const float* cw = args.in[I_RG_CONV_W]; const float* cbv = args.in[I_RG_CONV_B];
    for (int hf = 0; hf < 2; ++hf) {
        const int c0 = hf * 512 + 8 * lane;
        f32x4 w[4][2], cb[2];
#pragma unroll
        for (int k = 0; k < 4; ++k) { w[k][0] = *(const f32x4*)(cw + k * 1024 + c0); w[k][1] = *(const f32x4*)(cw + k * 1024 + c0 + 4); }
        cb[0] = *(const f32x4*)(cbv + c0); cb[1] = *(const f32x4*)(cbv + c0 + 4);
        for (int it = gw; it < NB * (SEQ / 16); it += NGW) {
            const int b = it >> 7, s0 = (it & 127) * 16; const bf16* xp = XB + (size_t)b * SEQ * D + c0; bf16* op = XC + (size_t)b * SEQ * D + c0;
            f32x4 xm[3][2];
#pragma unroll
            for (int j = 0; j < 3; ++j) { const int s = s0 - 3 + j; if (s >= 0) { const u32x4 v = *(const u32x4*)(xp + (size_t)s * D); unpack8(v, xm[j][0], xm[j][1]); } else { xm[j][0] = (f32x4){0.f, 0.f, 0.f, 0.f}; xm[j][1] = xm[j][0]; } }
#pragma unroll 4
            for (int s = s0; s < s0 + 16; ++s) { const u32x4 v = *(const u32x4*)(xp + (size_t)s * D); f32x4 x0, x1; unpack8(v, x0, x1);
                const f32x4 o0 = cb[0] + w[0][0] * xm[0][0] + w[1][0] * xm[1][0] + w[2][0] * xm[2][0] + w[3][0] * x0;
                const f32x4 o1 = cb[1] + w[0][1] * xm[0][1] + w[1][1] * xm[1][1] + w[2][1] * xm[2][1] + w[3][1] * x1;
                *(u32x4*)(op + (size_t)s * D) = pack8(o0, o1);
                xm[0][0] = xm[1][0]; xm[0][1] = xm[1][1]; xm[1][0] = xm[2][0]; xm[1][1] = xm[2][1]; xm[2][0] = x0; xm[2][1] = x1; }
        }
    }
}

constexpr int NSEG = 16, SEGL = SEQ / NSEG;
__device__ __forceinline__ void phase_scan1(Frame& F) {
    const int gw = F.vcu * 8 + F.wave, NGW = F.G * 8, lane = F.lane;
    const bf16* LA = (const bf16*)(F.ob + OB_LOGA); const bf16* BT = (const bf16*)(F.ob + OB_BT);
    float* AGS = (float*)(F.ws + WS_AGS); float* AGB = (float*)(F.ws + WS_AGB);
    for (int it = gw; it < NB * NSEG * 8; it += NGW) {
        const int cg = it & 7, sg = (it >> 3) & (NSEG - 1), b = it >> 7; const int ch = cg * 128 + 2 * lane;
        const size_t r0 = ((size_t)b * SEQ + sg * SEGL) * D + ch;
        float h0 = 0.f, h1 = 0.f, s0 = 0.f, s1 = 0.f;
#pragma unroll 16
        for (int s = 0; s < SEGL; ++s) { const unsigned lv = *(const unsigned*)(LA + r0 + (size_t)s * D), bv = *(const unsigned*)(BT + r0 + (size_t)s * D);
            const float l0 = bflo(lv), l1 = bfhi(lv); s0 += l0; s1 += l1;
            h0 = fast_exp2(l0 * LOG2E) * h0 + bflo(bv); h1 = fast_exp2(l1 * LOG2E) * h1 + bfhi(bv); }
        const size_t ao = ((size_t)b * NSEG + sg) * 1024 + ch;
        *(f32x2*)(AGS + ao) = (f32x2){s0, s1}; *(f32x2*)(AGB + ao) = (f32x2){h0, h1};
    }
}
__device__ __forceinline__ void scan2_item(const bf16* __restrict__ LA, const bf16* __restrict__ BT, const bf16* __restrict__ GATE, bf16* __restrict__ YRG, const float* __restrict__ AGS, const float* __restrict__ AGB, int it, int lane) {
    const int cg = it & 7, sg = (it >> 3) & (NSEG - 1), b = it >> 7; const int ch = cg * 128 + 2 * lane;
    f32x2 as[NSEG - 1], ab[NSEG - 1];
#pragma unroll
    for (int c = 0; c < NSEG - 1; ++c) { const size_t ao = ((size_t)b * NSEG + c) * 1024 + ch; as[c] = *(const f32x2*)(AGS + ao); ab[c] = *(const f32x2*)(AGB + ao); }
    float h0 = 0.f, h1 = 0.f;
#pragma unroll
    for (int c = 0; c < NSEG - 1; ++c) if (c < sg) { h0 = fast_exp2(as[c].x * LOG2E) * h0 + ab[c].x; h1 = fast_exp2(as[c].y * LOG2E) * h1 + ab[c].y; }
    const size_t r0 = ((size_t)b * SEQ + sg * SEGL) * D + ch;
#pragma nounroll
    for (int sb = 0; sb < SEGL; sb += 16) {
        unsigned lv[16], bv[16], gv[16];
#pragma unroll
        for (int k = 0; k < 16; ++k) { const size_t o = r0 + (size_t)(sb + k) * D; lv[k] = *(const unsigned*)(LA + o); bv[k] = *(const unsigned*)(BT + o); gv[k] = *(const unsigned*)(GATE + o); }
#pragma unroll
        for (int k = 0; k < 16; ++k) { h0 = fast_exp2(bflo(lv[k]) * LOG2E) * h0 + bflo(bv[k]); h1 = fast_exp2(bfhi(lv[k]) * LOG2E) * h1 + bfhi(bv[k]);
            *(unsigned*)(YRG + r0 + (size_t)(sb + k) * D) = cvt_pk_bf16(h0 * bflo(gv[k]), h1 * bfhi(gv[k])); }
    }
}
__device__ __forceinline__ void phase_scan2(Frame& F, const bf16* GATE, bf16* YRG) {
    const int gw = F.vcu * 8 + F.wave, NGW = F.G * 8;
    for (int it = gw; it < NB * NSEG * 8; it += NGW)
        scan2_item((const bf16*)(F.ob + OB_LOGA), (const bf16*)(F.ob + OB_BT), GATE, YRG, (const float*)(F.ws + WS_AGS), (const float*)(F.ws + WS_AGB), it, F.lane);
}

#if MK_PER_PHASE
#define GRID_BAR() do { } while (0)
#else
#if MK_TSEL >= 0
#define GRID_BAR() do { volatile LAS unsigned* _m = (volatile LAS unsigned*)(F.lds + MISC_OFF); const unsigned _t0 = (unsigned)__builtin_amdgcn_s_memrealtime(); xcd_barrier(bar); \
    if (threadIdx.x == 0) { const unsigned _k = _m[16]; const unsigned _t1 = (unsigned)__builtin_amdgcn_s_memrealtime(); if ((int)_k == MK_TSEL && !MK_GMODE) _m[18] = MK_TWAIT ? (_t1 - _t0) : (_t0 - _m[17]); _m[17] = _t1; _m[16] = _k + 1u; } } while (0)
#else
#define GRID_BAR() xcd_barrier(bar)
#endif
#endif
#ifndef MK_MASK
#define MK_MASK 0x1fffffu
#endif
#define IN(k) ((((MK_MASK) >> (k)) & 1u) && lo <= (k) && (k) < hi)
#define SEAM(k) do { if (lo <= (k) + 1 && (k) + 1 < hi) GRID_BAR(); } while (0)
#ifndef MK_DUP
#define MK_DUP 0u
#endif

template <int L>
__device__ __forceinline__ void mvw_gemm(Frame& F) {
    unsigned char* ws = F.ws;
    SchedMVW S{F.G, (int)blockIdx.x, (const char*)(ws + WS_K) + (size_t)L * 8388608, (const char*)(ws + WS_V) + (size_t)L * 8388608,
               (const char*)(ws + WS_W_Q) + (size_t)L * 2097152, (const char*)(ws + WS_W_OT) + (size_t)L * 2097152, (char*)(ws + WS_BS), (char*)(ws + WS_BO)};
    pg8::EpiPlain E{1024};
    pg8::gemm_phase<pg8::EpiPlain, SchedMVW, false>(F.lds + RING_OFF, 256, 2048u, 2048u, S, E, (LAS int*)(F.lds + TAB_OFF));
}
template <int L>
__device__ __forceinline__ void layer_phases(Frame& F, const Args& args, const XcdBarrier& bar, const int lo, const int hi) {
    unsigned char* ws = F.ws;
    LAS int* tab = (LAS int*)(F.lds + TAB_OFF); LAS float* tab2 = (LAS float*)(F.lds + TAB2_OFF);
    float* ss16 = (float*)(ws + WS_SS16);
    constexpr int ps = (L == 0) ? 3 : 15;
    if constexpr (L == 0) {
        if (IN(2)) {
            mvw_gemm<0>(F);
            SchedDense S{F.G, (int)blockIdx.x, 4, (const char*)(F.ob + OB_P0), (size_t)256 * 2048, (size_t)512, 1, (const char*)(ws + WS_W_POOL), (size_t)131072, 0, 256};
            pg8::EpiPool E{args.in[I_X], args.in[I_POOL_SCALE], (bf16*)(ws + WS_HA), ss16};
            pg8::gemm_phase<pg8::EpiPool, SchedDense, false>(F.lds + RING_OFF, 256, 2048u, 512u, S, E, tab);
            SEAM(2);
        }
    } else {
        const bf16* h3 = (const bf16*)(ws + WS_HA);
        bf16* XB = (bf16*)(ws + WS_HB); bf16* GATE = (bf16*)(ws + WS_Y); bf16* XC = (bf16*)(ws + WS_Y + 64 * MiB); bf16* YRG = (bf16*)(ws + WS_HB); bf16* HC = (bf16*)(ws + WS_Y);
        if (IN(9)) {
            SchedDense S{F.G, (int)blockIdx.x, 8, (const char*)h3, (size_t)256 * 2048, 0, 1, (const char*)(ws + WS_W_IN), (size_t)256 * 2048, 0, 256};
            fill_row_scale(S, F, (const float*)(ws + WS_RSTD_A), 1);
            pg8::EpiIn E{XB, GATE, tab2};
            pg8::gemm_phase<pg8::EpiIn, SchedDense, false>(F.lds + RING_OFF, 1024, 2048u, 2048u, S, E, tab);
            SEAM(9);
        }
        if (IN(10)) { phase_conv(F, args, XB, XC); SEAM(10); }
        if (IN(11)) {
            SchedDense S{F.G, (int)blockIdx.x, 8, (const char*)XC, (size_t)256 * 2048, (size_t)512, 2, (const char*)(ws + WS_W_GATE), (size_t)131072, 0, 128};
            pg8::EpiGates E{XC, (bf16*)(F.ob + OB_LOGA), (bf16*)(F.ob + OB_BT), args.in[I_RG_B_GATE], (const float*)(ws + WS_SPL)};
            pg8::gemm_phase<pg8::EpiGates, SchedDense, false>(F.lds + RING_OFF, 256, 2048u, 512u, S, E, tab);
            SEAM(11);
        }
        if (IN(12)) { phase_scan1(F); SEAM(12); }
        if (IN(13)) { phase_scan2(F, GATE, YRG); SEAM(13); }
        if (IN(14)) {
            SchedDense S{F.G, (int)blockIdx.x, 4, (const char*)YRG, (size_t)256 * 2048, 0, 1, (const char*)(ws + WS_W_OUT), (size_t)256 * 2048, 0, 256};
            pg8::EpiRes<true> E{h3, HC, ss16, nullptr};
            pg8::gemm_phase<pg8::EpiRes<true>, SchedDense, false>(F.lds + RING_OFF, 1024, 2048u, 2048u, S, E, tab);
            SEAM(14);
        }
    }
    const bf16* hmix = (L == 0) ? (const bf16*)(ws + WS_HA) : (const bf16*)(ws + WS_Y);
    bf16* hatt = (L == 0) ? (bf16*)(ws + WS_HB) : (bf16*)(ws + WS_HA);
    bf16* PATT = (bf16*)(F.ob + OB_PATT);
    if (IN(ps)) {
        SchedDense S{F.G, (int)blockIdx.x, 4, (const char*)hmix, (size_t)256 * 2048, 0, 1, (const char*)(ws + WS_BS), (size_t)256 * 2048, (size_t)2097152, 256};
        fill_row_scale(S, F, ss16, 0);
        pg8::EpiS E{PATT, tab2, (LAS f32x2*)(F.lds + XCH_OFF)};
        pg8::gemm_phase<pg8::EpiS, SchedDense, false>(F.lds + RING_OFF, 1024, 2048u, 2048u, S, E, tab);
        SEAM(ps);
    }
    if (IN(ps + 1)) {
        SchedDense S{F.G, (int)blockIdx.x, 4, (const char*)PATT, (size_t)256 * 2048, 0, 1, (const char*)(ws + WS_BO), (size_t)256 * 2048, (size_t)2097152, 256};
        pg8::EpiRes<false> E{hmix, hatt, ss16, (unsigned char*)(ws + WS_H8)};
        pg8::gemm_phase<pg8::EpiRes<false>, SchedDense, false>(F.lds + RING_OFF, 1024, 2048u, 2048u, S, E, tab);
        SEAM(ps + 1);
    }
    if (IN(ps + 2)) {
        phase_router(F, args, L, hatt);
        if constexpr (L == 0) { __syncthreads(); mvw_gemm<1>(F); }
        SEAM(ps + 2);
    }
    if (IN(ps + 3)) {
        SchedMoE S; moe_sched_init(S, F, L); S.A = (const char*)(ws + WS_H8); S.atile = 0; S.B = (const char*)(ws + WS_W_GU) + (size_t)L * 16777216; S.bexp = 1048576; S.bpn = (size_t)256 * 1024;
        moe_fill_tables(S, F, L, 0);
        pg8::EpiGU E{(unsigned char*)(F.ob + OB_HMID), tab2};
        pg8::gemm_phase<pg8::EpiGU, SchedMoE, true, true>(F.lds + RING_OFF, 1024, 1024u, 1024u, S, E, tab);
        SEAM(ps + 3);
    }
    if (IN(ps + 4)) {
        SchedMoE S; moe_sched_init(S, F, L); S.A = (const char*)(F.ob + OB_HMID); S.atile = (size_t)256 * 512; S.B = (const char*)(ws + WS_W_DOWN) + (size_t)L * 8388608; S.bexp = 524288; S.bpn = (size_t)256 * 512;
        moe_fill_tables(S, F, L, 1);
        pg8::EpiDown E{(bf16*)(ws + WS_Y), tab, tab2};
        pg8::gemm_phase<pg8::EpiDown, SchedMoE, false, true>(F.lds + RING_OFF, 512, 512u, 512u, S, E, tab);
        SEAM(ps + 4);
    }
    if (IN(ps + 5)) {
        if constexpr (L == 0) { phase_combine(F, args, 0, hatt, (bf16*)(ws + WS_HA), nullptr); SEAM(ps + 5); }
        else phase_combine(F, args, 1, hatt, nullptr, args.out);
    }
}

__global__ void __launch_bounds__(512, 2) hybrid_fwd(Args args) {
    extern __shared__ __attribute__((aligned(16))) unsigned char lds[];
    Frame F;
    F.lds = (LAS unsigned char*)lds;
    F.tid = threadIdx.x; F.lane = F.tid & 63; F.wave = __builtin_amdgcn_readfirstlane(F.tid >> 6);
    F.G = gridDim.x; { const int bx = blockIdx.x; F.vcu = (F.G % 8 == 0) ? (bx % 8) * (F.G / 8) + bx / 8 : bx; }
    F.ws = args.ws; F.ob = (unsigned char*)args.out;
    volatile LAS unsigned* MISC = (volatile LAS unsigned*)(F.lds + MISC_OFF);
    for (int u = F.tid; u < (LDS_BYTES - MISC_OFF) / 4; u += 512) ((LAS unsigned*)(F.lds + MISC_OFF))[u] = 0u;
    __syncthreads();
    unsigned* ctl = (unsigned*)(F.ws + WS_CTL);
#if MK_PER_PHASE
    XcdBarrier bar; bar.bar = ctl + CW_BAR; bar.x = 0; bar.st = nullptr;
#else
    XcdBarrier bar = xcd_barrier_post(ctl + CW_BAR, MISC + 8);
#endif
    const int lo = args.ph_lo, hi = args.ph_hi;
    unsigned char* ws = F.ws;
    LAS int* tab = (LAS int*)(F.lds + TAB_OFF);
#if MK_TSEL >= 0
    if (threadIdx.x == 0) MISC[17] = (unsigned)__builtin_amdgcn_s_memrealtime();
#endif

    if (IN(0)) { phase_prologue(F, args); SEAM(0); }
    if (IN(1)) {
        phase_pool_p(F, args);
        __syncthreads();
        SchedKV S{F.G, (int)blockIdx.x, (const char*)(ws + WS_MEMN), (const char*)(ws + WS_W_KV), (char*)(ws + WS_K), (char*)(ws + WS_V)};
        pg8::EpiPlain E{1024};
        pg8::gemm_phase<pg8::EpiPlain, SchedKV, false>(F.lds + RING_OFF, 1024, 2048u, 2048u, S, E, tab);
        SEAM(1);
    }
    layer_phases<0>(F, args, bar, lo, hi);
    layer_phases<1>(F, args, bar, lo, hi);
#if MK_TSEL >= 0
    if ((int)blockIdx.x == MK_TBLK && threadIdx.x == 0) { const unsigned long long w = (unsigned long long)MISC[18] * MK_TAMP, t0 = __builtin_amdgcn_s_memrealtime();
        while (__builtin_amdgcn_s_memrealtime() - t0 < w) __builtin_amdgcn_s_sleep(8); }
#endif
}
#undef IN
#undef SEAM

extern "C" void kernel_launch(void* const* d_in, const int* in_sizes, int n_in, void* d_out, int out_size, void* d_ws, size_t ws_size, hipStream_t stream) {
    static int grid = 0;
    if (grid == 0) {
        if (n_in != 25 || out_size != NTOK * D || ws_size < WS_END) { fprintf(stderr, "kernel_launch: unexpected shapes (n_in %d, out %d, ws %zu)\n", n_in, out_size, ws_size); grid = -1; return; }
        int dev = 0, cus = 0, per_cu = 0;
        if (hipGetDevice(&dev) != hipSuccess || hipDeviceGetAttribute(&cus, hipDeviceAttributeMultiprocessorCount, dev) != hipSuccess) { grid = -1; return; }
        if (hipFuncSetAttribute((const void*)hybrid_fwd, hipFuncAttributeMaxDynamicSharedMemorySize, LDS_BYTES) != hipSuccess) { fprintf(stderr, "kernel_launch: hipFuncSetAttribute failed\n"); grid = -1; return; }
        if (hipOccupancyMaxActiveBlocksPerMultiprocessor(&per_cu, (const void*)hybrid_fwd, 512, LDS_BYTES) != hipSuccess || per_cu < 1) fprintf(stderr, "kernel_launch: occupancy query reports %d\n", per_cu);
        (void)hipGetLastError();
        grid = cus;
    }
    if (grid < 0) return;
    (void)hipMemsetAsync((char*)d_ws + WS_CTL, 0, CTL_ZERO_BYTES, stream);
    Args a{};
    for (int i = 0; i < 25; ++i) a.in[i] = (const float*)d_in[i];
    a.out = (float*)d_out; a.ws = (unsigned char*)d_ws; a.dup = 0; a.pad = 0;
#if MK_PER_PHASE
    for (int p = 0; p < NPH; ++p) for (int r = 0; r < ((((MK_DUP) >> p) & 1u) ? 2 : 1); ++r) {
        if (r == 1 && (p == 5 || p == 17)) (void)hipMemsetAsync((char*)d_ws + WS_CTL + (size_t)(CW_CNT + (p == 17 ? 1 : 0) * 16 * 64) * 4, 0, 16 * 64 * 4, stream);
        a.ph_lo = p; a.ph_hi = p + 1; hipLaunchKernelGGL(hybrid_fwd, dim3(grid), dim3(512), LDS_BYTES, stream, a); }
#else
    a.ph_lo = 0; a.ph_hi = NPH; hipLaunchKernelGGL(hybrid_fwd, dim3(grid), dim3(512), LDS_BYTES, stream, a);
#endif
}
```

```cpp
#include <hip/hip_runtime.h>
#include <cstdio>
#include <cstdint>

#ifndef MK_KREP
#define MK_KREP 1
#endif
#ifndef MK_TSEL
#define MK_TSEL -1
#endif
#ifndef MK_TBLK
#define MK_TBLK 0
#endif
#ifndef MK_TAMP
#define MK_TAMP 8
#endif
#ifndef MK_TWAIT
#define MK_TWAIT 0
#endif
#ifndef MK_GMODE
#define MK_GMODE 0
#endif
#ifndef MK_PER_PHASE
#define MK_PER_PHASE 0
#endif

#define GAS __attribute__((address_space(1)))
#define LAS __attribute__((address_space(3)))
typedef unsigned short bf16;
typedef short bf16x8 __attribute__((ext_vector_type(8)));
typedef float f32x4 __attribute__((ext_vector_type(4)));
typedef float f32x2 __attribute__((ext_vector_type(2)));
typedef unsigned u32x4 __attribute__((ext_vector_type(4)));
typedef unsigned u32x2 __attribute__((ext_vector_type(2)));

constexpr int NB = 16, SEQ = 2048, D = 1024, NTOK = NB * SEQ, MEML = 256, NMR = NB * MEML;
constexpr int NEXP = 16, DE = 512;
constexpr float EPS = 1e-6f;
constexpr float LOG2E = 1.4426950408889634f;
constexpr int NPH = 21;
constexpr float W8_GU_SCALE = 32.0f, W8_DOWN_SCALE = 16.0f, H8_MID_SCALE = 4.0f;
constexpr float P8_SCALE = 256.0f, BO8_SCALE = 4.0f;

constexpr size_t MiB = 1u << 20;
constexpr size_t WS_CTL = 0, CTL_ZERO_BYTES = 1 * MiB;
constexpr int CW_BAR = 4096;
constexpr int CW_CNT = 16384;
constexpr size_t WS_RSTD_A = 1 * MiB;
constexpr size_t WS_RSTD_B = 1 * MiB + 128 * 1024;
constexpr size_t WS_RSTD_X = 1 * MiB + 256 * 1024;
constexpr size_t WS_SS16 = 2 * MiB;
constexpr size_t WS_WRB = 4 * MiB;
constexpr size_t WS_SPL = 4 * MiB + 256 * 1024;
constexpr size_t WS_GW = 5 * MiB;
constexpr size_t WS_LIST = 6 * MiB;
constexpr size_t WS_W_POOL = 8 * MiB;
constexpr size_t WS_W_GATE = 8 * MiB + 512 * 1024;
constexpr size_t WS_W_OUT = 10 * MiB;
constexpr size_t WS_W_IN = 12 * MiB;
constexpr size_t WS_W_Q = 16 * MiB;
constexpr size_t WS_W_OT = 20 * MiB;
constexpr size_t WS_W_KV = 24 * MiB;
constexpr size_t WS_W_DOWN = 32 * MiB;
constexpr size_t WS_W_GU = 64 * MiB;
constexpr size_t WS_K = 128 * MiB;
constexpr size_t WS_V = 144 * MiB;
constexpr size_t WS_BS = 160 * MiB;
constexpr size_t WS_BO = 192 * MiB;
constexpr size_t WS_HA = 224 * MiB;
constexpr size_t WS_HB = 288 * MiB;
constexpr size_t WS_MEMN = 352 * MiB;
constexpr size_t WS_AGS = 368 * MiB;
constexpr size_t WS_AGB = 372 * MiB;
constexpr size_t WS_Y = 384 * MiB;
constexpr size_t WS_END = 512 * MiB;
constexpr size_t OB_P0 = 0, OB_PATT = 64 * MiB, OB_HMID = 0, OB_LOGA = 0, OB_BT = 64 * MiB;
constexpr size_t WS_H8 = WS_Y + 64 * MiB;

constexpr int RING_OFF = 0, RING_BYTES = 131072;
constexpr int XCH_OFF = 131072;
constexpr int TAB_OFF = 139264;
constexpr int TAB2_OFF = 147456;
constexpr int MISC_OFF = 155648;
constexpr int LDS_BYTES = 155904;
constexpr int MAXU = 8;

#define LDS_WAIT() asm volatile("s_waitcnt lgkmcnt(0)" ::: "memory")
#define VM_WAIT() asm volatile("s_waitcnt vmcnt(0)" ::: "memory")

__device__ __forceinline__ unsigned f2bf(float f) { unsigned u = __builtin_bit_cast(unsigned, f); return (u + 0x7fffu + ((u >> 16) & 1u)) >> 16; }
__device__ __forceinline__ unsigned pk2(float lo, float hi) { return f2bf(lo) | (f2bf(hi) << 16); }
__device__ __forceinline__ float bflo(unsigned w) { return __builtin_bit_cast(float, w << 16); }
__device__ __forceinline__ float bfhi(unsigned w) { return __builtin_bit_cast(float, w & 0xffff0000u); }
__device__ __forceinline__ unsigned cvt_pk_bf16(float lo, float hi) { unsigned r; asm volatile("v_cvt_pk_bf16_f32 %0, %1, %2" : "=v"(r) : "v"(lo), "v"(hi)); return r; }
__device__ __forceinline__ u32x4 pack8(f32x4 a, f32x4 b) { u32x4 w; w.x = cvt_pk_bf16(a[0], a[1]); w.y = cvt_pk_bf16(a[2], a[3]); w.z = cvt_pk_bf16(b[0], b[1]); w.w = cvt_pk_bf16(b[2], b[3]); return w; }
__device__ __forceinline__ void unpack8(u32x4 w, f32x4& a, f32x4& b) { a[0] = bflo(w.x); a[1] = bfhi(w.x); a[2] = bflo(w.y); a[3] = bfhi(w.y); b[0] = bflo(w.z); b[1] = bfhi(w.z); b[2] = bflo(w.w); b[3] = bfhi(w.w); }
__device__ __forceinline__ u32x2 pack8_fp8(f32x4 a, f32x4 b) {
#pragma unroll
    for (int j = 0; j < 4; ++j) { a[j] = __builtin_amdgcn_fmed3f(a[j], -384.0f, 384.0f); b[j] = __builtin_amdgcn_fmed3f(b[j], -384.0f, 384.0f); }
    int lo = 0, hi = 0;
    lo = __builtin_amdgcn_cvt_pk_fp8_f32(a[0], a[1], lo, false); lo = __builtin_amdgcn_cvt_pk_fp8_f32(a[2], a[3], lo, true);
    hi = __builtin_amdgcn_cvt_pk_fp8_f32(b[0], b[1], hi, false); hi = __builtin_amdgcn_cvt_pk_fp8_f32(b[2], b[3], hi, true);
    return (u32x2){(unsigned)lo, (unsigned)hi};
}
__device__ __forceinline__ float wave_sum(float v) {
    v += __builtin_bit_cast(float, __builtin_amdgcn_update_dpp(0, __builtin_bit_cast(int, v), 0xB1, 0xF, 0xF, false));
    v += __builtin_bit_cast(float, __builtin_amdgcn_update_dpp(0, __builtin_bit_cast(int, v), 0x4E, 0xF, 0xF, false));
    v += __builtin_bit_cast(float, __builtin_amdgcn_update_dpp(0, __builtin_bit_cast(int, v), 0x141, 0xF, 0xF, false));
    v += __builtin_bit_cast(float, __builtin_amdgcn_update_dpp(0, __builtin_bit_cast(int, v), 0x140, 0xF, 0xF, false));
    v += __shfl_xor(v, 16); v += __shfl_xor(v, 32);
    return v;
}
__device__ __forceinline__ float fast_exp2(float x) { return __builtin_amdgcn_exp2f(x); }
__device__ __forceinline__ float fast_rcp(float x) { return __builtin_amdgcn_rcpf(x); }
__device__ __forceinline__ float sigmoidf_(float x) { return fast_rcp(1.0f + fast_exp2(-x * LOG2E)); }

namespace pg8 {
constexpr int BM = 256, BK = 64, HALF = 128, HTB = HALF * BK * 2, STAGE_BYTES = 8 * HTB, NXCD = 8, WGM = 8;
__host__ __device__ __forceinline__ int lds_byte(int r, int c) { const int st = (r >> 4) * 2 + (c >> 5), rr = r & 15, cc = c & 31, ob = rr * 64 + cc * 2; return st * 1024 + (ob ^ (((ob >> 9) & 1) << 5)); }
__host__ __device__ __forceinline__ void stage_rc(int b, int& R, int& C) { const int st = b / 1024, sb = b % 1024, swz = sb ^ (((sb >> 9) & 1) << 5); R = (st >> 1) * 16 + swz / 64; C = (st & 1) * 32 + (swz % 64) / 2; }
__host__ __device__ __forceinline__ int perm32(int rho) { const int n = rho >> 4, i = rho & 15; return 8 * (i >> 2) + 4 * n + (i & 3); }

struct Unit { const char* A; const char* B; char* C; int row0, col0, aux; };

__device__ __forceinline__ bool tile_of(int i, int G, int c, int nM, int nN, int& pm, int& pn) {
    const int nwg = nM * nN; const long L = (long)i * G + c; if (L >= nwg) return false;
    int wgid = (int)L; { const int q = nwg / NXCD, r = nwg % NXCD, xcd = wgid % NXCD, off = wgid / NXCD; wgid = (xcd < r ? xcd * (q + 1) : r * (q + 1) + (xcd - r) * q) + off; }
    const int nig = WGM * nN, gid = wgid / nig, fm = gid * WGM, gsz = (nM - fm) < WGM ? (nM - fm) : WGM;
    pm = fm + ((wgid % nig) % gsz); pn = (wgid % nig) / gsz; return true;
}

typedef int i32x8 __attribute__((ext_vector_type(8)));
template <class Epi, class Sched, bool GATHER, bool F8 = false>
__device__ __forceinline__ void gemm_phase(LAS unsigned char* lds, const int K, const unsigned lda, const unsigned ldb, const Sched& S, const Epi& E, const LAS int* tab) {
    const int tid = threadIdx.x, wid = __builtin_amdgcn_readfirstlane(tid >> 6), lane = tid & 63, wr = wid >> 2, wc = wid & 3, fr = lane & 15, fq = lane >> 4;
    const int nt = F8 ? K / 128 : K / BK;
    unsigned vA[2], vB[2], vG[2][2]; int rA[2]; unsigned cA2[2];
#pragma unroll
    for (int i = 0; i < 2; ++i) { int R, C; stage_rc(tid * 16 + i * 8192, R, C); const int Rb = (R & ~31) + perm32(R & 31);
        vA[i] = (unsigned)R * lda + (unsigned)C * 2u; vB[i] = (unsigned)Rb * ldb + (unsigned)C * 2u; rA[i] = R; cA2[i] = (unsigned)C * 2u; vG[0][i] = 0; vG[1][i] = 0; }
    const size_t kstep = (size_t)(BK * 2);
    const size_t hsA = (size_t)HALF * lda, hsB = (size_t)HALF * ldb;
    const unsigned ldsw = (unsigned)wid * 1024u;
    const int aoff = lds_byte(wr * 64 + fr, fq * (F8 ? 16 : 8)), boff = lds_byte(wc * 32 + fr, fq * (F8 ? 16 : 8));
#define PG8_SA(b, h) (((b) * 2 + (h)) * HTB)
#define PG8_SB(b, h) ((4 + (b) * 2 + (h)) * HTB)
#define PG8_STAGE_B(bufoff, gbase) do { _Pragma("unroll") for (int _i = 0; _i < 2; ++_i) \
        __builtin_amdgcn_global_load_lds((const unsigned*)((const char*)(gbase) + vB[_i]), (LAS unsigned*)(lds + (bufoff) + ldsw + _i * 8192), 16, 0, 0); } while (0)
#define PG8_STAGE_A(bufoff, gbase, h) do { _Pragma("unroll") for (int _i = 0; _i < 2; ++_i) { \
        if constexpr (GATHER) __builtin_amdgcn_global_load_lds((const unsigned*)((const char*)(gbase) + vG[h][_i]), (LAS unsigned*)(lds + (bufoff) + ldsw + _i * 8192), 16, 0, 0); \
        else __builtin_amdgcn_global_load_lds((const unsigned*)((const char*)(gbase) + (h) * hsA + vA[_i]), (LAS unsigned*)(lds + (bufoff) + ldsw + _i * 8192), 16, 0, 0); } } while (0)
#define PG8_LOADG(ui_) do { const int _u = ((ui_) < MAXU ? (ui_) : (MAXU - 1)) * 256; _Pragma("unroll") for (int _h = 0; _h < 2; ++_h) _Pragma("unroll") for (int _i = 0; _i < 2; ++_i) \
        vG[_h][_i] = (unsigned)tab[_u + rA[_i] + 128 * _h] * lda + cA2[_i]; } while (0)
#define PG8_LDA(dst, b, h) do { if constexpr (F8) { _Pragma("unroll") for (int m = 0; m < 4; ++m) dst##8[m] = *(const LAS i32x8*)(lds + PG8_SA(b, h) + aoff + m * 2048); } \
        else { _Pragma("unroll") for (int m = 0; m < 4; ++m) _Pragma("unroll") for (int k = 0; k < 2; ++k) dst[m][k] = *(const LAS bf16x8*)(lds + PG8_SA(b, h) + aoff + m * 2048 + k * 1024); } } while (0)
#define PG8_LDB(dst, b, h) do { if constexpr (F8) { _Pragma("unroll") for (int n = 0; n < 2; ++n) dst##8[n] = *(const LAS i32x8*)(lds + PG8_SB(b, h) + boff + n * 2048); } \
        else { _Pragma("unroll") for (int n = 0; n < 2; ++n) _Pragma("unroll") for (int k = 0; k < 2; ++k) dst[n][k] = *(const LAS bf16x8*)(lds + PG8_SB(b, h) + boff + n * 2048 + k * 1024); } } while (0)
#define PG8_MMA(ai, bj, At, Bt) do { __builtin_amdgcn_s_setprio(1); _Pragma("unroll") for (int m = 0; m < 4; ++m) _Pragma("unroll") for (int n = 0; n < 2; ++n) { \
        if constexpr (F8) { asm volatile("v_mfma_f32_16x16x128_f8f6f4 %0, %1, %2, %0" : "+v"(acc[ai][bj][m][n]) : "v"(Bt##8[n]), "v"(At##8[m])); } \
        else { _Pragma("unroll") for (int k = 0; k < 2; ++k) acc[ai][bj][m][n] = __builtin_amdgcn_mfma_f32_16x16x32_bf16(Bt[n][k], At[m][k], acc[ai][bj][m][n], 0, 0, 0); } } \
        __builtin_amdgcn_s_setprio(0); } while (0)
#define PG8_WAIT_V(n) asm volatile("s_waitcnt vmcnt(" #n ")" ::: "memory")
#define PG8_WAIT_L(n) asm volatile("s_waitcnt lgkmcnt(" #n ")" ::: "memory")
#define PG8_BAR __builtin_amdgcn_s_barrier()
#define PG8_SCHED __builtin_amdgcn_sched_barrier(0)
#if MK_GMODE
    volatile LAS unsigned* _gm = (volatile LAS unsigned*)(lds + 155648);
    const bool _gsel = (threadIdx.x == 0) && ((int)_gm[16] == MK_TSEL);
    unsigned _gt = (unsigned)__builtin_amdgcn_s_memrealtime(); unsigned _gacc = 0;
#define PG8_GSTAMP(mode_) do { if (_gsel) { const unsigned _n = (unsigned)__builtin_amdgcn_s_memrealtime(); if (MK_GMODE == (mode_)) _gacc += _n - _gt; _gt = _n; } } while (0)
#else
#define PG8_GSTAMP(mode_) do { } while (0)
#endif
    Unit cur, nxt; int ui = 0;
    if (!S.next(0, cur)) return;
    f32x4 acc[2][2][4][2];
#pragma unroll
    for (int a = 0; a < 2; ++a)
#pragma unroll
        for (int b = 0; b < 2; ++b)
#pragma unroll
            for (int m = 0; m < 4; ++m)
#pragma unroll
                for (int n = 0; n < 2; ++n) acc[a][b][m][n] = (f32x4){0.f, 0.f, 0.f, 0.f};
    bf16x8 At[4][2], B0[2][2], B1[2][2]; i32x8 At8[4], B08[2], B18[2];
    const char* cA = cur.A; const char* cB = cur.B;
    if constexpr (GATHER) { PG8_LOADG(0); }
    PG8_STAGE_B(PG8_SB(0, 0), cB); PG8_STAGE_B(PG8_SB(0, 1), cB + hsB); PG8_STAGE_A(PG8_SA(0, 0), cA, 0); PG8_STAGE_A(PG8_SA(0, 1), cA, 1);
    if (wr == 1) PG8_BAR;
    PG8_WAIT_V(2); PG8_BAR;
    PG8_STAGE_B(PG8_SB(1, 0), cB + kstep); PG8_STAGE_A(PG8_SA(1, 0), cA + kstep, 0); PG8_STAGE_B(PG8_SB(1, 1), cB + hsB + kstep);
    PG8_WAIT_V(6); PG8_BAR;
    PG8_GSTAMP(1);
    for (;;) {
        const bool has_next = S.next(ui + 1, nxt);
        const char* nA = has_next ? nxt.A : cA; const char* nB = has_next ? nxt.B : cB;
#pragma nounroll
        for (int t = 0; t < nt * MK_KREP; t += 2) {
            const bool last = (t == nt * MK_KREP - 2);
            const char* a1 = cA + (size_t)(MK_KREP == 1 ? (t + 1) : ((t + 1) % nt)) * kstep;
            const int t2 = (MK_KREP == 1) ? (t + 2) : ((t + 2) % nt);
            const char* a2 = last ? nA : cA + (size_t)t2 * kstep; const char* b2 = last ? nB : cB + (size_t)t2 * kstep;
            const char* a3 = a2 + kstep; const char* b3 = b2 + kstep;
            PG8_LDB(B0, 0, 0); PG8_LDB(B1, 0, 1); PG8_SCHED; PG8_LDA(At, 0, 0); PG8_STAGE_A(PG8_SA(1, 1), a1, 1);
            PG8_WAIT_V(8); PG8_WAIT_L(0); PG8_BAR; PG8_MMA(0, 0, At, B0); PG8_MMA(0, 1, At, B1); PG8_BAR; PG8_SCHED;
            if constexpr (GATHER) { if (last && has_next) { PG8_LOADG(ui + 1); } }
            PG8_LDA(At, 0, 1); PG8_STAGE_B(PG8_SB(0, 0), b2); PG8_STAGE_B(PG8_SB(0, 1), b2 + hsB); PG8_STAGE_A(PG8_SA(0, 0), a2, 0);
            PG8_WAIT_V(8); PG8_WAIT_L(0); PG8_BAR; PG8_MMA(1, 0, At, B0); PG8_MMA(1, 1, At, B1); PG8_BAR; PG8_SCHED;
            PG8_LDB(B0, 1, 0); PG8_LDB(B1, 1, 1); PG8_SCHED; PG8_LDA(At, 1, 0); PG8_STAGE_A(PG8_SA(0, 1), a2, 1);
            PG8_WAIT_V(8); PG8_WAIT_L(0); PG8_BAR; PG8_MMA(0, 0, At, B0); PG8_MMA(0, 1, At, B1); PG8_BAR; PG8_SCHED;
            PG8_LDA(At, 1, 1); PG8_STAGE_B(PG8_SB(1, 0), b3); PG8_STAGE_B(PG8_SB(1, 1), b3 + hsB); PG8_STAGE_A(PG8_SA(1, 0), a3, 0);
            PG8_WAIT_V(8); PG8_WAIT_L(0); PG8_BAR; PG8_MMA(1, 0, At, B0); PG8_MMA(1, 1, At, B1); PG8_BAR; PG8_SCHED;
        }
        if (wr == 0) PG8_BAR;
        PG8_GSTAMP(4);
        if constexpr (F8) asm volatile("s_nop 15\n\ts_nop 15\n\ts_nop 15\n\ts_nop 15" ::: "memory");
        if (MK_KREP != 1) {
#pragma unroll
            for (int a = 0; a < 2; ++a)
#pragma unroll
                for (int b = 0; b < 2; ++b)
#pragma unroll
                    for (int m = 0; m < 4; ++m)
#pragma unroll
                        for (int n = 0; n < 2; ++n) acc[a][b][m][n] *= (1.0f / MK_KREP);
        }
        E(acc, cur, wr, wc, fr, fq);
        PG8_GSTAMP(2);
        if (!has_next) break;
#pragma unroll
        for (int a = 0; a < 2; ++a)
#pragma unroll
            for (int b = 0; b < 2; ++b)
#pragma unroll
                for (int m = 0; m < 4; ++m)
#pragma unroll
                    for (int n = 0; n < 2; ++n) acc[a][b][m][n] = (f32x4){0.f, 0.f, 0.f, 0.f};
        cur = nxt; cA = nA; cB = nB; ++ui;
        if (wr == 1) PG8_BAR;
    }
    PG8_WAIT_V(0);
    PG8_BAR;
    PG8_GSTAMP(3);
#if MK_GMODE
    if (_gsel) _gm[18] = _gacc;
#endif
#undef PG8_GSTAMP
#undef PG8_SA
#undef PG8_SB
#undef PG8_STAGE_A
#undef PG8_STAGE_B
#undef PG8_LOADG
#undef PG8_LDA
#undef PG8_LDB
#undef PG8_MMA
#undef PG8_WAIT_V
#undef PG8_WAIT_L
#undef PG8_BAR
#undef PG8_SCHED
}

typedef f32x4 Acc[2][2][4][2];
#ifndef MK_EPI_SC1
#define MK_EPI_SC1 0
#endif
__device__ __forceinline__ void st16(bf16* p, u32x4 v) {
#if MK_EPI_SC1
    asm volatile("global_store_dwordx4 %0, %1, off sc1\n\ts_nop 1" :: "v"(p), "v"(v) : "memory");
#else
    *(u32x4*)p = v;
#endif
}

struct EpiPlain {
    int ldc;
    __device__ __forceinline__ void operator()(Acc& acc, const Unit& u, int wr, int wc, int fr, int fq) const {
        bf16* base = (bf16*)u.C + (size_t)(wr * 64 + fr) * ldc + wc * 32 + 8 * fq;
#pragma unroll
        for (int ai = 0; ai < 2; ++ai)
#pragma unroll
            for (int m = 0; m < 4; ++m) { bf16* rowp = base + (size_t)(ai * 128 + m * 16) * ldc;
#pragma unroll
                for (int bj = 0; bj < 2; ++bj) st16(rowp + bj * 128, pack8(acc[ai][bj][m][0], acc[ai][bj][m][1])); }
    }
};
struct EpiMVW {
    __device__ __forceinline__ void operator()(Acc& acc, const Unit& u, int wr, int wc, int fr, int fq) const {
        if (u.col0 == 0) { bf16* base = (bf16*)u.C + (size_t)(wr * 64 + fr) * 1024 + wc * 32 + 8 * fq;
#pragma unroll
            for (int ai = 0; ai < 2; ++ai)
#pragma unroll
                for (int m = 0; m < 4; ++m) { bf16* rowp = base + (size_t)(ai * 128 + m * 16) * 1024;
#pragma unroll
                    for (int bj = 0; bj < 2; ++bj) st16(rowp + bj * 128, pack8(acc[ai][bj][m][0], acc[ai][bj][m][1])); }
        } else { unsigned char* base = (unsigned char*)u.C + (size_t)(wr * 64 + fr) * 1024 + wc * 32 + 8 * fq;
#pragma unroll
            for (int ai = 0; ai < 2; ++ai)
#pragma unroll
                for (int m = 0; m < 4; ++m) { unsigned char* rowp = base + (size_t)(ai * 128 + m * 16) * 1024;
#pragma unroll
                    for (int bj = 0; bj < 2; ++bj) *(u32x2*)(rowp + bj * 128) = pack8_fp8(acc[ai][bj][m][0] * BO8_SCALE, acc[ai][bj][m][1] * BO8_SCALE); }
        }
    }
};
template <bool STATS> struct EpiRes {
    const bf16* hin; bf16* hout; float* ss16; unsigned char* h8; float ascale;
    __device__ __forceinline__ void operator()(Acc& acc, const Unit& u, int wr, int wc, int fr, int fq) const {
        const size_t ro0 = (size_t)(u.row0 + wr * 64 + fr) * 1024 + u.col0 + wc * 32 + 8 * fq;
        u32x4 hv[2][4][2];
#pragma unroll
        for (int ai = 0; ai < 2; ++ai)
#pragma unroll
            for (int m = 0; m < 4; ++m)
#pragma unroll
                for (int bj = 0; bj < 2; ++bj) hv[ai][m][bj] = *(const u32x4*)(hin + ro0 + (size_t)(ai * 128 + m * 16) * 1024 + bj * 128);
#pragma unroll
        for (int ai = 0; ai < 2; ++ai)
#pragma unroll
            for (int m = 0; m < 4; ++m) { const int row = u.row0 + ai * 128 + wr * 64 + m * 16 + fr; const size_t ro = ro0 + (size_t)(ai * 128 + m * 16) * 1024; float s = 0.f;
#pragma unroll
                for (int bj = 0; bj < 2; ++bj) { f32x4 a, b; unpack8(hv[ai][m][bj], a, b); a += acc[ai][bj][m][0] * ascale; b += acc[ai][bj][m][1] * ascale;
                    if constexpr (STATS) s += (a[0] * a[0] + a[1] * a[1]) + (a[2] * a[2] + a[3] * a[3]) + (b[0] * b[0] + b[1] * b[1]) + (b[2] * b[2] + b[3] * b[3]);
                    st16(hout + ro + bj * 128, pack8(a, b)); if (h8) *(u32x2*)(h8 + ro + bj * 128) = pack8_fp8(a, b); }
                if constexpr (STATS) { s += __shfl_xor(s, 16); s += __shfl_xor(s, 32);
                    if (fq == 0) ss16[(size_t)row * 16 + (u.col0 >> 8) * 4 + wc] = s; } }
    }
};
struct EpiPool {
    const float* x; const float* scale; bf16* hout; float* ss16;
    __device__ __forceinline__ void operator()(Acc& acc, const Unit& u, int wr, int wc, int fr, int fq) const {
        const int cb = u.col0 + wc * 32 + 8 * fq;
        f32x4 sc[2][2];
#pragma unroll
        for (int bj = 0; bj < 2; ++bj) { sc[bj][0] = *(const f32x4*)(scale + cb + bj * 128); sc[bj][1] = *(const f32x4*)(scale + cb + bj * 128 + 4); }
        float ssum[2][4];
#pragma unroll
        for (int ai = 0; ai < 2; ++ai) {
            f32x4 xv[4][2][2];
#pragma unroll
            for (int m = 0; m < 4; ++m)
#pragma unroll
                for (int bj = 0; bj < 2; ++bj) { const float* xp = x + (size_t)(u.row0 + ai * 128 + wr * 64 + m * 16 + fr) * 1024 + cb + bj * 128; xv[m][bj][0] = *(const f32x4*)xp; xv[m][bj][1] = *(const f32x4*)(xp + 4); }
#pragma unroll
            for (int m = 0; m < 4; ++m) { const int row = u.row0 + ai * 128 + wr * 64 + m * 16 + fr; const size_t ro = (size_t)row * 1024 + cb; float s = 0.f;
#pragma unroll
                for (int bj = 0; bj < 2; ++bj) { f32x4 a = xv[m][bj][0], b = xv[m][bj][1];
                    a += acc[ai][bj][m][0] * sc[bj][0]; b += acc[ai][bj][m][1] * sc[bj][1];
                    s += (a[0] * a[0] + a[1] * a[1]) + (a[2] * a[2] + a[3] * a[3]) + (b[0] * b[0] + b[1] * b[1]) + (b[2] * b[2] + b[3] * b[3]);
                    st16(hout + ro + bj * 128, pack8(a, b)); }
                s += __shfl_xor(s, 16); s += __shfl_xor(s, 32); ssum[ai][m] = s; }
        }
        if (fq == 0) {
#pragma unroll
            for (int ai = 0; ai < 2; ++ai)
#pragma unroll
                for (int m = 0; m < 4; ++m) ss16[(size_t)(u.row0 + ai * 128 + wr * 64 + m * 16 + fr) * 16 + (u.col0 >> 8) * 4 + wc] = ssum[ai][m];
        }
    }
};
struct EpiS {
    unsigned char* P; const LAS float* tab2; LAS f32x2* xch;
    __device__ __forceinline__ void operator()(Acc& acc, const Unit& u, int wr, int wc, int fr, int fq) const {
        float mxs[2][4];
#pragma unroll
        for (int ai = 0; ai < 2; ++ai)
#pragma unroll
            for (int m = 0; m < 4; ++m) { const int rl = ai * 128 + wr * 64 + m * 16 + fr; const int row = u.row0 + rl;
                const float rs = tab2[(u.aux < MAXU ? u.aux : MAXU - 1) * 256 + rl];
                float mx = -3.0e38f;
#pragma unroll
                for (int bj = 0; bj < 2; ++bj)
#pragma unroll
                    for (int n = 0; n < 2; ++n) { f32x4 v = acc[ai][bj][m][n] * rs; acc[ai][bj][m][n] = v; mx = fmaxf(mx, fmaxf(fmaxf(v[0], v[1]), fmaxf(v[2], v[3]))); }
                mx = fmaxf(mx, __shfl_xor(mx, 16)); mx = fmaxf(mx, __shfl_xor(mx, 32));
                float l = 0.f;
#pragma unroll
                for (int bj = 0; bj < 2; ++bj)
#pragma unroll
                    for (int n = 0; n < 2; ++n) { f32x4 v = acc[ai][bj][m][n]; f32x4 e; e[0] = fast_exp2(v[0] - mx); e[1] = fast_exp2(v[1] - mx); e[2] = fast_exp2(v[2] - mx); e[3] = fast_exp2(v[3] - mx);
                        acc[ai][bj][m][n] = e; l += (e[0] + e[1]) + (e[2] + e[3]); }
                l += __shfl_xor(l, 16); l += __shfl_xor(l, 32);
                if (fq == 0) xch[rl * 4 + wc] = (f32x2){mx, l};
                mxs[ai][m] = mx; }
        asm volatile("s_waitcnt lgkmcnt(0)" ::: "memory"); __builtin_amdgcn_s_barrier(); asm volatile("" ::: "memory");
#pragma unroll
        for (int ai = 0; ai < 2; ++ai)
#pragma unroll
            for (int m = 0; m < 4; ++m) { const int rl = ai * 128 + wr * 64 + m * 16 + fr; const int row = u.row0 + rl;
                const f32x2 p0 = xch[rl * 4 + 0], p1 = xch[rl * 4 + 1], p2 = xch[rl * 4 + 2], p3 = xch[rl * 4 + 3];
                const float M = fmaxf(fmaxf(p0.x, p1.x), fmaxf(p2.x, p3.x));
                const float L = (p0.y * fast_exp2(p0.x - M) + p1.y * fast_exp2(p1.x - M)) + (p2.y * fast_exp2(p2.x - M) + p3.y * fast_exp2(p3.x - M));
                const float f = fast_exp2(mxs[ai][m] - M) * fast_rcp(L) * P8_SCALE;
                unsigned char* rowp = P + (size_t)row * 1024 + u.col0 + wc * 32 + 8 * fq;
#pragma unroll
                for (int bj = 0; bj < 2; ++bj) *(u32x2*)(rowp + bj * 128) = pack8_fp8(acc[ai][bj][m][0] * f, acc[ai][bj][m][1] * f); }
    }
};
struct EpiGU {
    unsigned char* hmid; const LAS float* tab2;
    __device__ __forceinline__ void operator()(Acc& acc, const Unit& u, int wr, int wc, int fr, int fq) const {
        const int ub = (u.aux < MAXU ? u.aux : MAXU - 1) * 256;
#pragma unroll
        for (int ai = 0; ai < 2; ++ai)
#pragma unroll
            for (int m = 0; m < 4; ++m) { const int rl = ai * 128 + wr * 64 + m * 16 + fr; const float rs = tab2[ub + rl] * (1.0f / W8_GU_SCALE);
                f32x4 o[2];
#pragma unroll
                for (int n = 0; n < 2; ++n)
#pragma unroll
                    for (int j = 0; j < 4; ++j) { const float g = acc[ai][0][m][n][j] * rs, uu = acc[ai][1][m][n][j] * rs; o[n][j] = g * sigmoidf_(g) * uu * H8_MID_SCALE; }
                *(u32x2*)(hmid + (size_t)(u.row0 + rl) * 512 + (u.col0 >> 1) + wc * 32 + 8 * fq) = pack8_fp8(o[0], o[1]); }
    }
};
struct EpiDown {
    bf16* y; const LAS int* tab; const LAS float* tab2;
    __device__ __forceinline__ void operator()(Acc& acc, const Unit& u, int wr, int wc, int fr, int fq) const {
        const int ub = (u.aux < MAXU ? u.aux : MAXU - 1) * 256;
#pragma unroll
        for (int ai = 0; ai < 2; ++ai)
#pragma unroll
            for (int m = 0; m < 4; ++m) { const int rl = ai * 128 + wr * 64 + m * 16 + fr; const int slot = tab[ub + rl]; const float w = tab2[ub + rl] * (1.0f / (W8_DOWN_SCALE * H8_MID_SCALE));
                if (slot >= 0) { bf16* rowp = y + (size_t)slot * 1024 + u.col0 + wc * 32 + 8 * fq;
#pragma unroll
                    for (int bj = 0; bj < 2; ++bj) st16(rowp + bj * 128, pack8(acc[ai][bj][m][0] * w, acc[ai][bj][m][1] * w)); } }
    }
};
struct EpiIn {
    bf16* xb; bf16* gate; const LAS float* tab2;
    __device__ __forceinline__ void operator()(Acc& acc, const Unit& u, int wr, int wc, int fr, int fq) const {
        const bool isg = u.col0 >= 1024; bf16* dst = isg ? gate : xb; const int c0 = (u.col0 & 1023) + wc * 32 + 8 * fq;
#pragma unroll
        for (int ai = 0; ai < 2; ++ai)
#pragma unroll
            for (int m = 0; m < 4; ++m) { const int rl = ai * 128 + wr * 64 + m * 16 + fr; const int row = u.row0 + rl; const float rs = tab2[(u.aux < MAXU ? u.aux : MAXU - 1) * 256 + rl];
#pragma unroll
                for (int bj = 0; bj < 2; ++bj) { f32x4 o[2];
#pragma unroll
                    for (int n = 0; n < 2; ++n)
#pragma unroll
                        for (int j = 0; j < 4; ++j) { float v = acc[ai][bj][m][n][j] * rs; if (isg) { const float t = 1.5957691216057308f * (v + 0.044715f * v * v * v); v = v * sigmoidf_(t); } o[n][j] = v; }
                    st16(dst + (size_t)row * 1024 + c0 + bj * 128, pack8(o[0], o[1])); } }
    }
};
struct EpiGates {
    const bf16* xc; bf16* loga; bf16* bt; const float* bgate; const float* spl;
    __device__ __forceinline__ void operator()(Acc& acc, const Unit& u, int wr, int wc, int fr, int fq) const {
        const int ch = u.col0 + wc * 32 + 8 * fq;
        const int hh = u.col0 >> 8, cin = (u.col0 & 255) + wc * 32 + 8 * fq;
        f32x4 br[2], bi[2], sp[2];
#pragma unroll
        for (int n = 0; n < 2; ++n) { br[n] = *(const f32x4*)(bgate + hh * 512 + cin + 4 * n); bi[n] = *(const f32x4*)(bgate + hh * 512 + 256 + cin + 4 * n); sp[n] = *(const f32x4*)(spl + ch + 4 * n); }
        u32x4 xv[2][4];
#pragma unroll
        for (int ai = 0; ai < 2; ++ai)
#pragma unroll
            for (int m = 0; m < 4; ++m) xv[ai][m] = *(const u32x4*)(xc + (size_t)(u.row0 + ai * 128 + wr * 64 + m * 16 + fr) * 1024 + ch);
#pragma unroll
        for (int ai = 0; ai < 2; ++ai)
#pragma unroll
            for (int m = 0; m < 4; ++m) { const int row = u.row0 + ai * 128 + wr * 64 + m * 16 + fr; const size_t ro = (size_t)row * 1024 + ch;
                f32x4 x[2]; unpack8(xv[ai][m], x[0], x[1]);
                f32x4 la[2], bb[2];
#pragma unroll
                for (int n = 0; n < 2; ++n)
#pragma unroll
                    for (int j = 0; j < 4; ++j) { const float er = 1.0f + fast_exp2(fminf(-(acc[ai][0][m][n][j] + br[n][j]) * LOG2E, 60.f)), ei = 1.0f + fast_exp2(fminf(-(acc[ai][1][m][n][j] + bi[n][j]) * LOG2E, 60.f));
                        const float q = fast_rcp(er * ei); const float r = q * ei, ig = q * er;
                        const float l = -8.0f * r * sp[n][j]; const float a2 = fast_exp2(2.0f * LOG2E * l); const float mult = __builtin_amdgcn_sqrtf(fmaxf(1.0f - a2, 0.f));
                        la[n][j] = l; bb[n][j] = mult * ig * x[n][j]; }
                *(u32x4*)(loga + ro) = pack8(la[0], la[1]); *(u32x4*)(bt + ro) = pack8(bb[0], bb[1]); }
    }
};
}

#define XB_TMO      128
#define XB_XCNT(j)  (256  + 64 * (j))
#define XB_XSUB(j)  (1280 + 64 * (j))
#define XB_XGEN(j)  (2304 + 64 * (j))
#define XB_TOP      3328
#define XB_TOPGEN   3392
#define XCD_BAR_WORDS 3456
#define XB_SPIN_CAP (1u << 18)

__device__ __forceinline__ unsigned xb_ld(unsigned* p)              { return __hip_atomic_load(p, __ATOMIC_RELAXED, __HIP_MEMORY_SCOPE_AGENT); }
__device__ __forceinline__ unsigned xb_add(unsigned* p, unsigned v) { return __hip_atomic_fetch_add(p, v, __ATOMIC_RELAXED, __HIP_MEMORY_SCOPE_AGENT); }
__device__ __forceinline__ unsigned xb_xcc_id() { return (unsigned)__builtin_amdgcn_s_getreg((3 << 11) | 20) & 0xFu; }
#define XB_SPIN(cond, bar) do { unsigned _sp = 0; while (cond) { __builtin_amdgcn_s_sleep(1); \
    if ((++_sp & 255u) == 0u) { if (xb_ld(&(bar)[XB_TMO])) break; if (_sp > XB_SPIN_CAP) { atomicAdd(&(bar)[XB_TMO], 1u); break; } } } } while (0)

struct XcdBarrier { unsigned* bar; unsigned x; volatile LAS unsigned* st; };

__device__ __forceinline__ XcdBarrier xcd_barrier_post(unsigned* bar, volatile LAS unsigned* st) {
    XcdBarrier b; b.bar = bar; b.x = xb_xcc_id(); b.st = st;
    if (threadIdx.x == 0) (void)xb_add(&bar[XB_XCNT(b.x)], 1u);
    return b;
}
__device__ __forceinline__ void xcd_barrier_complete(unsigned* bar, unsigned x, unsigned& nloc, unsigned& nx) {
    const unsigned G = gridDim.x * gridDim.y * gridDim.z;
    unsigned sum, cnt, mine, sp = 0u;
    for (;;) {
        sum = 0u; cnt = 0u; mine = 0u;
#pragma unroll
        for (unsigned j = 0; j < 16; ++j) { const unsigned c = xb_ld(&bar[XB_XCNT(j)]); sum += c; cnt += (c > 0u) ? 1u : 0u; mine = (j == x) ? c : mine; }
        if (sum == G) break;
        __builtin_amdgcn_s_sleep(1);
        if ((++sp & 255u) == 0u) { if (xb_ld(&bar[XB_TMO])) break; if (sp > XB_SPIN_CAP) { atomicAdd(&bar[XB_TMO], 1u); break; } }
    }
    nloc = mine > 0u ? mine : 1u; nx = cnt > 0u ? cnt : 1u;
}
__device__ __forceinline__ void xcd_barrier(const XcdBarrier& b) {
    asm volatile("s_waitcnt vmcnt(0)" ::: "memory");
    __syncthreads();
    if (threadIdx.x == 0) {
        unsigned* bar = b.bar;
        __builtin_amdgcn_s_waitcnt(0);
        unsigned nloc = b.st[0], nx = b.st[1];
        if (nloc == 0u) { xcd_barrier_complete(bar, b.x, nloc, nx); b.st[0] = nloc; b.st[1] = nx; }
        const unsigned old = xb_add(&bar[XB_XSUB(b.x)], 1u);
        const unsigned gen = old / nloc;
        if (old + 1u == (gen + 1u) * nloc) {
            __builtin_amdgcn_fence(__ATOMIC_RELEASE, "agent");
            asm volatile("s_waitcnt vmcnt(0)" ::: "memory");
            const unsigned og = xb_add(&bar[XB_TOP], 1u);
            const unsigned tg = og / nx;
            if (og + 1u == (tg + 1u) * nx) xb_add(&bar[XB_TOPGEN], 1u);
            else XB_SPIN(xb_ld(&bar[XB_TOPGEN]) == tg, bar);
            __builtin_amdgcn_fence(__ATOMIC_ACQUIRE, "agent");
            xb_add(&bar[XB_XGEN(b.x)], 1u);
            asm volatile("s_waitcnt vmcnt(0)" ::: "memory");
        } else {
            XB_SPIN(xb_ld(&bar[XB_XGEN(b.x)]) == gen, bar);
            __builtin_amdgcn_fence(__ATOMIC_ACQUIRE, "agent");
            asm volatile("s_waitcnt vmcnt(0)" ::: "memory");
        }
    }
    __syncthreads();
}

struct Args { const float* in[25]; float* out; unsigned char* ws; int ph_lo, ph_hi; unsigned dup, pad; };
struct Frame {
    LAS unsigned char* lds;
    int tid, lane, wave, G, vcu;
    unsigned char* ws; unsigned char* ob;
};
enum { I_X = 0, I_MEM, I_POOL_W, I_POOL_SCALE, I_RG_W_IN, I_RG_CONV_W, I_RG_CONV_B, I_RG_W_GATE, I_RG_B_GATE, I_RG_LAMBDA, I_RG_W_OUT, I_XA_WQ, I_XA_WKV, I_XA_WO,
       I_MOE_WG, I_MOE_BG, I_MOE_WE, I_MOE_BE, I_MOE_W_GU, I_MOE_W_DOWN, I_NORM_MIX, I_NORM_XATTN, I_NORM_MEM, I_NORM_MOE, I_NORM_FINAL };

__device__ __forceinline__ void tr_item(const float* W, int ldw, int k0, int scol0, const float* gain, void* out, int ldo, int orow0, LAS float* scr, int lane, int f8 = 0, float scl = 1.0f) {
    f32x4 v[8];
    const int kq = lane >> 3, n4 = (lane & 7) * 4;
#pragma unroll
    for (int i = 0; i < 8; ++i) v[i] = *(const f32x4*)(W + (size_t)(k0 + 8 * i + kq) * ldw + scol0 + n4);
    if (gain) {
#pragma unroll
        for (int i = 0; i < 8; ++i) v[i] *= gain[k0 + 8 * i + kq] * scl;
    } else if (f8) {
#pragma unroll
        for (int i = 0; i < 8; ++i) v[i] *= scl;
    }
#pragma unroll
    for (int i = 0; i < 8; ++i) { LAS float* d = scr + (8 * i + kq) * 33 + n4; d[0] = v[i][0]; d[1] = v[i][1]; d[2] = v[i][2]; d[3] = v[i][3]; }
    LDS_WAIT(); asm volatile("" ::: "memory");
    const int c = lane & 7;
#pragma unroll
    for (int j = 0; j < 4; ++j) { const int n = (lane >> 3) + 8 * j; const LAS float* s = scr + (8 * c) * 33 + n;
        if (f8) { *(u32x2*)((unsigned char*)out + (size_t)(orow0 + n) * ldo + k0 + 8 * c) = pack8_fp8((f32x4){s[0 * 33], s[1 * 33], s[2 * 33], s[3 * 33]}, (f32x4){s[4 * 33], s[5 * 33], s[6 * 33], s[7 * 33]}); }
        else { u32x4 o; o.x = pk2(s[0 * 33], s[1 * 33]); o.y = pk2(s[2 * 33], s[3 * 33]); o.z = pk2(s[4 * 33], s[5 * 33]); o.w = pk2(s[6 * 33], s[7 * 33]);
            *(u32x4*)((bf16*)out + (size_t)(orow0 + n) * ldo + k0 + 8 * c) = o; } }
    LDS_WAIT(); asm volatile("" ::: "memory");
}
__device__ __forceinline__ void tr_job(int q, const float* W, int Kdim, int ldw, int NO, int mapmode, int mapoff, const float* gain, void* out, LAS float* scr, int lane, int f8 = 0, float scl = 1.0f) {
    const int nblk = NO / 32, kb = q / nblk, nb = q % nblk, n0 = 32 * nb;
    int sc = n0;
    if (mapmode) { const int tile = n0 >> 8, w = n0 & 255; sc = (w < 128) ? (128 * tile + w) : (mapoff + 128 * tile + (w - 128)); }
    tr_item(W, ldw, 64 * kb, sc, gain, out, Kdim, n0, scr, lane, f8, scl);
}
__device__ __forceinline__ float row_sumsq_f32(const float* row, int lane, f32x4 (&v)[4]) {
    const f32x4* xr = (const f32x4*)row + lane; float s = 0.f;
#pragma unroll
    for (int j = 0; j < 4; ++j) { v[j] = xr[64 * j]; s += (v[j][0] * v[j][0] + v[j][1] * v[j][1]) + (v[j][2] * v[j][2] + v[j][3] * v[j][3]); }
    return wave_sum(s);
}

__device__ __forceinline__ void phase_prologue(Frame& F, const Args& args) {
    LAS float* scr = (LAS float*)(F.lds + RING_OFF + F.wave * 16384);
    const int gw = F.vcu * 8 + F.wave, NGW = F.G * 8, lane = F.lane;
    unsigned char* ws = F.ws;
    const float* nmix = args.in[I_NORM_MIX]; const float* nxat = args.in[I_NORM_XATTN]; const float* nmem = args.in[I_NORM_MEM]; const float* nmoe = args.in[I_NORM_MOE];
    constexpr int J0 = 128, J1 = 1024, J2 = 256, J3 = 512, J4 = 2048, J5 = 1024, J6 = 16384, J7 = 8192;
    constexpr int NITEMS = J0 + J1 + J2 + J3 + J4 + J5 + J6 + J7;
    for (int it = gw; it < NITEMS; it += NGW) {
        int r = it;
        if (r < J0) { const int g = r / 32, q = r % 32; tr_job(q, args.in[I_POOL_W] + (size_t)g * 65536, 256, 256, 256, 0, 0, nullptr, (bf16*)(ws + WS_W_POOL) + (size_t)g * 65536, scr, lane); continue; } r -= J0;
        if (r < J1) { tr_job(r, args.in[I_RG_W_IN], 1024, 2048, 2048, 0, 0, nmix + 1024, (bf16*)(ws + WS_W_IN), scr, lane); continue; } r -= J1;
        if (r < J2) { const int h = r / 64, q = r % 64; tr_job(q, args.in[I_RG_W_GATE] + (size_t)h * 131072, 256, 512, 512, 1, 256, nullptr, (bf16*)(ws + WS_W_GATE) + (size_t)h * 131072, scr, lane); continue; } r -= J2;
        if (r < J3) { tr_job(r, args.in[I_RG_W_OUT], 1024, 1024, 1024, 0, 0, nullptr, (bf16*)(ws + WS_W_OUT), scr, lane); continue; } r -= J3;
        if (r < J4) { const int l = r / 1024, q = r % 1024; tr_job(q, args.in[I_XA_WKV] + (size_t)l * 2097152, 1024, 2048, 2048, 0, 0, nullptr, (bf16*)(ws + WS_W_KV) + (size_t)l * 2097152, scr, lane); continue; } r -= J4;
        if (r < J5) { const int l = r / 512, q = r % 512; tr_job(q, args.in[I_XA_WO] + (size_t)l * 1048576, 1024, 1024, 1024, 0, 0, nullptr, (bf16*)(ws + WS_W_OT) + (size_t)l * 1048576, scr, lane); continue; } r -= J5;
        if (r < J6) { const int le = r / 512, q = r % 512; tr_job(q, args.in[I_MOE_W_GU] + (size_t)le * 1048576, 1024, 1024, 1024, 1, 512, nmoe + (le >> 4) * 1024, (unsigned char*)(ws + WS_W_GU) + (size_t)le * 1048576, scr, lane, 1, W8_GU_SCALE); continue; } r -= J6;
        { const int le = r / 256, q = r % 256; tr_job(q, args.in[I_MOE_W_DOWN] + (size_t)le * 524288, 512, 1024, 1024, 0, 0, nullptr, (unsigned char*)(ws + WS_W_DOWN) + (size_t)le * 524288, scr, lane, 1, W8_DOWN_SCALE); }
    }
    constexpr int R_WQ = 2048, R_MEMN = 2 * NMR, R_WRB = 2 * 128, R_SPL = 1;
    constexpr int NROWS = R_WQ + R_MEMN + R_WRB + R_SPL;
    for (int it = gw; it < NROWS; it += NGW) {
        int r = it;
        if (r < R_WQ) {
            const int l = r >> 10, d = r & 1023; const float gsc = nxat[l * 1024 + d] * (LOG2E / 16.0f);
            const f32x4* src = (const f32x4*)(args.in[I_XA_WQ] + (size_t)r * 1024) + lane; u32x2* dst = (u32x2*)((bf16*)(ws + WS_W_Q) + (size_t)r * 1024) + lane;
#pragma unroll
            for (int j = 0; j < 4; ++j) { const f32x4 v = src[64 * j] * gsc; dst[64 * j] = (u32x2){pk2(v[0], v[1]), pk2(v[2], v[3])}; }
            continue; } r -= R_WQ;
        if (r < R_MEMN) {
            const int l = r / NMR, row = r % NMR; f32x4 v[4]; const float ss = row_sumsq_f32(args.in[I_MEM] + (size_t)row * 1024, lane, v);
            const float rs = __builtin_amdgcn_rsqf(ss * (1.0f / 1024.0f) + EPS);
            const f32x4* gp = (const f32x4*)(nmem + l * 1024) + lane; u32x2* dst = (u32x2*)((bf16*)(ws + WS_MEMN) + (size_t)r * 1024) + lane;
#pragma unroll
            for (int j = 0; j < 4; ++j) { const f32x4 o = v[j] * gp[64 * j] * rs; dst[64 * j] = (u32x2){pk2(o[0], o[1]), pk2(o[2], o[3])}; }
            continue; } r -= R_MEMN;
        if (r < R_WRB) {
            const int l = r >> 7, blk = r & 127;
            bf16* dst = (bf16*)(ws + WS_WRB) + (size_t)l * 65536 + blk * 512;
#pragma unroll
            for (int e8 = 0; e8 < 8; ++e8) { const int idx = blk * 512 + e8 * 64 + lane; const int jj = idx & 7, ln = (idx >> 3) & 63, ks = (idx >> 9) & 31, tl = idx >> 14;
                const int col = (tl & 1) * 16 + (ln & 15), d = 32 * ks + 8 * (ln >> 4) + jj;
                float w = 0.f;
                if (col < 4) w = args.in[I_MOE_WG][(size_t)l * 4096 + d * 4 + col];
                else if (col < 20) w = args.in[I_MOE_WE][(((size_t)l * 4 + ((col - 4) >> 2)) * 1024 + d) * 4 + ((col - 4) & 3)];
                w *= nmoe[l * 1024 + d];
                const unsigned hi = f2bf(w); const float lo = w - __builtin_bit_cast(float, hi << 16);
                dst[e8 * 64 + lane] = (bf16)((tl < 2) ? hi : f2bf(lo)); }
            continue; } r -= R_WRB;
        {
#pragma unroll
            for (int j = 0; j < 16; ++j) { const int c = j * 64 + lane; const float lam = args.in[I_RG_LAMBDA][c]; const float z = -lam;
                ((float*)(ws + WS_SPL))[c] = (z > 20.f) ? z : log1pf(expf(z)); }
        }
    }
}

template <int W> __device__ __forceinline__ void pool_step(f32x4 (&hist)[W], f32x4& sum, const f32x4 cur, const int i, const int cnt_s, const f32x4 gm, u32x2* dst) {
    sum += cur; const int cnt = cnt_s < W ? cnt_s : W; const f32x4 p = (sum * (1.0f / (float)cnt) - cur) * gm; *dst = (u32x2){pk2(p[0], p[1]), pk2(p[2], p[3])};
    hist[i % W] = cur; sum -= hist[(i + 1) % W];
}
constexpr int PBR = 2;
__device__ __forceinline__ void pool_loadn(const float* __restrict__ xb, int s, int nrow, f32x4 (&v)[PBR][4]) {
#pragma unroll
    for (int r = 0; r < PBR; ++r) if (r < nrow) {
        if (s + r >= 0) {
#pragma unroll
            for (int g = 0; g < 4; ++g) v[r][g] = *(const f32x4*)(xb + (size_t)(s + r) * D + g * 256);
        } else {
#pragma unroll
            for (int g = 0; g < 4; ++g) v[r][g] = (f32x4){0.f, 0.f, 0.f, 0.f};
        } }
#pragma unroll
    for (int r = 0; r < PBR; ++r) if (r < nrow) { float ss = 0.f;
#pragma unroll
        for (int g = 0; g < 4; ++g) ss += (v[r][g][0] * v[r][g][0] + v[r][g][1] * v[r][g][1]) + (v[r][g][2] * v[r][g][2] + v[r][g][3] * v[r][g][3]);
        const float rs = __builtin_amdgcn_rsqf(wave_sum(ss) * (1.0f / 1024.0f) + EPS);
#pragma unroll
        for (int g = 0; g < 4; ++g) v[r][g] *= rs; }
}
__device__ __forceinline__ void pool_run(const float* __restrict__ xb, bf16* __restrict__ prow, const int s0, const f32x4 (&gm)[4], const int lane) {
    f32x4 h0[2], h1[4], h2[8], h3[16], sum[4];
#pragma unroll
    for (int g = 0; g < 4; ++g) sum[g] = (f32x4){0.f, 0.f, 0.f, 0.f};
#pragma unroll
    for (int jb = 15; jb >= 1; jb -= PBR) { const int nrow = jb >= PBR ? PBR : jb; f32x4 v[PBR][4]; pool_loadn(xb, s0 - jb, nrow, v);
#pragma unroll
        for (int r = 0; r < PBR; ++r) if (r < nrow) { const int j = jb - r;
            if (j < 2) { h0[(16 - j) % 2] = v[r][0]; sum[0] += v[r][0]; }
            if (j < 4) { h1[(16 - j) % 4] = v[r][1]; sum[1] += v[r][1]; }
            if (j < 8) { h2[(16 - j) % 8] = v[r][2]; sum[2] += v[r][2]; }
            { h3[(16 - j) % 16] = v[r][3]; sum[3] += v[r][3]; } } }
#pragma unroll
    for (int ib = 0; ib < 16; ib += PBR) { f32x4 v[PBR][4]; pool_loadn(xb, s0 + ib, PBR, v);
#pragma unroll
        for (int r = 0; r < PBR; ++r) { const int i = ib + r, s = s0 + i; u32x2* dst = (u32x2*)(prow + (size_t)i * D) + lane;
            pool_step<2>(h0, sum[0], v[r][0], i, s + 1, gm[0], dst);
            pool_step<4>(h1, sum[1], v[r][1], i, s + 1, gm[1], dst + 64);
            pool_step<8>(h2, sum[2], v[r][2], i, s + 1, gm[2], dst + 128);
            pool_step<16>(h3, sum[3], v[r][3], i, s + 1, gm[3], dst + 192); } }
}
__device__ __forceinline__ void phase_pool_p(Frame& F, const Args& args) {
    const int gw = F.vcu * 8 + F.wave, NGW = F.G * 8, lane = F.lane;
    bf16* P0 = (bf16*)(F.ob + OB_P0);
    f32x4 gm[4];
#pragma unroll
    for (int g = 0; g < 4; ++g) gm[g] = *(const f32x4*)(args.in[I_NORM_MIX] + g * 256 + 4 * lane);
    for (int it = gw; it < NB * (SEQ / 16); it += NGW) {
        const int b = it >> 7, s0 = (it & 127) * 16;
        pool_run(args.in[I_X] + (size_t)b * SEQ * D + 4 * lane, P0 + ((size_t)b * SEQ + s0) * D, s0, gm, lane);
    }
}

struct SchedKV {
    int G, c; const char* A; const char* B; char* Kb; char* Vb;
    __device__ __forceinline__ bool next(int i, pg8::Unit& u) const { int pm, pn; if (!pg8::tile_of(i, G, c, 32, 8, pm, pn)) return false;
        const int l = pm >> 4; u.A = A + (size_t)pm * 256 * 2048; u.B = B + (size_t)l * 4194304 + (size_t)pn * 256 * 2048;
        u.C = ((pn < 4) ? Kb : Vb) + ((size_t)l * 4096 + (size_t)(pm & 15) * 256) * 2048 + (size_t)(pn & 3) * 512; u.row0 = pm * 256; u.col0 = pn * 256; u.aux = i; return true; }
};
struct SchedMVW {
    int G, c; const char* Kl; const char* Vl; const char* Wq; const char* Wot; char* BS; char* BO;
    __device__ __forceinline__ bool next(int i, pg8::Unit& u) const { int pm, pn; if (!pg8::tile_of(i, G, c, 128, 4, pm, pn)) return false;
        const int kind = pm >> 6, bh = pm & 63, b = bh >> 2, h = bh & 3;
        if (kind == 0) { u.A = Kl + ((size_t)b * 256) * 2048 + h * 512; u.B = Wq + ((size_t)pn * 256) * 2048 + h * 512; u.C = BS + (size_t)b * 2097152 + ((size_t)h * 256) * 2048 + pn * 512; }
        else { u.A = Wot + ((size_t)pn * 256) * 2048 + h * 512; u.B = Vl + ((size_t)b * 256) * 2048 + h * 512; u.C = BO + (size_t)b * 1048576 + ((size_t)pn * 256) * 1024 + h * 256; }
        u.row0 = 0; u.col0 = kind; u.aux = i; return true; }
};
struct SchedDense {
    int G, c, nN; const char* A; size_t apan; size_t acol; int adiv; const char* B; size_t bpn; size_t bbatch; int cmul;
    __device__ __forceinline__ bool next(int i, pg8::Unit& u) const { int pm, pn; if (!pg8::tile_of(i, G, c, NTOK / 256, nN, pm, pn)) return false;
        u.A = A + (size_t)pm * apan + (size_t)(pn / adiv) * acol; u.B = B + (size_t)pn * bpn + (size_t)(pm >> 3) * bbatch; u.C = nullptr; u.row0 = pm * 256; u.col0 = pn * cmul; u.aux = i; return true; }
};
struct SchedMoE {
    int G, c, nT; int tpre[17]; const char* A; size_t atile; const char* B; size_t bexp, bpn;
    __device__ __forceinline__ int expert_of(int tile) const { int e = 0;
#pragma unroll
        for (int k = 1; k < 16; ++k) e += (tile >= tpre[k]) ? 1 : 0;
        return e; }
    __device__ __forceinline__ int first_tile(int e) const { int t = 0;
#pragma unroll
        for (int k = 1; k < 16; ++k) t = (k == e) ? tpre[k] : t;
        return t; }
    __device__ __forceinline__ bool next(int i, pg8::Unit& u) const { int tile, pn; if (!pg8::tile_of(i, G, c, nT, 4, tile, pn)) return false;
        const int e = expert_of(tile);
        u.A = A + (size_t)tile * atile; u.B = B + (size_t)e * bexp + (size_t)pn * bpn; u.C = nullptr; u.row0 = tile * 256; u.col0 = pn * 256; u.aux = i; return true; }
};
__device__ __forceinline__ void moe_sched_init(SchedMoE& S, Frame& F, int l) {
    const unsigned* cnt = (const unsigned*)(F.ws + WS_CTL) + CW_CNT + l * 16 * 64;
    unsigned n[16];
#pragma unroll
    for (int e = 0; e < 16; ++e) n[e] = __hip_atomic_load(cnt + e * 64, __ATOMIC_RELAXED, __HIP_MEMORY_SCOPE_AGENT);
    int acc = 0;
#pragma unroll
    for (int e = 0; e < 16; ++e) { S.tpre[e] = acc; acc += ((int)__builtin_amdgcn_readfirstlane(n[e]) + 255) >> 8; }
    S.tpre[16] = acc; S.nT = acc; S.G = F.G; S.c = (int)blockIdx.x;
}
__device__ __forceinline__ void moe_fill_tables(const SchedMoE& S, Frame& F, int l, int mode) {
    const int* list = (const int*)(F.ws + WS_LIST); const float* rstd = (const float*)(F.ws + WS_RSTD_B); const float* gwv = (const float*)(F.ws + WS_GW);
    LAS int* tab = (LAS int*)(F.lds + TAB_OFF); LAS float* tab2 = (LAS float*)(F.lds + TAB2_OFF);
    const unsigned* cntp = (const unsigned*)(F.ws + WS_CTL) + CW_CNT + l * 16 * 64;
    if (F.tid < 256) {
        unsigned n[16];
#pragma unroll
        for (int e = 0; e < 16; ++e) n[e] = __hip_atomic_load(cntp + e * 64, __ATOMIC_RELAXED, __HIP_MEMORY_SCOPE_AGENT);
        int slot[MAXU]; bool valid[MAXU]; bool have[MAXU]; float aux[MAXU];
#pragma unroll
        for (int j = 0; j < MAXU; ++j) { pg8::Unit u; have[j] = S.next(j, u); slot[j] = 0; valid[j] = false;
            if (have[j]) { const int tile = u.row0 >> 8, e = S.expert_of(tile), tl = tile - S.first_tile(e), pos = tl * 256 + F.tid; int ne = (int)n[0];
#pragma unroll
                for (int k = 1; k < 16; ++k) ne = (k == e) ? (int)n[k] : ne;
                valid[j] = pos < ne;
                slot[j] = list[(size_t)e * NTOK + (valid[j] ? pos : 0)]; } }
#pragma unroll
        for (int j = 0; j < MAXU; ++j) { aux[j] = 0.f; if (have[j]) aux[j] = (mode == 0) ? rstd[slot[j] >> 1] : gwv[slot[j]]; }
#pragma unroll
        for (int j = 0; j < MAXU; ++j) if (have[j]) { tab[j * 256 + F.tid] = (mode == 0) ? (slot[j] >> 1) : (valid[j] ? slot[j] : -1); tab2[j * 256 + F.tid] = aux[j]; }
    }
    __syncthreads();
}

template <class Sched> __device__ __forceinline__ void fill_row_scale(const Sched& S, Frame& F, const float* src, int mode) {
    LAS float* tab2 = (LAS float*)(F.lds + TAB2_OFF);
    if (F.tid < 256) {
#pragma unroll
        for (int j = 0; j < MAXU; ++j) { pg8::Unit u; if (S.next(j, u)) { const int row = u.row0 + F.tid; float r;
            if (mode == 0) { const f32x4* sp = (const f32x4*)(src + (size_t)row * 16); const f32x4 qs = (sp[0] + sp[1]) + (sp[2] + sp[3]); r = __builtin_amdgcn_rsqf(((qs[0] + qs[1]) + (qs[2] + qs[3])) * (1.0f / 1024.0f) + EPS); }
            else r = src[row];
            tab2[j * 256 + F.tid] = r; } }
    }
    __syncthreads();
}

__device__ __forceinline__ void phase_router(Frame& F, const Args& args, int l, const bf16* H) {
    { const u32x4* src = (const u32x4*)(F.ws + WS_WRB + (size_t)l * 131072); LAS u32x4* dst = (LAS u32x4*)(F.lds + RING_OFF);
      u32x4 t[16];
#pragma unroll
      for (int i = 0; i < 16; ++i) t[i] = src[F.tid + 512 * i];
#pragma unroll
      for (int i = 0; i < 16; ++i) dst[F.tid + 512 * i] = t[i]; }
    __syncthreads();
    LAS float* lgs = (LAS float*)(F.lds + TAB_OFF) + F.wave * 336;
    LAS int* sel_e = (LAS int*)(F.lds + XCH_OFF); LAS float* sel_w = (LAS float*)(F.lds + XCH_OFF + 1024);
    LAS int* lcnt = (LAS int*)(F.lds + XCH_OFF + 2048); LAS int* lbase = lcnt + 16; LAS int* rnk = (LAS int*)(F.lds + XCH_OFF + 3072);
    unsigned* gcnt = (unsigned*)(F.ws + WS_CTL) + CW_CNT + l * 16 * 64;
    int* list = (int*)(F.ws + WS_LIST); float* gwv = (float*)(F.ws + WS_GW); float* rstd = (float*)(F.ws + WS_RSTD_B);
    const float* bg = args.in[I_MOE_BG] + l * 4; const float* be = args.in[I_MOE_BE] + l * 16;
    const int lane = F.lane, fr = lane & 15, fq = lane >> 4;
    for (int tb = F.vcu; tb < NTOK / 128; tb += F.G) {
        const int t0 = tb * 128 + F.wave * 16;
        const bf16* hp = H + (size_t)(t0 + fr) * 1024 + 8 * fq;
        f32x4 acc0 = {0.f, 0.f, 0.f, 0.f}, acc1 = {0.f, 0.f, 0.f, 0.f}; float ssq = 0.f;
        if (F.tid < 16) lcnt[F.tid] = 0;
#pragma unroll 16
        for (int ks = 0; ks < 32; ++ks) {
            const u32x4 av = *(const u32x4*)(hp + ks * 32);
            f32x4 x0, x1; unpack8(av, x0, x1); ssq += (x0[0] * x0[0] + x0[1] * x0[1]) + (x0[2] * x0[2] + x0[3] * x0[3]) + (x1[0] * x1[0] + x1[1] * x1[1]) + (x1[2] * x1[2] + x1[3] * x1[3]);
            const bf16x8 a = __builtin_bit_cast(bf16x8, av);
            const LAS bf16x8* bp = (const LAS bf16x8*)(F.lds + RING_OFF) + ks * 64 + lane;
            const bf16x8 b0 = bp[0], b1 = bp[2048], b2 = bp[4096], b3 = bp[6144];
            acc0 = __builtin_amdgcn_mfma_f32_16x16x32_bf16(a, b0, acc0, 0, 0, 0); acc0 = __builtin_amdgcn_mfma_f32_16x16x32_bf16(a, b2, acc0, 0, 0, 0);
            acc1 = __builtin_amdgcn_mfma_f32_16x16x32_bf16(a, b1, acc1, 0, 0, 0); acc1 = __builtin_amdgcn_mfma_f32_16x16x32_bf16(a, b3, acc1, 0, 0, 0);
        }
        ssq += __shfl_xor(ssq, 16); ssq += __shfl_xor(ssq, 32);
#pragma unroll
        for (int rg = 0; rg < 4; ++rg) { lgs[(4 * fq + rg) * 21 + fr] = acc0[rg]; if (fr < 4) lgs[(4 * fq + rg) * 21 + 16 + fr] = acc1[rg]; }
        LDS_WAIT(); asm volatile("" ::: "memory");
        if (lane < 16) {
            const float rs = __builtin_amdgcn_rsqf(ssq * (1.0f / 1024.0f) + EPS);
            const LAS float* lg = lgs + lane * 21;
            float g0 = lg[0] * rs + bg[0], g1 = lg[1] * rs + bg[1], g2 = lg[2] * rs + bg[2], g3 = lg[3] * rs + bg[3];
            int g = 0; float gm = g0; if (g1 > gm) { gm = g1; g = 1; } if (g2 > gm) { gm = g2; g = 2; } if (g3 > gm) { gm = g3; g = 3; }
            const float gp = 1.0f / (expf(g0 - gm) + expf(g1 - gm) + expf(g2 - gm) + expf(g3 - gm));
            float le[4];
#pragma unroll
            for (int k = 0; k < 4; ++k) le[k] = lg[4 + 4 * g + k] * rs + be[4 * g + k];
            int e1 = 0; float m1 = le[0];
#pragma unroll
            for (int k = 1; k < 4; ++k) if (le[k] > m1) { m1 = le[k]; e1 = k; }
            int e2 = -1; float m2 = -3.0e38f;
#pragma unroll
            for (int k = 0; k < 4; ++k) if (k != e1 && le[k] > m2) { m2 = le[k]; e2 = k; }
            const float z = expf(m2 - m1); const float q1 = 1.0f / (1.0f + z), q2 = z * q1;
            const int tl = F.wave * 16 + lane;
            sel_e[2 * tl] = 4 * g + e1; sel_e[2 * tl + 1] = 4 * g + e2; sel_w[2 * tl] = gp * q1; sel_w[2 * tl + 1] = gp * q2;
            rstd[t0 + lane] = rs;
        }
        __syncthreads();
        int my_e = 0;
        if (F.tid < 256) { my_e = sel_e[F.tid]; rnk[F.tid] = __hip_atomic_fetch_add(&lcnt[my_e], 1, __ATOMIC_RELAXED, __HIP_MEMORY_SCOPE_WORKGROUP); }
        __syncthreads();
        if (F.tid < 16) { const int n = lcnt[F.tid]; lbase[F.tid] = n ? (int)__hip_atomic_fetch_add(gcnt + F.tid * 64, (unsigned)n, __ATOMIC_RELAXED, __HIP_MEMORY_SCOPE_AGENT) : 0; }
        __syncthreads();
        if (F.tid < 256) { const int pos = lbase[my_e] + rnk[F.tid]; const int slot = tb * 256 + F.tid; list[(size_t)my_e * NTOK + pos] = slot; gwv[slot] = sel_w[F.tid]; }
        __syncthreads();
    }
}

__device__ __forceinline__ void phase_combine(Frame& F, const Args& args, int mode, const bf16* H, bf16* Hout, float* outf) {
    const int gw = F.vcu * 8 + F.wave, NGW = F.G * 8, lane = F.lane;
    const bf16* Y = (const bf16*)(F.ws + WS_Y); float* rstd = (float*)(F.ws + WS_RSTD_A);
    f32x4 gf[4];
    if (mode == 1) {
#pragma unroll
        for (int hf = 0; hf < 2; ++hf) { gf[2 * hf] = *(const f32x4*)(args.in[I_NORM_FINAL] + hf * 512 + 8 * lane); gf[2 * hf + 1] = *(const f32x4*)(args.in[I_NORM_FINAL] + hf * 512 + 8 * lane + 4); }
    }
    for (int t0 = gw; t0 < NTOK; t0 += 2 * NGW) {
        u32x4 hv[2][2], y0[2][2], y1[2][2];
#pragma unroll
        for (int q = 0; q < 2; ++q) { const int t = (t0 + q * NGW < NTOK) ? t0 + q * NGW : t0;
#pragma unroll
            for (int hf = 0; hf < 2; ++hf) { const size_t off = hf * 512 + 8 * lane;
                hv[q][hf] = *(const u32x4*)(H + (size_t)t * 1024 + off); y0[q][hf] = *(const u32x4*)(Y + (size_t)(2 * t) * 1024 + off); y1[q][hf] = *(const u32x4*)(Y + (size_t)(2 * t + 1) * 1024 + off); } }
#pragma unroll
        for (int q = 0; q < 2; ++q) { const int t = t0 + q * NGW; if (t >= NTOK) break;
            f32x4 v[4]; float ss = 0.f;
#pragma unroll
            for (int hf = 0; hf < 2; ++hf) {
                f32x4 a, b, c, d, e, f; unpack8(hv[q][hf], a, b); unpack8(y0[q][hf], c, d); unpack8(y1[q][hf], e, f); a += c + e; b += d + f; v[2 * hf] = a; v[2 * hf + 1] = b;
                ss += (a[0] * a[0] + a[1] * a[1]) + (a[2] * a[2] + a[3] * a[3]) + (b[0] * b[0] + b[1] * b[1]) + (b[2] * b[2] + b[3] * b[3]); }
            ss = wave_sum(ss);
            const float rs = __builtin_amdgcn_rsqf(ss * (1.0f / 1024.0f) + EPS);
            if (mode == 0) {
#pragma unroll
                for (int hf = 0; hf < 2; ++hf) *(u32x4*)(Hout + (size_t)t * 1024 + hf * 512 + 8 * lane) = pack8(v[2 * hf], v[2 * hf + 1]);
                if (lane == 0) rstd[t] = rs;
            } else {
#pragma unroll
                for (int hf = 0; hf < 2; ++hf) { float* op = outf + (size_t)t * 1024 + hf * 512 + 8 * lane; *(f32x4*)op = v[2 * hf] * gf[2 * hf] * rs; *(f32x4*)(op + 4) = v[2 * hf + 1] * gf[2 * hf + 1] * rs; }
            }
        }
    }
}

__device__ __forceinline__ void phase_conv(Frame& F, const Args& args, const bf16* XB, bf16* XC) {
    const int gw = F.vcu * 8 + F.wave, NGW = F.G * 8, lane = F.lane;
    const float* cw = args.in[I_RG_CONV_W]; const float* cbv = args.in[I_RG_CONV_B];
    for (int hf = 0; hf < 2; ++hf) {
        const int c0 = hf * 512 + 8 * lane;
        f32x4 w[4][2], cb[2];
#pragma unroll
        for (int k = 0; k < 4; ++k) { w[k][0] = *(const f32x4*)(cw + k * 1024 + c0); w[k][1] = *(const f32x4*)(cw + k * 1024 + c0 + 4); }
        cb[0] = *(const f32x4*)(cbv + c0); cb[1] = *(const f32x4*)(cbv + c0 + 4);
        for (int it = gw; it < NB * (SEQ / 16); it += NGW) {
            const int b = it >> 7, s0 = (it & 127) * 16; const bf16* xp = XB + (size_t)b * SEQ * D + c0; bf16* op = XC + (size_t)b * SEQ * D + c0;
            f32x4 xm[3][2];
#pragma unroll
            for (int j = 0; j < 3; ++j) { const int s = s0 - 3 + j; if (s >= 0) { const u32x4 v = *(const u32x4*)(xp + (size_t)s * D); unpack8(v, xm[j][0], xm[j][1]); } else { xm[j][0] = (f32x4){0.f, 0.f, 0.f, 0.f}; xm[j][1] = xm[j][0]; } }
#pragma unroll 4
            for (int s = s0; s < s0 + 16; ++s) { const u32x4 v = *(const u32x4*)(xp + (size_t)s * D); f32x4 x0, x1; unpack8(v, x0, x1);
                const f32x4 o0 = cb[0] + w[0][0] * xm[0][0] + w[1][0] * xm[1][0] + w[2][0] * xm[2][0] + w[3][0] * x0;
                const f32x4 o1 = cb[1] + w[0][1] * xm[0][1] + w[1][1] * xm[1][1] + w[2][1] * xm[2][1] + w[3][1] * x1;
                *(u32x4*)(op + (size_t)s * D) = pack8(o0, o1);
                xm[0][0] = xm[1][0]; xm[0][1] = xm[1][1]; xm[1][0] = xm[2][0]; xm[1][1] = xm[2][1]; xm[2][0] = x0; xm[2][1] = x1; }
        }
    }
}

constexpr int NSEG = 16, SEGL = SEQ / NSEG;
__device__ __forceinline__ void phase_scan1(Frame& F) {
    const int gw = F.vcu * 8 + F.wave, NGW = F.G * 8, lane = F.lane;
    const bf16* LA = (const bf16*)(F.ob + OB_LOGA); const bf16* BT = (const bf16*)(F.ob + OB_BT);
    float* AGS = (float*)(F.ws + WS_AGS); float* AGB = (float*)(F.ws + WS_AGB);
    for (int it = gw; it < NB * NSEG * 8; it += NGW) {
        const int cg = it & 7, sg = (it >> 3) & (NSEG - 1), b = it >> 7; const int ch = cg * 128 + 2 * lane;
        const size_t r0 = ((size_t)b * SEQ + sg * SEGL) * D + ch;
        float h0 = 0.f, h1 = 0.f, s0 = 0.f, s1 = 0.f;
#pragma unroll 16
        for (int s = 0; s < SEGL; ++s) { const unsigned lv = *(const unsigned*)(LA + r0 + (size_t)s * D), bv = *(const unsigned*)(BT + r0 + (size_t)s * D);
            const float l0 = bflo(lv), l1 = bfhi(lv); s0 += l0; s1 += l1;
            h0 = fast_exp2(l0 * LOG2E) * h0 + bflo(bv); h1 = fast_exp2(l1 * LOG2E) * h1 + bfhi(bv); }
        const size_t ao = ((size_t)b * NSEG + sg) * 1024 + ch;
        *(f32x2*)(AGS + ao) = (f32x2){s0, s1}; *(f32x2*)(AGB + ao) = (f32x2){h0, h1};
    }
}
__device__ __forceinline__ void scan2_item(const bf16* __restrict__ LA, const bf16* __restrict__ BT, const bf16* __restrict__ GATE, bf16* __restrict__ YRG, const float* __restrict__ AGS, const float* __restrict__ AGB, int it, int lane) {
    const int cg = it & 7, sg = (it >> 3) & (NSEG - 1), b = it >> 7; const int ch = cg * 128 + 2 * lane;
    f32x2 as[NSEG - 1], ab[NSEG - 1];
#pragma unroll
    for (int c = 0; c < NSEG - 1; ++c) { const size_t ao = ((size_t)b * NSEG + c) * 1024 + ch; as[c] = *(const f32x2*)(AGS + ao); ab[c] = *(const f32x2*)(AGB + ao); }
    float h0 = 0.f, h1 = 0.f;
#pragma unroll
    for (int c = 0; c < NSEG - 1; ++c) if (c < sg) { h0 = fast_exp2(as[c].x * LOG2E) * h0 + ab[c].x; h1 = fast_exp2(as[c].y * LOG2E) * h1 + ab[c].y; }
    const size_t r0 = ((size_t)b * SEQ + sg * SEGL) * D + ch;
#pragma nounroll
    for (int sb = 0; sb < SEGL; sb += 16) {
        unsigned lv[16], bv[16], gv[16];
#pragma unroll
        for (int k = 0; k < 16; ++k) { const size_t o = r0 + (size_t)(sb + k) * D; lv[k] = *(const unsigned*)(LA + o); bv[k] = *(const unsigned*)(BT + o); gv[k] = *(const unsigned*)(GATE + o); }
#pragma unroll
        for (int k = 0; k < 16; ++k) { h0 = fast_exp2(bflo(lv[k]) * LOG2E) * h0 + bflo(bv[k]); h1 = fast_exp2(bfhi(lv[k]) * LOG2E) * h1 + bfhi(bv[k]);
            *(unsigned*)(YRG + r0 + (size_t)(sb + k) * D) = cvt_pk_bf16(h0 * bflo(gv[k]), h1 * bfhi(gv[k])); }
    }
}
__device__ __forceinline__ void phase_scan2(Frame& F, const bf16* GATE, bf16* YRG) {
    const int gw = F.vcu * 8 + F.wave, NGW = F.G * 8;
    for (int it = gw; it < NB * NSEG * 8; it += NGW)
        scan2_item((const bf16*)(F.ob + OB_LOGA), (const bf16*)(F.ob + OB_BT), GATE, YRG, (const float*)(F.ws + WS_AGS), (const float*)(F.ws + WS_AGB), it, F.lane);
}

#if MK_PER_PHASE
#define GRID_BAR() do { } while (0)
#else
#if MK_TSEL >= 0
#define GRID_BAR() do { volatile LAS unsigned* _m = (volatile LAS unsigned*)(F.lds + MISC_OFF); const unsigned _t0 = (unsigned)__builtin_amdgcn_s_memrealtime(); xcd_barrier(bar); \
    if (threadIdx.x == 0) { const unsigned _k = _m[16]; const unsigned _t1 = (unsigned)__builtin_amdgcn_s_memrealtime(); if ((int)_k == MK_TSEL && !MK_GMODE) _m[18] = MK_TWAIT ? (_t1 - _t0) : (_t0 - _m[17]); _m[17] = _t1; _m[16] = _k + 1u; } } while (0)
#else
#define GRID_BAR() xcd_barrier(bar)
#endif
#endif
#ifndef MK_MASK
#define MK_MASK 0x1fffffu
#endif
#define IN(k) ((((MK_MASK) >> (k)) & 1u) && lo <= (k) && (k) < hi)
#define SEAM(k) do { if (lo <= (k) + 1 && (k) + 1 < hi) GRID_BAR(); } while (0)
#ifndef MK_DUP
#define MK_DUP 0u
#endif

template <int L>
__device__ __forceinline__ void mvw_gemm(Frame& F) {
    unsigned char* ws = F.ws;
    SchedMVW S{F.G, (int)blockIdx.x, (const char*)(ws + WS_K) + (size_t)L * 8388608, (const char*)(ws + WS_V) + (size_t)L * 8388608,
               (const char*)(ws + WS_W_Q) + (size_t)L * 2097152, (const char*)(ws + WS_W_OT) + (size_t)L * 2097152, (char*)(ws + WS_BS), (char*)(ws + WS_BO)};
    pg8::EpiMVW E{};
    pg8::gemm_phase<pg8::EpiMVW, SchedMVW, false>(F.lds + RING_OFF, 256, 2048u, 2048u, S, E, (LAS int*)(F.lds + TAB_OFF));
}
template <int L>
__device__ __forceinline__ void layer_phases(Frame& F, const Args& args, const XcdBarrier& bar, const int lo, const int hi) {
    unsigned char* ws = F.ws;
    LAS int* tab = (LAS int*)(F.lds + TAB_OFF); LAS float* tab2 = (LAS float*)(F.lds + TAB2_OFF);
    float* ss16 = (float*)(ws + WS_SS16);
    constexpr int ps = (L == 0) ? 3 : 15;
    if constexpr (L == 0) {
        if (IN(2)) {
            mvw_gemm<0>(F);
            SchedDense S{F.G, (int)blockIdx.x, 4, (const char*)(F.ob + OB_P0), (size_t)256 * 2048, (size_t)512, 1, (const char*)(ws + WS_W_POOL), (size_t)131072, 0, 256};
            pg8::EpiPool E{args.in[I_X], args.in[I_POOL_SCALE], (bf16*)(ws + WS_HA), ss16};
            pg8::gemm_phase<pg8::EpiPool, SchedDense, false>(F.lds + RING_OFF, 256, 2048u, 512u, S, E, tab);
            SEAM(2);
        }
    } else {
        const bf16* h3 = (const bf16*)(ws + WS_HA);
        bf16* XB = (bf16*)(ws + WS_HB); bf16* GATE = (bf16*)(ws + WS_Y); bf16* XC = (bf16*)(ws + WS_Y + 64 * MiB); bf16* YRG = (bf16*)(ws + WS_HB); bf16* HC = (bf16*)(ws + WS_Y);
        if (IN(9)) {
            SchedDense S{F.G, (int)blockIdx.x, 8, (const char*)h3, (size_t)256 * 2048, 0, 1, (const char*)(ws + WS_W_IN), (size_t)256 * 2048, 0, 256};
            fill_row_scale(S, F, (const float*)(ws + WS_RSTD_A), 1);
            pg8::EpiIn E{XB, GATE, tab2};
            pg8::gemm_phase<pg8::EpiIn, SchedDense, false>(F.lds + RING_OFF, 1024, 2048u, 2048u, S, E, tab);
            SEAM(9);
        }
        if (IN(10)) { phase_conv(F, args, XB, XC); SEAM(10); }
        if (IN(11)) {
            SchedDense S{F.G, (int)blockIdx.x, 8, (const char*)XC, (size_t)256 * 2048, (size_t)512, 2, (const char*)(ws + WS_W_GATE), (size_t)131072, 0, 128};
            pg8::EpiGates E{XC, (bf16*)(F.ob + OB_LOGA), (bf16*)(F.ob + OB_BT), args.in[I_RG_B_GATE], (const float*)(ws + WS_SPL)};
            pg8::gemm_phase<pg8::EpiGates, SchedDense, false>(F.lds + RING_OFF, 256, 2048u, 512u, S, E, tab);
            SEAM(11);
        }
        if (IN(12)) { phase_scan1(F); SEAM(12); }
        if (IN(13)) { phase_scan2(F, GATE, YRG); SEAM(13); }
        if (IN(14)) {
            SchedDense S{F.G, (int)blockIdx.x, 4, (const char*)YRG, (size_t)256 * 2048, 0, 1, (const char*)(ws + WS_W_OUT), (size_t)256 * 2048, 0, 256};
            pg8::EpiRes<true> E{h3, HC, ss16, nullptr, 1.0f};
            pg8::gemm_phase<pg8::EpiRes<true>, SchedDense, false>(F.lds + RING_OFF, 1024, 2048u, 2048u, S, E, tab);
            SEAM(14);
        }
    }
    const bf16* hmix = (L == 0) ? (const bf16*)(ws + WS_HA) : (const bf16*)(ws + WS_Y);
    bf16* hatt = (L == 0) ? (bf16*)(ws + WS_HB) : (bf16*)(ws + WS_HA);
    unsigned char* PATT = (unsigned char*)(F.ob + OB_PATT);
    if (IN(ps)) {
        SchedDense S{F.G, (int)blockIdx.x, 4, (const char*)hmix, (size_t)256 * 2048, 0, 1, (const char*)(ws + WS_BS), (size_t)256 * 2048, (size_t)2097152, 256};
        fill_row_scale(S, F, ss16, 0);
        pg8::EpiS E{PATT, tab2, (LAS f32x2*)(F.lds + XCH_OFF)};
        pg8::gemm_phase<pg8::EpiS, SchedDense, false>(F.lds + RING_OFF, 1024, 2048u, 2048u, S, E, tab);
        SEAM(ps);
    }
    if (IN(ps + 1)) {
        SchedDense S{F.G, (int)blockIdx.x, 4, (const char*)PATT, (size_t)256 * 1024, 0, 1, (const char*)(ws + WS_BO), (size_t)256 * 1024, (size_t)1048576, 256};
        pg8::EpiRes<false> E{hmix, hatt, ss16, (unsigned char*)(ws + WS_H8), 1.0f / (P8_SCALE * BO8_SCALE)};
        pg8::gemm_phase<pg8::EpiRes<false>, SchedDense, false, true>(F.lds + RING_OFF, 1024, 1024u, 1024u, S, E, tab);
        SEAM(ps + 1);
    }
    if (IN(ps + 2)) {
        phase_router(F, args, L, hatt);
        if constexpr (L == 0) { __syncthreads(); mvw_gemm<1>(F); }
        SEAM(ps + 2);
    }
    if (IN(ps + 3)) {
        SchedMoE S; moe_sched_init(S, F, L); S.A = (const char*)(ws + WS_H8); S.atile = 0; S.B = (const char*)(ws + WS_W_GU) + (size_t)L * 16777216; S.bexp = 1048576; S.bpn = (size_t)256 * 1024;
        moe_fill_tables(S, F, L, 0);
        pg8::EpiGU E{(unsigned char*)(F.ob + OB_HMID), tab2};
        pg8::gemm_phase<pg8::EpiGU, SchedMoE, true, true>(F.lds + RING_OFF, 1024, 1024u, 1024u, S, E, tab);
        SEAM(ps + 3);
    }
    if (IN(ps + 4)) {
        SchedMoE S; moe_sched_init(S, F, L); S.A = (const char*)(F.ob + OB_HMID); S.atile = (size_t)256 * 512; S.B = (const char*)(ws + WS_W_DOWN) + (size_t)L * 8388608; S.bexp = 524288; S.bpn = (size_t)256 * 512;
        moe_fill_tables(S, F, L, 1);
        pg8::EpiDown E{(bf16*)(ws + WS_Y), tab, tab2};
        pg8::gemm_phase<pg8::EpiDown, SchedMoE, false, true>(F.lds + RING_OFF, 512, 512u, 512u, S, E, tab);
        SEAM(ps + 4);
    }
    if (IN(ps + 5)) {
        if constexpr (L == 0) { phase_combine(F, args, 0, hatt, (bf16*)(ws + WS_HA), nullptr); SEAM(ps + 5); }
        else phase_combine(F, args, 1, hatt, nullptr, args.out);
    }
}

__global__ void __launch_bounds__(512, 2) hybrid_fwd(Args args) {
    extern __shared__ __attribute__((aligned(16))) unsigned char lds[];
    Frame F;
    F.lds = (LAS unsigned char*)lds;
    F.tid = threadIdx.x; F.lane = F.tid & 63; F.wave = __builtin_amdgcn_readfirstlane(F.tid >> 6);
    F.G = gridDim.x; { const int bx = blockIdx.x; F.vcu = (F.G % 8 == 0) ? (bx % 8) * (F.G / 8) + bx / 8 : bx; }
    F.ws = args.ws; F.ob = (unsigned char*)args.out;
    volatile LAS unsigned* MISC = (volatile LAS unsigned*)(F.lds + MISC_OFF);
    for (int u = F.tid; u < (LDS_BYTES - MISC_OFF) / 4; u += 512) ((LAS unsigned*)(F.lds + MISC_OFF))[u] = 0u;
    __syncthreads();
    unsigned* ctl = (unsigned*)(F.ws + WS_CTL);
#if MK_PER_PHASE
    XcdBarrier bar; bar.bar = ctl + CW_BAR; bar.x = 0; bar.st = nullptr;
#else
    XcdBarrier bar = xcd_barrier_post(ctl + CW_BAR, MISC + 8);
#endif
    const int lo = args.ph_lo, hi = args.ph_hi;
    unsigned char* ws = F.ws;
    LAS int* tab = (LAS int*)(F.lds + TAB_OFF);
#if MK_TSEL >= 0
    if (threadIdx.x == 0) MISC[17] = (unsigned)__builtin_amdgcn_s_memrealtime();
#endif

    if (IN(0)) { phase_prologue(F, args); SEAM(0); }
    if (IN(1)) {
        phase_pool_p(F, args);
        __syncthreads();
        SchedKV S{F.G, (int)blockIdx.x, (const char*)(ws + WS_MEMN), (const char*)(ws + WS_W_KV), (char*)(ws + WS_K), (char*)(ws + WS_V)};
        pg8::EpiPlain E{1024};
        pg8::gemm_phase<pg8::EpiPlain, SchedKV, false>(F.lds + RING_OFF, 1024, 2048u, 2048u, S, E, tab);
        SEAM(1);
    }
    layer_phases<0>(F, args, bar, lo, hi);
    layer_phases<1>(F, args, bar, lo, hi);
#if MK_TSEL >= 0
    if ((int)blockIdx.x == MK_TBLK && threadIdx.x == 0) { const unsigned long long w = (unsigned long long)MISC[18] * MK_TAMP, t0 = __builtin_amdgcn_s_memrealtime();
        while (__builtin_amdgcn_s_memrealtime() - t0 < w) __builtin_amdgcn_s_sleep(8); }
#endif
}
#undef IN
#undef SEAM

extern "C" void kernel_launch(void* const* d_in, const int* in_sizes, int n_in, void* d_out, int out_size, void* d_ws, size_t ws_size, hipStream_t stream) {
    static int grid = 0;
    if (grid == 0) {
        if (n_in != 25 || out_size != NTOK * D || ws_size < WS_END) { fprintf(stderr, "kernel_launch: unexpected shapes (n_in %d, out %d, ws %zu)\n", n_in, out_size, ws_size); grid = -1; return; }
        int dev = 0, cus = 0, per_cu = 0;
        if (hipGetDevice(&dev) != hipSuccess || hipDeviceGetAttribute(&cus, hipDeviceAttributeMultiprocessorCount, dev) != hipSuccess) { grid = -1; return; }
        if (hipFuncSetAttribute((const void*)hybrid_fwd, hipFuncAttributeMaxDynamicSharedMemorySize, LDS_BYTES) != hipSuccess) { fprintf(stderr, "kernel_launch: hipFuncSetAttribute failed\n"); grid = -1; return; }
        if (hipOccupancyMaxActiveBlocksPerMultiprocessor(&per_cu, (const void*)hybrid_fwd, 512, LDS_BYTES) != hipSuccess || per_cu < 1) fprintf(stderr, "kernel_launch: occupancy query reports %d\n", per_cu);
        (void)hipGetLastError();
        grid = cus;
    }
    if (grid < 0) return;
    (void)hipMemsetAsync((char*)d_ws + WS_CTL, 0, CTL_ZERO_BYTES, stream);
    Args a{};
    for (int i = 0; i < 25; ++i) a.in[i] = (const float*)d_in[i];
    a.out = (float*)d_out; a.ws = (unsigned char*)d_ws; a.dup = 0; a.pad = 0;
#if MK_PER_PHASE
    for (int p = 0; p < NPH; ++p) for (int r = 0; r < ((((MK_DUP) >> p) & 1u) ? 2 : 1); ++r) {
        if (r == 1 && (p == 5 || p == 17)) (void)hipMemsetAsync((char*)d_ws + WS_CTL + (size_t)(CW_CNT + (p == 17 ? 1 : 0) * 16 * 64) * 4, 0, 16 * 64 * 4, stream);
        a.ph_lo = p; a.ph_hi = p + 1; hipLaunchKernelGGL(hybrid_fwd, dim3(grid), dim3(512), LDS_BYTES, stream, a); }
#else
    a.ph_lo = 0; a.ph_hi = NPH; hipLaunchKernelGGL(hybrid_fwd, dim3(grid), dim3(512), LDS_BYTES, stream, a);
#endif
}
```

```cpp
#include <hip/hip_runtime.h>
#include <cstdio>
#include <cstdint>

#ifndef MK_KREP
#define MK_KREP 1
#endif
#ifndef MK_TSEL
#define MK_TSEL -1
#endif
#ifndef MK_TBLK
#define MK_TBLK 0
#endif
#ifndef MK_TAMP
#define MK_TAMP 8
#endif
#ifndef MK_TWAIT
#define MK_TWAIT 0
#endif
#ifndef MK_GMODE
#define MK_GMODE 0
#endif
#ifndef MK_PER_PHASE
#define MK_PER_PHASE 0
#endif

#define GAS __attribute__((address_space(1)))
#define LAS __attribute__((address_space(3)))
typedef unsigned short bf16;
typedef short bf16x8 __attribute__((ext_vector_type(8)));
typedef float f32x4 __attribute__((ext_vector_type(4)));
typedef float f32x2 __attribute__((ext_vector_type(2)));
typedef unsigned u32x4 __attribute__((ext_vector_type(4)));
typedef unsigned u32x2 __attribute__((ext_vector_type(2)));

constexpr int NB = 16, SEQ = 2048, D = 1024, NTOK = NB * SEQ, MEML = 256, NMR = NB * MEML;
constexpr int NEXP = 16, DE = 512;
constexpr float EPS = 1e-6f;
constexpr float LOG2E = 1.4426950408889634f;
constexpr int NPH = 21;
constexpr float W8_GU_SCALE = 32.0f, W8_DOWN_SCALE = 16.0f, H8_MID_SCALE = 4.0f;
constexpr float P8_SCALE = 256.0f, BO8_SCALE = 4.0f, BS8_SCALE = 16.0f;

constexpr size_t MiB = 1u << 20;
constexpr size_t WS_CTL = 0, CTL_ZERO_BYTES = 1 * MiB;
constexpr int CW_BAR = 4096;
constexpr int CW_CNT = 16384;
constexpr size_t WS_RSTD_A = 1 * MiB;
constexpr size_t WS_RSTD_B = 1 * MiB + 128 * 1024;
constexpr size_t WS_RSTD_X = 1 * MiB + 256 * 1024;
constexpr size_t WS_SS16 = 2 * MiB;
constexpr size_t WS_WRB = 4 * MiB;
constexpr size_t WS_SPL = 4 * MiB + 256 * 1024;
constexpr size_t WS_GW = 5 * MiB;
constexpr size_t WS_LIST = 6 * MiB;
constexpr size_t WS_W_POOL = 8 * MiB;
constexpr size_t WS_W_GATE = 8 * MiB + 512 * 1024;
constexpr size_t WS_W_OUT = 10 * MiB;
constexpr size_t WS_W_IN = 12 * MiB;
constexpr size_t WS_W_Q = 16 * MiB;
constexpr size_t WS_W_OT = 20 * MiB;
constexpr size_t WS_W_KV = 24 * MiB;
constexpr size_t WS_W_DOWN = 32 * MiB;
constexpr size_t WS_W_GU = 64 * MiB;
constexpr size_t WS_K = 128 * MiB;
constexpr size_t WS_V = 144 * MiB;
constexpr size_t WS_BS = 160 * MiB;
constexpr size_t WS_BO = 192 * MiB;
constexpr size_t WS_HA = 224 * MiB;
constexpr size_t WS_HB = 288 * MiB;
constexpr size_t WS_MEMN = 352 * MiB;
constexpr size_t WS_AGS = 368 * MiB;
constexpr size_t WS_AGB = 372 * MiB;
constexpr size_t WS_Y = 384 * MiB;
constexpr size_t WS_END = 512 * MiB;
constexpr size_t OB_P0 = 0, OB_PATT = 64 * MiB, OB_HMID = 0, OB_LOGA = 0, OB_BT = 64 * MiB, OB_HMIX8 = 96 * MiB;
constexpr size_t WS_H8 = WS_Y + 64 * MiB;

constexpr int RING_OFF = 0, RING_BYTES = 131072;
constexpr int XCH_OFF = 131072;
constexpr int TAB_OFF = 139264;
constexpr int TAB2_OFF = 147456;
constexpr int MISC_OFF = 155648;
constexpr int LDS_BYTES = 155904;
constexpr int MAXU = 8;

#define LDS_WAIT() asm volatile("s_waitcnt lgkmcnt(0)" ::: "memory")
#define VM_WAIT() asm volatile("s_waitcnt vmcnt(0)" ::: "memory")

__device__ __forceinline__ unsigned f2bf(float f) { unsigned u = __builtin_bit_cast(unsigned, f); return (u + 0x7fffu + ((u >> 16) & 1u)) >> 16; }
__device__ __forceinline__ unsigned pk2(float lo, float hi) { return f2bf(lo) | (f2bf(hi) << 16); }
__device__ __forceinline__ float bflo(unsigned w) { return __builtin_bit_cast(float, w << 16); }
__device__ __forceinline__ float bfhi(unsigned w) { return __builtin_bit_cast(float, w & 0xffff0000u); }
__device__ __forceinline__ unsigned cvt_pk_bf16(float lo, float hi) { unsigned r; asm volatile("v_cvt_pk_bf16_f32 %0, %1, %2" : "=v"(r) : "v"(lo), "v"(hi)); return r; }
__device__ __forceinline__ u32x4 pack8(f32x4 a, f32x4 b) { u32x4 w; w.x = cvt_pk_bf16(a[0], a[1]); w.y = cvt_pk_bf16(a[2], a[3]); w.z = cvt_pk_bf16(b[0], b[1]); w.w = cvt_pk_bf16(b[2], b[3]); return w; }
__device__ __forceinline__ void unpack8(u32x4 w, f32x4& a, f32x4& b) { a[0] = bflo(w.x); a[1] = bfhi(w.x); a[2] = bflo(w.y); a[3] = bfhi(w.y); b[0] = bflo(w.z); b[1] = bfhi(w.z); b[2] = bflo(w.w); b[3] = bfhi(w.w); }
__device__ __forceinline__ u32x2 pack8_fp8(f32x4 a, f32x4 b) {
#pragma unroll
    for (int j = 0; j < 4; ++j) { a[j] = __builtin_amdgcn_fmed3f(a[j], -384.0f, 384.0f); b[j] = __builtin_amdgcn_fmed3f(b[j], -384.0f, 384.0f); }
    int lo = 0, hi = 0;
    lo = __builtin_amdgcn_cvt_pk_fp8_f32(a[0], a[1], lo, false); lo = __builtin_amdgcn_cvt_pk_fp8_f32(a[2], a[3], lo, true);
    hi = __builtin_amdgcn_cvt_pk_fp8_f32(b[0], b[1], hi, false); hi = __builtin_amdgcn_cvt_pk_fp8_f32(b[2], b[3], hi, true);
    return (u32x2){(unsigned)lo, (unsigned)hi};
}
__device__ __forceinline__ float wave_sum(float v) {
    v += __builtin_bit_cast(float, __builtin_amdgcn_update_dpp(0, __builtin_bit_cast(int, v), 0xB1, 0xF, 0xF, false));
    v += __builtin_bit_cast(float, __builtin_amdgcn_update_dpp(0, __builtin_bit_cast(int, v), 0x4E, 0xF, 0xF, false));
    v += __builtin_bit_cast(float, __builtin_amdgcn_update_dpp(0, __builtin_bit_cast(int, v), 0x141, 0xF, 0xF, false));
    v += __builtin_bit_cast(float, __builtin_amdgcn_update_dpp(0, __builtin_bit_cast(int, v), 0x140, 0xF, 0xF, false));
    v += __shfl_xor(v, 16); v += __shfl_xor(v, 32);
    return v;
}
__device__ __forceinline__ float fast_exp2(float x) { return __builtin_amdgcn_exp2f(x); }
__device__ __forceinline__ float fast_rcp(float x) { return __builtin_amdgcn_rcpf(x); }
__device__ __forceinline__ float sigmoidf_(float x) { return fast_rcp(1.0f + fast_exp2(-x * LOG2E)); }

namespace pg8 {
constexpr int BM = 256, BK = 64, HALF = 128, HTB = HALF * BK * 2, STAGE_BYTES = 8 * HTB, NXCD = 8, WGM = 8;
__host__ __device__ __forceinline__ int lds_byte(int r, int c) { const int st = (r >> 4) * 2 + (c >> 5), rr = r & 15, cc = c & 31, ob = rr * 64 + cc * 2; return st * 1024 + (ob ^ (((ob >> 9) & 1) << 5)); }
__host__ __device__ __forceinline__ void stage_rc(int b, int& R, int& C) { const int st = b / 1024, sb = b % 1024, swz = sb ^ (((sb >> 9) & 1) << 5); R = (st >> 1) * 16 + swz / 64; C = (st & 1) * 32 + (swz % 64) / 2; }
__host__ __device__ __forceinline__ int perm32(int rho) { const int n = rho >> 4, i = rho & 15; return 8 * (i >> 2) + 4 * n + (i & 3); }

struct Unit { const char* A; const char* B; char* C; int row0, col0, aux; };

__device__ __forceinline__ bool tile_of(int i, int G, int c, int nM, int nN, int& pm, int& pn) {
    const int nwg = nM * nN; const long L = (long)i * G + c; if (L >= nwg) return false;
    int wgid = (int)L; { const int q = nwg / NXCD, r = nwg % NXCD, xcd = wgid % NXCD, off = wgid / NXCD; wgid = (xcd < r ? xcd * (q + 1) : r * (q + 1) + (xcd - r) * q) + off; }
    const int nig = WGM * nN, gid = wgid / nig, fm = gid * WGM, gsz = (nM - fm) < WGM ? (nM - fm) : WGM;
    pm = fm + ((wgid % nig) % gsz); pn = (wgid % nig) / gsz; return true;
}

typedef int i32x8 __attribute__((ext_vector_type(8)));
template <class Epi, class Sched, bool GATHER, bool F8 = false>
__device__ __forceinline__ void gemm_phase(LAS unsigned char* lds, const int K, const unsigned lda, const unsigned ldb, const Sched& S, const Epi& E, const LAS int* tab) {
    const int tid = threadIdx.x, wid = __builtin_amdgcn_readfirstlane(tid >> 6), lane = tid & 63, wr = wid >> 2, wc = wid & 3, fr = lane & 15, fq = lane >> 4;
    const int nt = F8 ? K / 128 : K / BK;
    unsigned vA[2], vB[2], vG[2][2]; int rA[2]; unsigned cA2[2];
#pragma unroll
    for (int i = 0; i < 2; ++i) { int R, C; stage_rc(tid * 16 + i * 8192, R, C); const int Rb = (R & ~31) + perm32(R & 31);
        vA[i] = (unsigned)R * lda + (unsigned)C * 2u; vB[i] = (unsigned)Rb * ldb + (unsigned)C * 2u; rA[i] = R; cA2[i] = (unsigned)C * 2u; vG[0][i] = 0; vG[1][i] = 0; }
    const size_t kstep = (size_t)(BK * 2);
    const size_t hsA = (size_t)HALF * lda, hsB = (size_t)HALF * ldb;
    const unsigned ldsw = (unsigned)wid * 1024u;
    const int aoff = lds_byte(wr * 64 + fr, fq * (F8 ? 16 : 8)), boff = lds_byte(wc * 32 + fr, fq * (F8 ? 16 : 8));
#define PG8_SA(b, h) (((b) * 2 + (h)) * HTB)
#define PG8_SB(b, h) ((4 + (b) * 2 + (h)) * HTB)
#define PG8_STAGE_B(bufoff, gbase) do { _Pragma("unroll") for (int _i = 0; _i < 2; ++_i) \
        __builtin_amdgcn_global_load_lds((const unsigned*)((const char*)(gbase) + vB[_i]), (LAS unsigned*)(lds + (bufoff) + ldsw + _i * 8192), 16, 0, 0); } while (0)
#define PG8_STAGE_A(bufoff, gbase, h) do { _Pragma("unroll") for (int _i = 0; _i < 2; ++_i) { \
        if constexpr (GATHER) __builtin_amdgcn_global_load_lds((const unsigned*)((const char*)(gbase) + vG[h][_i]), (LAS unsigned*)(lds + (bufoff) + ldsw + _i * 8192), 16, 0, 0); \
        else __builtin_amdgcn_global_load_lds((const unsigned*)((const char*)(gbase) + (h) * hsA + vA[_i]), (LAS unsigned*)(lds + (bufoff) + ldsw + _i * 8192), 16, 0, 0); } } while (0)
#define PG8_LOADG(ui_) do { const int _u = ((ui_) < MAXU ? (ui_) : (MAXU - 1)) * 256; _Pragma("unroll") for (int _h = 0; _h < 2; ++_h) _Pragma("unroll") for (int _i = 0; _i < 2; ++_i) \
        vG[_h][_i] = (unsigned)tab[_u + rA[_i] + 128 * _h] * lda + cA2[_i]; } while (0)
#define PG8_LDA(dst, b, h) do { if constexpr (F8) { _Pragma("unroll") for (int m = 0; m < 4; ++m) dst##8[m] = *(const LAS i32x8*)(lds + PG8_SA(b, h) + aoff + m * 2048); } \
        else { _Pragma("unroll") for (int m = 0; m < 4; ++m) _Pragma("unroll") for (int k = 0; k < 2; ++k) dst[m][k] = *(const LAS bf16x8*)(lds + PG8_SA(b, h) + aoff + m * 2048 + k * 1024); } } while (0)
#define PG8_LDB(dst, b, h) do { if constexpr (F8) { _Pragma("unroll") for (int n = 0; n < 2; ++n) dst##8[n] = *(const LAS i32x8*)(lds + PG8_SB(b, h) + boff + n * 2048); } \
        else { _Pragma("unroll") for (int n = 0; n < 2; ++n) _Pragma("unroll") for (int k = 0; k < 2; ++k) dst[n][k] = *(const LAS bf16x8*)(lds + PG8_SB(b, h) + boff + n * 2048 + k * 1024); } } while (0)
#define PG8_MMA(ai, bj, At, Bt) do { __builtin_amdgcn_s_setprio(1); _Pragma("unroll") for (int m = 0; m < 4; ++m) _Pragma("unroll") for (int n = 0; n < 2; ++n) { \
        if constexpr (F8) { asm volatile("v_mfma_f32_16x16x128_f8f6f4 %0, %1, %2, %0" : "+v"(acc[ai][bj][m][n]) : "v"(Bt##8[n]), "v"(At##8[m])); } \
        else { _Pragma("unroll") for (int k = 0; k < 2; ++k) acc[ai][bj][m][n] = __builtin_amdgcn_mfma_f32_16x16x32_bf16(Bt[n][k], At[m][k], acc[ai][bj][m][n], 0, 0, 0); } } \
        __builtin_amdgcn_s_setprio(0); } while (0)
#define PG8_WAIT_V(n) asm volatile("s_waitcnt vmcnt(" #n ")" ::: "memory")
#define PG8_WAIT_L(n) asm volatile("s_waitcnt lgkmcnt(" #n ")" ::: "memory")
#define PG8_BAR __builtin_amdgcn_s_barrier()
#define PG8_SCHED __builtin_amdgcn_sched_barrier(0)
#if MK_GMODE
    volatile LAS unsigned* _gm = (volatile LAS unsigned*)(lds + 155648);
    const bool _gsel = (threadIdx.x == 0) && ((int)_gm[16] == MK_TSEL);
    unsigned _gt = (unsigned)__builtin_amdgcn_s_memrealtime(); unsigned _gacc = 0;
#define PG8_GSTAMP(mode_) do { if (_gsel) { const unsigned _n = (unsigned)__builtin_amdgcn_s_memrealtime(); if (MK_GMODE == (mode_)) _gacc += _n - _gt; _gt = _n; } } while (0)
#else
#define PG8_GSTAMP(mode_) do { } while (0)
#endif
    Unit cur, nxt; int ui = 0;
    if (!S.next(0, cur)) return;
    f32x4 acc[2][2][4][2];
#pragma unroll
    for (int a = 0; a < 2; ++a)
#pragma unroll
        for (int b = 0; b < 2; ++b)
#pragma unroll
            for (int m = 0; m < 4; ++m)
#pragma unroll
                for (int n = 0; n < 2; ++n) acc[a][b][m][n] = (f32x4){0.f, 0.f, 0.f, 0.f};
    bf16x8 At[4][2], B0[2][2], B1[2][2]; i32x8 At8[4], B08[2], B18[2];
    const char* cA = cur.A; const char* cB = cur.B;
    if constexpr (GATHER) { PG8_LOADG(0); }
    PG8_STAGE_B(PG8_SB(0, 0), cB); PG8_STAGE_B(PG8_SB(0, 1), cB + hsB); PG8_STAGE_A(PG8_SA(0, 0), cA, 0); PG8_STAGE_A(PG8_SA(0, 1), cA, 1);
    if (wr == 1) PG8_BAR;
    PG8_WAIT_V(2); PG8_BAR;
    PG8_STAGE_B(PG8_SB(1, 0), cB + kstep); PG8_STAGE_A(PG8_SA(1, 0), cA + kstep, 0); PG8_STAGE_B(PG8_SB(1, 1), cB + hsB + kstep);
    PG8_WAIT_V(6); PG8_BAR;
    PG8_GSTAMP(1);
    for (;;) {
        const bool has_next = S.next(ui + 1, nxt);
        const char* nA = has_next ? nxt.A : cA; const char* nB = has_next ? nxt.B : cB;
#pragma nounroll
        for (int t = 0; t < nt * MK_KREP; t += 2) {
            const bool last = (t == nt * MK_KREP - 2);
            const char* a1 = cA + (size_t)(MK_KREP == 1 ? (t + 1) : ((t + 1) % nt)) * kstep;
            const int t2 = (MK_KREP == 1) ? (t + 2) : ((t + 2) % nt);
            const char* a2 = last ? nA : cA + (size_t)t2 * kstep; const char* b2 = last ? nB : cB + (size_t)t2 * kstep;
            const char* a3 = a2 + kstep; const char* b3 = b2 + kstep;
            PG8_LDB(B0, 0, 0); PG8_LDB(B1, 0, 1); PG8_SCHED; PG8_LDA(At, 0, 0); PG8_STAGE_A(PG8_SA(1, 1), a1, 1);
            PG8_WAIT_V(8); PG8_WAIT_L(0); PG8_BAR; PG8_MMA(0, 0, At, B0); PG8_MMA(0, 1, At, B1); PG8_BAR; PG8_SCHED;
            if constexpr (GATHER) { if (last && has_next) { PG8_LOADG(ui + 1); } }
            PG8_LDA(At, 0, 1); PG8_STAGE_B(PG8_SB(0, 0), b2); PG8_STAGE_B(PG8_SB(0, 1), b2 + hsB); PG8_STAGE_A(PG8_SA(0, 0), a2, 0);
            PG8_WAIT_V(8); PG8_WAIT_L(0); PG8_BAR; PG8_MMA(1, 0, At, B0); PG8_MMA(1, 1, At, B1); PG8_BAR; PG8_SCHED;
            PG8_LDB(B0, 1, 0); PG8_LDB(B1, 1, 1); PG8_SCHED; PG8_LDA(At, 1, 0); PG8_STAGE_A(PG8_SA(0, 1), a2, 1);
            PG8_WAIT_V(8); PG8_WAIT_L(0); PG8_BAR; PG8_MMA(0, 0, At, B0); PG8_MMA(0, 1, At, B1); PG8_BAR; PG8_SCHED;
            PG8_LDA(At, 1, 1); PG8_STAGE_B(PG8_SB(1, 0), b3); PG8_STAGE_B(PG8_SB(1, 1), b3 + hsB); PG8_STAGE_A(PG8_SA(1, 0), a3, 0);
            PG8_WAIT_V(8); PG8_WAIT_L(0); PG8_BAR; PG8_MMA(1, 0, At, B0); PG8_MMA(1, 1, At, B1); PG8_BAR; PG8_SCHED;
        }
        if (wr == 0) PG8_BAR;
        PG8_GSTAMP(4);
        if constexpr (F8) asm volatile("s_nop 15\n\ts_nop 15\n\ts_nop 15\n\ts_nop 15" ::: "memory");
        if (MK_KREP != 1) {
#pragma unroll
            for (int a = 0; a < 2; ++a)
#pragma unroll
                for (int b = 0; b < 2; ++b)
#pragma unroll
                    for (int m = 0; m < 4; ++m)
#pragma unroll
                        for (int n = 0; n < 2; ++n) acc[a][b][m][n] *= (1.0f / MK_KREP);
        }
        E(acc, cur, wr, wc, fr, fq);
        PG8_GSTAMP(2);
        if (!has_next) break;
#pragma unroll
        for (int a = 0; a < 2; ++a)
#pragma unroll
            for (int b = 0; b < 2; ++b)
#pragma unroll
                for (int m = 0; m < 4; ++m)
#pragma unroll
                    for (int n = 0; n < 2; ++n) acc[a][b][m][n] = (f32x4){0.f, 0.f, 0.f, 0.f};
        cur = nxt; cA = nA; cB = nB; ++ui;
        if (wr == 1) PG8_BAR;
    }
    PG8_WAIT_V(0);
    PG8_BAR;
    PG8_GSTAMP(3);
#if MK_GMODE
    if (_gsel) _gm[18] = _gacc;
#endif
#undef PG8_GSTAMP
#undef PG8_SA
#undef PG8_SB
#undef PG8_STAGE_A
#undef PG8_STAGE_B
#undef PG8_LOADG
#undef PG8_LDA
#undef PG8_LDB
#undef PG8_MMA
#undef PG8_WAIT_V
#undef PG8_WAIT_L
#undef PG8_BAR
#undef PG8_SCHED
}

typedef f32x4 Acc[2][2][4][2];
#ifndef MK_EPI_SC1
#define MK_EPI_SC1 0
#endif
__device__ __forceinline__ void st16(bf16* p, u32x4 v) {
#if MK_EPI_SC1
    asm volatile("global_store_dwordx4 %0, %1, off sc1\n\ts_nop 1" :: "v"(p), "v"(v) : "memory");
#else
    *(u32x4*)p = v;
#endif
}

struct EpiPlain {
    int ldc;
    __device__ __forceinline__ void operator()(Acc& acc, const Unit& u, int wr, int wc, int fr, int fq) const {
        bf16* base = (bf16*)u.C + (size_t)(wr * 64 + fr) * ldc + wc * 32 + 8 * fq;
#pragma unroll
        for (int ai = 0; ai < 2; ++ai)
#pragma unroll
            for (int m = 0; m < 4; ++m) { bf16* rowp = base + (size_t)(ai * 128 + m * 16) * ldc;
#pragma unroll
                for (int bj = 0; bj < 2; ++bj) st16(rowp + bj * 128, pack8(acc[ai][bj][m][0], acc[ai][bj][m][1])); }
    }
};
struct EpiMVW {
    __device__ __forceinline__ void operator()(Acc& acc, const Unit& u, int wr, int wc, int fr, int fq) const {
        const float sc = u.col0 ? BO8_SCALE : BS8_SCALE;
        unsigned char* base = (unsigned char*)u.C + (size_t)(wr * 64 + fr) * 1024 + wc * 32 + 8 * fq;
#pragma unroll
        for (int ai = 0; ai < 2; ++ai)
#pragma unroll
            for (int m = 0; m < 4; ++m) { unsigned char* rowp = base + (size_t)(ai * 128 + m * 16) * 1024;
#pragma unroll
                for (int bj = 0; bj < 2; ++bj) *(u32x2*)(rowp + bj * 128) = pack8_fp8(acc[ai][bj][m][0] * sc, acc[ai][bj][m][1] * sc); }
    }
};
template <bool STATS> struct EpiRes {
    const bf16* hin; bf16* hout; float* ss16; unsigned char* h8; float ascale;
    __device__ __forceinline__ void operator()(Acc& acc, const Unit& u, int wr, int wc, int fr, int fq) const {
        const size_t ro0 = (size_t)(u.row0 + wr * 64 + fr) * 1024 + u.col0 + wc * 32 + 8 * fq;
        u32x4 hv[2][4][2];
#pragma unroll
        for (int ai = 0; ai < 2; ++ai)
#pragma unroll
            for (int m = 0; m < 4; ++m)
#pragma unroll
                for (int bj = 0; bj < 2; ++bj) hv[ai][m][bj] = *(const u32x4*)(hin + ro0 + (size_t)(ai * 128 + m * 16) * 1024 + bj * 128);
#pragma unroll
        for (int ai = 0; ai < 2; ++ai)
#pragma unroll
            for (int m = 0; m < 4; ++m) { const int row = u.row0 + ai * 128 + wr * 64 + m * 16 + fr; const size_t ro = ro0 + (size_t)(ai * 128 + m * 16) * 1024; float s = 0.f;
#pragma unroll
                for (int bj = 0; bj < 2; ++bj) { f32x4 a, b; unpack8(hv[ai][m][bj], a, b); a += acc[ai][bj][m][0] * ascale; b += acc[ai][bj][m][1] * ascale;
                    if constexpr (STATS) s += (a[0] * a[0] + a[1] * a[1]) + (a[2] * a[2] + a[3] * a[3]) + (b[0] * b[0] + b[1] * b[1]) + (b[2] * b[2] + b[3] * b[3]);
                    st16(hout + ro + bj * 128, pack8(a, b)); if (h8) *(u32x2*)(h8 + ro + bj * 128) = pack8_fp8(a, b); }
                if constexpr (STATS) { s += __shfl_xor(s, 16); s += __shfl_xor(s, 32);
                    if (fq == 0) ss16[(size_t)row * 16 + (u.col0 >> 8) * 4 + wc] = s; } }
    }
};
struct EpiPool {
    const float* x; const float* scale; bf16* hout; float* ss16; unsigned char* h8;
    __device__ __forceinline__ void operator()(Acc& acc, const Unit& u, int wr, int wc, int fr, int fq) const {
        const int cb = u.col0 + wc * 32 + 8 * fq;
        f32x4 sc[2][2];
#pragma unroll
        for (int bj = 0; bj < 2; ++bj) { sc[bj][0] = *(const f32x4*)(scale + cb + bj * 128); sc[bj][1] = *(const f32x4*)(scale + cb + bj * 128 + 4); }
        float ssum[2][4];
#pragma unroll
        for (int ai = 0; ai < 2; ++ai) {
            f32x4 xv[4][2][2];
#pragma unroll
            for (int m = 0; m < 4; ++m)
#pragma unroll
                for (int bj = 0; bj < 2; ++bj) { const float* xp = x + (size_t)(u.row0 + ai * 128 + wr * 64 + m * 16 + fr) * 1024 + cb + bj * 128; xv[m][bj][0] = *(const f32x4*)xp; xv[m][bj][1] = *(const f32x4*)(xp + 4); }
#pragma unroll
            for (int m = 0; m < 4; ++m) { const int row = u.row0 + ai * 128 + wr * 64 + m * 16 + fr; const size_t ro = (size_t)row * 1024 + cb; float s = 0.f;
#pragma unroll
                for (int bj = 0; bj < 2; ++bj) { f32x4 a = xv[m][bj][0], b = xv[m][bj][1];
                    a += acc[ai][bj][m][0] * sc[bj][0]; b += acc[ai][bj][m][1] * sc[bj][1];
                    s += (a[0] * a[0] + a[1] * a[1]) + (a[2] * a[2] + a[3] * a[3]) + (b[0] * b[0] + b[1] * b[1]) + (b[2] * b[2] + b[3] * b[3]);
                    st16(hout + ro + bj * 128, pack8(a, b)); *(u32x2*)(h8 + ro + bj * 128) = pack8_fp8(a, b); }
                s += __shfl_xor(s, 16); s += __shfl_xor(s, 32); ssum[ai][m] = s; }
        }
        if (fq == 0) {
#pragma unroll
            for (int ai = 0; ai < 2; ++ai)
#pragma unroll
                for (int m = 0; m < 4; ++m) ss16[(size_t)(u.row0 + ai * 128 + wr * 64 + m * 16 + fr) * 16 + (u.col0 >> 8) * 4 + wc] = ssum[ai][m];
        }
    }
};
struct EpiS {
    unsigned char* P; const LAS float* tab2; LAS f32x2* xch;
    __device__ __forceinline__ void operator()(Acc& acc, const Unit& u, int wr, int wc, int fr, int fq) const {
        float mxs[2][4];
#pragma unroll
        for (int ai = 0; ai < 2; ++ai)
#pragma unroll
            for (int m = 0; m < 4; ++m) { const int rl = ai * 128 + wr * 64 + m * 16 + fr; const int row = u.row0 + rl;
                const float rs = tab2[(u.aux < MAXU ? u.aux : MAXU - 1) * 256 + rl] * (1.0f / BS8_SCALE);
                float mx = -3.0e38f;
#pragma unroll
                for (int bj = 0; bj < 2; ++bj)
#pragma unroll
                    for (int n = 0; n < 2; ++n) { f32x4 v = acc[ai][bj][m][n] * rs; acc[ai][bj][m][n] = v; mx = fmaxf(mx, fmaxf(fmaxf(v[0], v[1]), fmaxf(v[2], v[3]))); }
                mx = fmaxf(mx, __shfl_xor(mx, 16)); mx = fmaxf(mx, __shfl_xor(mx, 32));
                float l = 0.f;
#pragma unroll
                for (int bj = 0; bj < 2; ++bj)
#pragma unroll
                    for (int n = 0; n < 2; ++n) { f32x4 v = acc[ai][bj][m][n]; f32x4 e; e[0] = fast_exp2(v[0] - mx); e[1] = fast_exp2(v[1] - mx); e[2] = fast_exp2(v[2] - mx); e[3] = fast_exp2(v[3] - mx);
                        acc[ai][bj][m][n] = e; l += (e[0] + e[1]) + (e[2] + e[3]); }
                l += __shfl_xor(l, 16); l += __shfl_xor(l, 32);
                if (fq == 0) xch[rl * 4 + wc] = (f32x2){mx, l};
                mxs[ai][m] = mx; }
        asm volatile("s_waitcnt lgkmcnt(0)" ::: "memory"); __builtin_amdgcn_s_barrier(); asm volatile("" ::: "memory");
#pragma unroll
        for (int ai = 0; ai < 2; ++ai)
#pragma unroll
            for (int m = 0; m < 4; ++m) { const int rl = ai * 128 + wr * 64 + m * 16 + fr; const int row = u.row0 + rl;
                const f32x2 p0 = xch[rl * 4 + 0], p1 = xch[rl * 4 + 1], p2 = xch[rl * 4 + 2], p3 = xch[rl * 4 + 3];
                const float M = fmaxf(fmaxf(p0.x, p1.x), fmaxf(p2.x, p3.x));
                const float L = (p0.y * fast_exp2(p0.x - M) + p1.y * fast_exp2(p1.x - M)) + (p2.y * fast_exp2(p2.x - M) + p3.y * fast_exp2(p3.x - M));
                const float f = fast_exp2(mxs[ai][m] - M) * fast_rcp(L) * P8_SCALE;
                unsigned char* rowp = P + (size_t)row * 1024 + u.col0 + wc * 32 + 8 * fq;
#pragma unroll
                for (int bj = 0; bj < 2; ++bj) *(u32x2*)(rowp + bj * 128) = pack8_fp8(acc[ai][bj][m][0] * f, acc[ai][bj][m][1] * f); }
    }
};
struct EpiGU {
    unsigned char* hmid; const LAS float* tab2;
    __device__ __forceinline__ void operator()(Acc& acc, const Unit& u, int wr, int wc, int fr, int fq) const {
        const int ub = (u.aux < MAXU ? u.aux : MAXU - 1) * 256;
#pragma unroll
        for (int ai = 0; ai < 2; ++ai)
#pragma unroll
            for (int m = 0; m < 4; ++m) { const int rl = ai * 128 + wr * 64 + m * 16 + fr; const float rs = tab2[ub + rl] * (1.0f / W8_GU_SCALE);
                f32x4 o[2];
#pragma unroll
                for (int n = 0; n < 2; ++n)
#pragma unroll
                    for (int j = 0; j < 4; ++j) { const float g = acc[ai][0][m][n][j] * rs, uu = acc[ai][1][m][n][j] * rs; o[n][j] = g * sigmoidf_(g) * uu * H8_MID_SCALE; }
                *(u32x2*)(hmid + (size_t)(u.row0 + rl) * 512 + (u.col0 >> 1) + wc * 32 + 8 * fq) = pack8_fp8(o[0], o[1]); }
    }
};
struct EpiDown {
    bf16* y; const LAS int* tab; const LAS float* tab2;
    __device__ __forceinline__ void operator()(Acc& acc, const Unit& u, int wr, int wc, int fr, int fq) const {
        const int ub = (u.aux < MAXU ? u.aux : MAXU - 1) * 256;
#pragma unroll
        for (int ai = 0; ai < 2; ++ai)
#pragma unroll
            for (int m = 0; m < 4; ++m) { const int rl = ai * 128 + wr * 64 + m * 16 + fr; const int slot = tab[ub + rl]; const float w = tab2[ub + rl] * (1.0f / (W8_DOWN_SCALE * H8_MID_SCALE));
                if (slot >= 0) { bf16* rowp = y + (size_t)slot * 1024 + u.col0 + wc * 32 + 8 * fq;
#pragma unroll
                    for (int bj = 0; bj < 2; ++bj) st16(rowp + bj * 128, pack8(acc[ai][bj][m][0] * w, acc[ai][bj][m][1] * w)); } }
    }
};
struct EpiIn {
    bf16* xb; bf16* gate; const LAS float* tab2;
    __device__ __forceinline__ void operator()(Acc& acc, const Unit& u, int wr, int wc, int fr, int fq) const {
        const bool isg = u.col0 >= 1024; bf16* dst = isg ? gate : xb; const int c0 = (u.col0 & 1023) + wc * 32 + 8 * fq;
#pragma unroll
        for (int ai = 0; ai < 2; ++ai)
#pragma unroll
            for (int m = 0; m < 4; ++m) { const int rl = ai * 128 + wr * 64 + m * 16 + fr; const int row = u.row0 + rl; const float rs = tab2[(u.aux < MAXU ? u.aux : MAXU - 1) * 256 + rl];
#pragma unroll
                for (int bj = 0; bj < 2; ++bj) { f32x4 o[2];
#pragma unroll
                    for (int n = 0; n < 2; ++n)
#pragma unroll
                        for (int j = 0; j < 4; ++j) { float v = acc[ai][bj][m][n][j] * rs; if (isg) { const float t = 1.5957691216057308f * (v + 0.044715f * v * v * v); v = v * sigmoidf_(t); } o[n][j] = v; }
                    st16(dst + (size_t)row * 1024 + c0 + bj * 128, pack8(o[0], o[1])); } }
    }
};
struct EpiGates {
    const bf16* xc; bf16* loga; bf16* bt; const float* bgate; const float* spl;
    __device__ __forceinline__ void operator()(Acc& acc, const Unit& u, int wr, int wc, int fr, int fq) const {
        const int ch = u.col0 + wc * 32 + 8 * fq;
        const int hh = u.col0 >> 8, cin = (u.col0 & 255) + wc * 32 + 8 * fq;
        f32x4 br[2], bi[2], sp[2];
#pragma unroll
        for (int n = 0; n < 2; ++n) { br[n] = *(const f32x4*)(bgate + hh * 512 + cin + 4 * n); bi[n] = *(const f32x4*)(bgate + hh * 512 + 256 + cin + 4 * n); sp[n] = *(const f32x4*)(spl + ch + 4 * n); }
        u32x4 xv[2][4];
#pragma unroll
        for (int ai = 0; ai < 2; ++ai)
#pragma unroll
            for (int m = 0; m < 4; ++m) xv[ai][m] = *(const u32x4*)(xc + (size_t)(u.row0 + ai * 128 + wr * 64 + m * 16 + fr) * 1024 + ch);
#pragma unroll
        for (int ai = 0; ai < 2; ++ai)
#pragma unroll
            for (int m = 0; m < 4; ++m) { const int row = u.row0 + ai * 128 + wr * 64 + m * 16 + fr; const size_t ro = (size_t)row * 1024 + ch;
                f32x4 x[2]; unpack8(xv[ai][m], x[0], x[1]);
                f32x4 la[2], bb[2];
#pragma unroll
                for (int n = 0; n < 2; ++n)
#pragma unroll
                    for (int j = 0; j < 4; ++j) { const float er = 1.0f + fast_exp2(fminf(-(acc[ai][0][m][n][j] + br[n][j]) * LOG2E, 60.f)), ei = 1.0f + fast_exp2(fminf(-(acc[ai][1][m][n][j] + bi[n][j]) * LOG2E, 60.f));
                        const float q = fast_rcp(er * ei); const float r = q * ei, ig = q * er;
                        const float l = -8.0f * r * sp[n][j]; const float a2 = fast_exp2(2.0f * LOG2E * l); const float mult = __builtin_amdgcn_sqrtf(fmaxf(1.0f - a2, 0.f));
                        la[n][j] = l; bb[n][j] = mult * ig * x[n][j]; }
                *(u32x4*)(loga + ro) = pack8(la[0], la[1]); *(u32x4*)(bt + ro) = pack8(bb[0], bb[1]); }
    }
};
}

#define XB_TMO      128
#define XB_XCNT(j)  (256  + 64 * (j))
#define XB_XSUB(j)  (1280 + 64 * (j))
#define XB_XGEN(j)  (2304 + 64 * (j))
#define XB_TOP      3328
#define XB_TOPGEN   3392
#define XCD_BAR_WORDS 3456
#define XB_SPIN_CAP (1u << 18)

__device__ __forceinline__ unsigned xb_ld(unsigned* p)              { return __hip_atomic_load(p, __ATOMIC_RELAXED, __HIP_MEMORY_SCOPE_AGENT); }
__device__ __forceinline__ unsigned xb_add(unsigned* p, unsigned v) { return __hip_atomic_fetch_add(p, v, __ATOMIC_RELAXED, __HIP_MEMORY_SCOPE_AGENT); }
__device__ __forceinline__ unsigned xb_xcc_id() { return (unsigned)__builtin_amdgcn_s_getreg((3 << 11) | 20) & 0xFu; }
#define XB_SPIN(cond, bar) do { unsigned _sp = 0; while (cond) { __builtin_amdgcn_s_sleep(1); \
    if ((++_sp & 255u) == 0u) { if (xb_ld(&(bar)[XB_TMO])) break; if (_sp > XB_SPIN_CAP) { atomicAdd(&(bar)[XB_TMO], 1u); break; } } } } while (0)

struct XcdBarrier { unsigned* bar; unsigned x; volatile LAS unsigned* st; };

__device__ __forceinline__ XcdBarrier xcd_barrier_post(unsigned* bar, volatile LAS unsigned* st) {
    XcdBarrier b; b.bar = bar; b.x = xb_xcc_id(); b.st = st;
    if (threadIdx.x == 0) (void)xb_add(&bar[XB_XCNT(b.x)], 1u);
    return b;
}
__device__ __forceinline__ void xcd_barrier_complete(unsigned* bar, unsigned x, unsigned& nloc, unsigned& nx) {
    const unsigned G = gridDim.x * gridDim.y * gridDim.z;
    unsigned sum, cnt, mine, sp = 0u;
    for (;;) {
        sum = 0u; cnt = 0u; mine = 0u;
#pragma unroll
        for (unsigned j = 0; j < 16; ++j) { const unsigned c = xb_ld(&bar[XB_XCNT(j)]); sum += c; cnt += (c > 0u) ? 1u : 0u; mine = (j == x) ? c : mine; }
        if (sum == G) break;
        __builtin_amdgcn_s_sleep(1);
        if ((++sp & 255u) == 0u) { if (xb_ld(&bar[XB_TMO])) break; if (sp > XB_SPIN_CAP) { atomicAdd(&bar[XB_TMO], 1u); break; } }
    }
    nloc = mine > 0u ? mine : 1u; nx = cnt > 0u ? cnt : 1u;
}
__device__ __forceinline__ void xcd_barrier(const XcdBarrier& b) {
    asm volatile("s_waitcnt vmcnt(0)" ::: "memory");
    __syncthreads();
    if (threadIdx.x == 0) {
        unsigned* bar = b.bar;
        __builtin_amdgcn_s_waitcnt(0);
        unsigned nloc = b.st[0], nx = b.st[1];
        if (nloc == 0u) { xcd_barrier_complete(bar, b.x, nloc, nx); b.st[0] = nloc; b.st[1] = nx; }
        const unsigned old = xb_add(&bar[XB_XSUB(b.x)], 1u);
        const unsigned gen = old / nloc;
        if (old + 1u == (gen + 1u) * nloc) {
            __builtin_amdgcn_fence(__ATOMIC_RELEASE, "agent");
            asm volatile("s_waitcnt vmcnt(0)" ::: "memory");
            const unsigned og = xb_add(&bar[XB_TOP], 1u);
            const unsigned tg = og / nx;
            if (og + 1u == (tg + 1u) * nx) xb_add(&bar[XB_TOPGEN], 1u);
            else XB_SPIN(xb_ld(&bar[XB_TOPGEN]) == tg, bar);
            __builtin_amdgcn_fence(__ATOMIC_ACQUIRE, "agent");
            xb_add(&bar[XB_XGEN(b.x)], 1u);
            asm volatile("s_waitcnt vmcnt(0)" ::: "memory");
        } else {
            XB_SPIN(xb_ld(&bar[XB_XGEN(b.x)]) == gen, bar);
            __builtin_amdgcn_fence(__ATOMIC_ACQUIRE, "agent");
            asm volatile("s_waitcnt vmcnt(0)" ::: "memory");
        }
    }
    __syncthreads();
}

struct Args { const float* in[25]; float* out; unsigned char* ws; int ph_lo, ph_hi; unsigned dup, pad; };
struct Frame {
    LAS unsigned char* lds;
    int tid, lane, wave, G, vcu;
    unsigned char* ws; unsigned char* ob;
};
enum { I_X = 0, I_MEM, I_POOL_W, I_POOL_SCALE, I_RG_W_IN, I_RG_CONV_W, I_RG_CONV_B, I_RG_W_GATE, I_RG_B_GATE, I_RG_LAMBDA, I_RG_W_OUT, I_XA_WQ, I_XA_WKV, I_XA_WO,
       I_MOE_WG, I_MOE_BG, I_MOE_WE, I_MOE_BE, I_MOE_W_GU, I_MOE_W_DOWN, I_NORM_MIX, I_NORM_XATTN, I_NORM_MEM, I_NORM_MOE, I_NORM_FINAL };

__device__ __forceinline__ void tr_item(const float* W, int ldw, int k0, int scol0, const float* gain, void* out, int ldo, int orow0, LAS float* scr, int lane, int f8 = 0, float scl = 1.0f) {
    f32x4 v[8];
    const int kq = lane >> 3, n4 = (lane & 7) * 4;
#pragma unroll
    for (int i = 0; i < 8; ++i) v[i] = *(const f32x4*)(W + (size_t)(k0 + 8 * i + kq) * ldw + scol0 + n4);
    if (gain) {
#pragma unroll
        for (int i = 0; i < 8; ++i) v[i] *= gain[k0 + 8 * i + kq] * scl;
    } else if (f8) {
#pragma unroll
        for (int i = 0; i < 8; ++i) v[i] *= scl;
    }
#pragma unroll
    for (int i = 0; i < 8; ++i) { LAS float* d = scr + (8 * i + kq) * 33 + n4; d[0] = v[i][0]; d[1] = v[i][1]; d[2] = v[i][2]; d[3] = v[i][3]; }
    LDS_WAIT(); asm volatile("" ::: "memory");
    const int c = lane & 7;
#pragma unroll
    for (int j = 0; j < 4; ++j) { const int n = (lane >> 3) + 8 * j; const LAS float* s = scr + (8 * c) * 33 + n;
        if (f8) { *(u32x2*)((unsigned char*)out + (size_t)(orow0 + n) * ldo + k0 + 8 * c) = pack8_fp8((f32x4){s[0 * 33], s[1 * 33], s[2 * 33], s[3 * 33]}, (f32x4){s[4 * 33], s[5 * 33], s[6 * 33], s[7 * 33]}); }
        else { u32x4 o; o.x = pk2(s[0 * 33], s[1 * 33]); o.y = pk2(s[2 * 33], s[3 * 33]); o.z = pk2(s[4 * 33], s[5 * 33]); o.w = pk2(s[6 * 33], s[7 * 33]);
            *(u32x4*)((bf16*)out + (size_t)(orow0 + n) * ldo + k0 + 8 * c) = o; } }
    LDS_WAIT(); asm volatile("" ::: "memory");
}
__device__ __forceinline__ void tr_job(int q, const float* W, int Kdim, int ldw, int NO, int mapmode, int mapoff, const float* gain, void* out, LAS float* scr, int lane, int f8 = 0, float scl = 1.0f) {
    const int nblk = NO / 32, kb = q / nblk, nb = q % nblk, n0 = 32 * nb;
    int sc = n0;
    if (mapmode) { const int tile = n0 >> 8, w = n0 & 255; sc = (w < 128) ? (128 * tile + w) : (mapoff + 128 * tile + (w - 128)); }
    tr_item(W, ldw, 64 * kb, sc, gain, out, Kdim, n0, scr, lane, f8, scl);
}
__device__ __forceinline__ float row_sumsq_f32(const float* row, int lane, f32x4 (&v)[4]) {
    const f32x4* xr = (const f32x4*)row + lane; float s = 0.f;
#pragma unroll
    for (int j = 0; j < 4; ++j) { v[j] = xr[64 * j]; s += (v[j][0] * v[j][0] + v[j][1] * v[j][1]) + (v[j][2] * v[j][2] + v[j][3] * v[j][3]); }
    return wave_sum(s);
}

__device__ __forceinline__ void phase_prologue(Frame& F, const Args& args) {
    LAS float* scr = (LAS float*)(F.lds + RING_OFF + F.wave * 16384);
    const int gw = F.vcu * 8 + F.wave, NGW = F.G * 8, lane = F.lane;
    unsigned char* ws = F.ws;
    const float* nmix = args.in[I_NORM_MIX]; const float* nxat = args.in[I_NORM_XATTN]; const float* nmem = args.in[I_NORM_MEM]; const float* nmoe = args.in[I_NORM_MOE];
    constexpr int J0 = 128, J1 = 1024, J2 = 256, J3 = 512, J4 = 2048, J5 = 1024, J6 = 16384, J7 = 8192;
    constexpr int NITEMS = J0 + J1 + J2 + J3 + J4 + J5 + J6 + J7;
    for (int it = gw; it < NITEMS; it += NGW) {
        int r = it;
        if (r < J0) { const int g = r / 32, q = r % 32; tr_job(q, args.in[I_POOL_W] + (size_t)g * 65536, 256, 256, 256, 0, 0, nullptr, (bf16*)(ws + WS_W_POOL) + (size_t)g * 65536, scr, lane); continue; } r -= J0;
        if (r < J1) { tr_job(r, args.in[I_RG_W_IN], 1024, 2048, 2048, 0, 0, nmix + 1024, (bf16*)(ws + WS_W_IN), scr, lane); continue; } r -= J1;
        if (r < J2) { const int h = r / 64, q = r % 64; tr_job(q, args.in[I_RG_W_GATE] + (size_t)h * 131072, 256, 512, 512, 1, 256, nullptr, (bf16*)(ws + WS_W_GATE) + (size_t)h * 131072, scr, lane); continue; } r -= J2;
        if (r < J3) { tr_job(r, args.in[I_RG_W_OUT], 1024, 1024, 1024, 0, 0, nullptr, (bf16*)(ws + WS_W_OUT), scr, lane); continue; } r -= J3;
        if (r < J4) { const int l = r / 1024, q = r % 1024; tr_job(q, args.in[I_XA_WKV] + (size_t)l * 2097152, 1024, 2048, 2048, 0, 0, nullptr, (bf16*)(ws + WS_W_KV) + (size_t)l * 2097152, scr, lane); continue; } r -= J4;
        if (r < J5) { const int l = r / 512, q = r % 512; tr_job(q, args.in[I_XA_WO] + (size_t)l * 1048576, 1024, 1024, 1024, 0, 0, nullptr, (bf16*)(ws + WS_W_OT) + (size_t)l * 1048576, scr, lane); continue; } r -= J5;
        if (r < J6) { const int le = r / 512, q = r % 512; tr_job(q, args.in[I_MOE_W_GU] + (size_t)le * 1048576, 1024, 1024, 1024, 1, 512, nmoe + (le >> 4) * 1024, (unsigned char*)(ws + WS_W_GU) + (size_t)le * 1048576, scr, lane, 1, W8_GU_SCALE); continue; } r -= J6;
        { const int le = r / 256, q = r % 256; tr_job(q, args.in[I_MOE_W_DOWN] + (size_t)le * 524288, 512, 1024, 1024, 0, 0, nullptr, (unsigned char*)(ws + WS_W_DOWN) + (size_t)le * 524288, scr, lane, 1, W8_DOWN_SCALE); }
    }
    constexpr int R_WQ = 2048, R_MEMN = 2 * NMR, R_WRB = 2 * 128, R_SPL = 1;
    constexpr int NROWS = R_WQ + R_MEMN + R_WRB + R_SPL;
    for (int it = gw; it < NROWS; it += NGW) {
        int r = it;
        if (r < R_WQ) {
            const int l = r >> 10, d = r & 1023; const float gsc = nxat[l * 1024 + d] * (LOG2E / 16.0f);
            const f32x4* src = (const f32x4*)(args.in[I_XA_WQ] + (size_t)r * 1024) + lane; u32x2* dst = (u32x2*)((bf16*)(ws + WS_W_Q) + (size_t)r * 1024) + lane;
#pragma unroll
            for (int j = 0; j < 4; ++j) { const f32x4 v = src[64 * j] * gsc; dst[64 * j] = (u32x2){pk2(v[0], v[1]), pk2(v[2], v[3])}; }
            continue; } r -= R_WQ;
        if (r < R_MEMN) {
            const int l = r / NMR, row = r % NMR; f32x4 v[4]; const float ss = row_sumsq_f32(args.in[I_MEM] + (size_t)row * 1024, lane, v);
            const float rs = __builtin_amdgcn_rsqf(ss * (1.0f / 1024.0f) + EPS);
            const f32x4* gp = (const f32x4*)(nmem + l * 1024) + lane; u32x2* dst = (u32x2*)((bf16*)(ws + WS_MEMN) + (size_t)r * 1024) + lane;
#pragma unroll
            for (int j = 0; j < 4; ++j) { const f32x4 o = v[j] * gp[64 * j] * rs; dst[64 * j] = (u32x2){pk2(o[0], o[1]), pk2(o[2], o[3])}; }
            continue; } r -= R_MEMN;
        if (r < R_WRB) {
            const int l = r >> 7, blk = r & 127;
            bf16* dst = (bf16*)(ws + WS_WRB) + (size_t)l * 65536 + blk * 512;
#pragma unroll
            for (int e8 = 0; e8 < 8; ++e8) { const int idx = blk * 512 + e8 * 64 + lane; const int jj = idx & 7, ln = (idx >> 3) & 63, ks = (idx >> 9) & 31, tl = idx >> 14;
                const int col = (tl & 1) * 16 + (ln & 15), d = 32 * ks + 8 * (ln >> 4) + jj;
                float w = 0.f;
                if (col < 4) w = args.in[I_MOE_WG][(size_t)l * 4096 + d * 4 + col];
                else if (col < 20) w = args.in[I_MOE_WE][(((size_t)l * 4 + ((col - 4) >> 2)) * 1024 + d) * 4 + ((col - 4) & 3)];
                w *= nmoe[l * 1024 + d];
                const unsigned hi = f2bf(w); const float lo = w - __builtin_bit_cast(float, hi << 16);
                dst[e8 * 64 + lane] = (bf16)((tl < 2) ? hi : f2bf(lo)); }
            continue; } r -= R_WRB;
        {
#pragma unroll
            for (int j = 0; j < 16; ++j) { const int c = j * 64 + lane; const float lam = args.in[I_RG_LAMBDA][c]; const float z = -lam;
                ((float*)(ws + WS_SPL))[c] = (z > 20.f) ? z : log1pf(expf(z)); }
        }
    }
}

template <int W> __device__ __forceinline__ void pool_step(f32x4 (&hist)[W], f32x4& sum, const f32x4 cur, const int i, const int cnt_s, const f32x4 gm, u32x2* dst) {
    sum += cur; const int cnt = cnt_s < W ? cnt_s : W; const f32x4 p = (sum * (1.0f / (float)cnt) - cur) * gm; *dst = (u32x2){pk2(p[0], p[1]), pk2(p[2], p[3])};
    hist[i % W] = cur; sum -= hist[(i + 1) % W];
}
constexpr int PBR = 2;
__device__ __forceinline__ void pool_loadn(const float* __restrict__ xb, int s, int nrow, f32x4 (&v)[PBR][4]) {
#pragma unroll
    for (int r = 0; r < PBR; ++r) if (r < nrow) {
        if (s + r >= 0) {
#pragma unroll
            for (int g = 0; g < 4; ++g) v[r][g] = *(const f32x4*)(xb + (size_t)(s + r) * D + g * 256);
        } else {
#pragma unroll
            for (int g = 0; g < 4; ++g) v[r][g] = (f32x4){0.f, 0.f, 0.f, 0.f};
        } }
#pragma unroll
    for (int r = 0; r < PBR; ++r) if (r < nrow) { float ss = 0.f;
#pragma unroll
        for (int g = 0; g < 4; ++g) ss += (v[r][g][0] * v[r][g][0] + v[r][g][1] * v[r][g][1]) + (v[r][g][2] * v[r][g][2] + v[r][g][3] * v[r][g][3]);
        const float rs = __builtin_amdgcn_rsqf(wave_sum(ss) * (1.0f / 1024.0f) + EPS);
#pragma unroll
        for (int g = 0; g < 4; ++g) v[r][g] *= rs; }
}
__device__ __forceinline__ void pool_run(const float* __restrict__ xb, bf16* __restrict__ prow, const int s0, const f32x4 (&gm)[4], const int lane) {
    f32x4 h0[2], h1[4], h2[8], h3[16], sum[4];
#pragma unroll
    for (int g = 0; g < 4; ++g) sum[g] = (f32x4){0.f, 0.f, 0.f, 0.f};
#pragma unroll
    for (int jb = 15; jb >= 1; jb -= PBR) { const int nrow = jb >= PBR ? PBR : jb; f32x4 v[PBR][4]; pool_loadn(xb, s0 - jb, nrow, v);
#pragma unroll
        for (int r = 0; r < PBR; ++r) if (r < nrow) { const int j = jb - r;
            if (j < 2) { h0[(16 - j) % 2] = v[r][0]; sum[0] += v[r][0]; }
            if (j < 4) { h1[(16 - j) % 4] = v[r][1]; sum[1] += v[r][1]; }
            if (j < 8) { h2[(16 - j) % 8] = v[r][2]; sum[2] += v[r][2]; }
            { h3[(16 - j) % 16] = v[r][3]; sum[3] += v[r][3]; } } }
#pragma unroll
    for (int ib = 0; ib < 16; ib += PBR) { f32x4 v[PBR][4]; pool_loadn(xb, s0 + ib, PBR, v);
#pragma unroll
        for (int r = 0; r < PBR; ++r) { const int i = ib + r, s = s0 + i; u32x2* dst = (u32x2*)(prow + (size_t)i * D) + lane;
            pool_step<2>(h0, sum[0], v[r][0], i, s + 1, gm[0], dst);
            pool_step<4>(h1, sum[1], v[r][1], i, s + 1, gm[1], dst + 64);
            pool_step<8>(h2, sum[2], v[r][2], i, s + 1, gm[2], dst + 128);
            pool_step<16>(h3, sum[3], v[r][3], i, s + 1, gm[3], dst + 192); } }
}
__device__ __forceinline__ void phase_pool_p(Frame& F, const Args& args) {
    const int gw = F.vcu * 8 + F.wave, NGW = F.G * 8, lane = F.lane;
    bf16* P0 = (bf16*)(F.ob + OB_P0);
    f32x4 gm[4];
#pragma unroll
    for (int g = 0; g < 4; ++g) gm[g] = *(const f32x4*)(args.in[I_NORM_MIX] + g * 256 + 4 * lane);
    for (int it = gw; it < NB * (SEQ / 16); it += NGW) {
        const int b = it >> 7, s0 = (it & 127) * 16;
        pool_run(args.in[I_X] + (size_t)b * SEQ * D + 4 * lane, P0 + ((size_t)b * SEQ + s0) * D, s0, gm, lane);
    }
}

struct SchedKV {
    int G, c; const char* A; const char* B; char* Kb; char* Vb;
    __device__ __forceinline__ bool next(int i, pg8::Unit& u) const { int pm, pn; if (!pg8::tile_of(i, G, c, 32, 8, pm, pn)) return false;
        const int l = pm >> 4; u.A = A + (size_t)pm * 256 * 2048; u.B = B + (size_t)l * 4194304 + (size_t)pn * 256 * 2048;
        u.C = ((pn < 4) ? Kb : Vb) + ((size_t)l * 4096 + (size_t)(pm & 15) * 256) * 2048 + (size_t)(pn & 3) * 512; u.row0 = pm * 256; u.col0 = pn * 256; u.aux = i; return true; }
};
struct SchedMVW {
    int G, c; const char* Kl; const char* Vl; const char* Wq; const char* Wot; char* BS; char* BO;
    __device__ __forceinline__ bool next(int i, pg8::Unit& u) const { int pm, pn; if (!pg8::tile_of(i, G, c, 128, 4, pm, pn)) return false;
        const int kind = pm >> 6, bh = pm & 63, b = bh >> 2, h = bh & 3;
        if (kind == 0) { u.A = Kl + ((size_t)b * 256) * 2048 + h * 512; u.B = Wq + ((size_t)pn * 256) * 2048 + h * 512; u.C = BS + (size_t)b * 1048576 + ((size_t)h * 256) * 1024 + pn * 256; }
        else { u.A = Wot + ((size_t)pn * 256) * 2048 + h * 512; u.B = Vl + ((size_t)b * 256) * 2048 + h * 512; u.C = BO + (size_t)b * 1048576 + ((size_t)pn * 256) * 1024 + h * 256; }
        u.row0 = 0; u.col0 = kind; u.aux = i; return true; }
};
struct SchedDense {
    int G, c, nN; const char* A; size_t apan; size_t acol; int adiv; const char* B; size_t bpn; size_t bbatch; int cmul;
    __device__ __forceinline__ bool next(int i, pg8::Unit& u) const { int pm, pn; if (!pg8::tile_of(i, G, c, NTOK / 256, nN, pm, pn)) return false;
        u.A = A + (size_t)pm * apan + (size_t)(pn / adiv) * acol; u.B = B + (size_t)pn * bpn + (size_t)(pm >> 3) * bbatch; u.C = nullptr; u.row0 = pm * 256; u.col0 = pn * cmul; u.aux = i; return true; }
};
struct SchedMoE {
    int G, c, nT; int tpre[17]; const char* A; size_t atile; const char* B; size_t bexp, bpn;
    __device__ __forceinline__ int expert_of(int tile) const { int e = 0;
#pragma unroll
        for (int k = 1; k < 16; ++k) e += (tile >= tpre[k]) ? 1 : 0;
        return e; }
    __device__ __forceinline__ int first_tile(int e) const { int t = 0;
#pragma unroll
        for (int k = 1; k < 16; ++k) t = (k == e) ? tpre[k] : t;
        return t; }
    __device__ __forceinline__ bool next(int i, pg8::Unit& u) const { int tile, pn; if (!pg8::tile_of(i, G, c, nT, 4, tile, pn)) return false;
        const int e = expert_of(tile);
        u.A = A + (size_t)tile * atile; u.B = B + (size_t)e * bexp + (size_t)pn * bpn; u.C = nullptr; u.row0 = tile * 256; u.col0 = pn * 256; u.aux = i; return true; }
};
__device__ __forceinline__ void moe_sched_init(SchedMoE& S, Frame& F, int l) {
    const unsigned* cnt = (const unsigned*)(F.ws + WS_CTL) + CW_CNT + l * 16 * 64;
    unsigned n[16];
#pragma unroll
    for (int e = 0; e < 16; ++e) n[e] = __hip_atomic_load(cnt + e * 64, __ATOMIC_RELAXED, __HIP_MEMORY_SCOPE_AGENT);
    int acc = 0;
#pragma unroll
    for (int e = 0; e < 16; ++e) { S.tpre[e] = acc; acc += ((int)__builtin_amdgcn_readfirstlane(n[e]) + 255) >> 8; }
    S.tpre[16] = acc; S.nT = acc; S.G = F.G; S.c = (int)blockIdx.x;
}
__device__ __forceinline__ void moe_fill_tables(const SchedMoE& S, Frame& F, int l, int mode) {
    const int* list = (const int*)(F.ws + WS_LIST); const float* rstd = (const float*)(F.ws + WS_RSTD_B); const float* gwv = (const float*)(F.ws + WS_GW);
    LAS int* tab = (LAS int*)(F.lds + TAB_OFF); LAS float* tab2 = (LAS float*)(F.lds + TAB2_OFF);
    const unsigned* cntp = (const unsigned*)(F.ws + WS_CTL) + CW_CNT + l * 16 * 64;
    if (F.tid < 256) {
        unsigned n[16];
#pragma unroll
        for (int e = 0; e < 16; ++e) n[e] = __hip_atomic_load(cntp + e * 64, __ATOMIC_RELAXED, __HIP_MEMORY_SCOPE_AGENT);
        int slot[MAXU]; bool valid[MAXU]; bool have[MAXU]; float aux[MAXU];
#pragma unroll
        for (int j = 0; j < MAXU; ++j) { pg8::Unit u; have[j] = S.next(j, u); slot[j] = 0; valid[j] = false;
            if (have[j]) { const int tile = u.row0 >> 8, e = S.expert_of(tile), tl = tile - S.first_tile(e), pos = tl * 256 + F.tid; int ne = (int)n[0];
#pragma unroll
                for (int k = 1; k < 16; ++k) ne = (k == e) ? (int)n[k] : ne;
                valid[j] = pos < ne;
                slot[j] = list[(size_t)e * NTOK + (valid[j] ? pos : 0)]; } }
#pragma unroll
        for (int j = 0; j < MAXU; ++j) { aux[j] = 0.f; if (have[j]) aux[j] = (mode == 0) ? rstd[slot[j] >> 1] : gwv[slot[j]]; }
#pragma unroll
        for (int j = 0; j < MAXU; ++j) if (have[j]) { tab[j * 256 + F.tid] = (mode == 0) ? (slot[j] >> 1) : (valid[j] ? slot[j] : -1); tab2[j * 256 + F.tid] = aux[j]; }
    }
    __syncthreads();
}

template <class Sched> __device__ __forceinline__ void fill_row_scale(const Sched& S, Frame& F, const float* src, int mode) {
    LAS float* tab2 = (LAS float*)(F.lds + TAB2_OFF);
    if (F.tid < 256) {
#pragma unroll
        for (int j = 0; j < MAXU; ++j) { pg8::Unit u; if (S.next(j, u)) { const int row = u.row0 + F.tid; float r;
            if (mode == 0) { const f32x4* sp = (const f32x4*)(src + (size_t)row * 16); const f32x4 qs = (sp[0] + sp[1]) + (sp[2] + sp[3]); r = __builtin_amdgcn_rsqf(((qs[0] + qs[1]) + (qs[2] + qs[3])) * (1.0f / 1024.0f) + EPS); }
            else r = src[row];
            tab2[j * 256 + F.tid] = r; } }
    }
    __syncthreads();
}

__device__ __forceinline__ void phase_router(Frame& F, const Args& args, int l, const bf16* H) {
    { const u32x4* src = (const u32x4*)(F.ws + WS_WRB + (size_t)l * 131072); LAS u32x4* dst = (LAS u32x4*)(F.lds + RING_OFF);
      u32x4 t[16];
#pragma unroll
      for (int i = 0; i < 16; ++i) t[i] = src[F.tid + 512 * i];
#pragma unroll
      for (int i = 0; i < 16; ++i) dst[F.tid + 512 * i] = t[i]; }
    __syncthreads();
    LAS float* lgs = (LAS float*)(F.lds + TAB_OFF) + F.wave * 336;
    LAS int* sel_e = (LAS int*)(F.lds + XCH_OFF); LAS float* sel_w = (LAS float*)(F.lds + XCH_OFF + 1024);
    LAS int* lcnt = (LAS int*)(F.lds + XCH_OFF + 2048); LAS int* lbase = lcnt + 16; LAS int* rnk = (LAS int*)(F.lds + XCH_OFF + 3072);
    unsigned* gcnt = (unsigned*)(F.ws + WS_CTL) + CW_CNT + l * 16 * 64;
    int* list = (int*)(F.ws + WS_LIST); float* gwv = (float*)(F.ws + WS_GW); float* rstd = (float*)(F.ws + WS_RSTD_B);
    const float* bg = args.in[I_MOE_BG] + l * 4; const float* be = args.in[I_MOE_BE] + l * 16;
    const int lane = F.lane, fr = lane & 15, fq = lane >> 4;
    for (int tb = F.vcu; tb < NTOK / 128; tb += F.G) {
        const int t0 = tb * 128 + F.wave * 16;
        const bf16* hp = H + (size_t)(t0 + fr) * 1024 + 8 * fq;
        f32x4 acc0 = {0.f, 0.f, 0.f, 0.f}, acc1 = {0.f, 0.f, 0.f, 0.f}; float ssq = 0.f;
        if (F.tid < 16) lcnt[F.tid] = 0;
#pragma unroll 16
        for (int ks = 0; ks < 32; ++ks) {
            const u32x4 av = *(const u32x4*)(hp + ks * 32);
            f32x4 x0, x1; unpack8(av, x0, x1); ssq += (x0[0] * x0[0] + x0[1] * x0[1]) + (x0[2] * x0[2] + x0[3] * x0[3]) + (x1[0] * x1[0] + x1[1] * x1[1]) + (x1[2] * x1[2] + x1[3] * x1[3]);
            const bf16x8 a = __builtin_bit_cast(bf16x8, av);
            const LAS bf16x8* bp = (const LAS bf16x8*)(F.lds + RING_OFF) + ks * 64 + lane;
            const bf16x8 b0 = bp[0], b1 = bp[2048], b2 = bp[4096], b3 = bp[6144];
            acc0 = __builtin_amdgcn_mfma_f32_16x16x32_bf16(a, b0, acc0, 0, 0, 0); acc0 = __builtin_amdgcn_mfma_f32_16x16x32_bf16(a, b2, acc0, 0, 0, 0);
            acc1 = __builtin_amdgcn_mfma_f32_16x16x32_bf16(a, b1, acc1, 0, 0, 0); acc1 = __builtin_amdgcn_mfma_f32_16x16x32_bf16(a, b3, acc1, 0, 0, 0);
        }
        ssq += __shfl_xor(ssq, 16); ssq += __shfl_xor(ssq, 32);
#pragma unroll
        for (int rg = 0; rg < 4; ++rg) { lgs[(4 * fq + rg) * 21 + fr] = acc0[rg]; if (fr < 4) lgs[(4 * fq + rg) * 21 + 16 + fr] = acc1[rg]; }
        LDS_WAIT(); asm volatile("" ::: "memory");
        if (lane < 16) {
            const float rs = __builtin_amdgcn_rsqf(ssq * (1.0f / 1024.0f) + EPS);
            const LAS float* lg = lgs + lane * 21;
            float g0 = lg[0] * rs + bg[0], g1 = lg[1] * rs + bg[1], g2 = lg[2] * rs + bg[2], g3 = lg[3] * rs + bg[3];
            int g = 0; float gm = g0; if (g1 > gm) { gm = g1; g = 1; } if (g2 > gm) { gm = g2; g = 2; } if (g3 > gm) { gm = g3; g = 3; }
            const float gp = 1.0f / (expf(g0 - gm) + expf(g1 - gm) + expf(g2 - gm) + expf(g3 - gm));
            float le[4];
#pragma unroll
            for (int k = 0; k < 4; ++k) le[k] = lg[4 + 4 * g + k] * rs + be[4 * g + k];
            int e1 = 0; float m1 = le[0];
#pragma unroll
            for (int k = 1; k < 4; ++k) if (le[k] > m1) { m1 = le[k]; e1 = k; }
            int e2 = -1; float m2 = -3.0e38f;
#pragma unroll
            for (int k = 0; k < 4; ++k) if (k != e1 && le[k] > m2) { m2 = le[k]; e2 = k; }
            const float z = expf(m2 - m1); const float q1 = 1.0f / (1.0f + z), q2 = z * q1;
            const int tl = F.wave * 16 + lane;
            sel_e[2 * tl] = 4 * g + e1; sel_e[2 * tl + 1] = 4 * g + e2; sel_w[2 * tl] = gp * q1; sel_w[2 * tl + 1] = gp * q2;
            rstd[t0 + lane] = rs;
        }
        __syncthreads();
        int my_e = 0;
        if (F.tid < 256) { my_e = sel_e[F.tid]; rnk[F.tid] = __hip_atomic_fetch_add(&lcnt[my_e], 1, __ATOMIC_RELAXED, __HIP_MEMORY_SCOPE_WORKGROUP); }
        __syncthreads();
        if (F.tid < 16) { const int n = lcnt[F.tid]; lbase[F.tid] = n ? (int)__hip_atomic_fetch_add(gcnt + F.tid * 64, (unsigned)n, __ATOMIC_RELAXED, __HIP_MEMORY_SCOPE_AGENT) : 0; }
        __syncthreads();
        if (F.tid < 256) { const int pos = lbase[my_e] + rnk[F.tid]; const int slot = tb * 256 + F.tid; list[(size_t)my_e * NTOK + pos] = slot; gwv[slot] = sel_w[F.tid]; }
        __syncthreads();
    }
}

__device__ __forceinline__ void phase_combine(Frame& F, const Args& args, int mode, const bf16* H, bf16* Hout, float* outf) {
    const int gw = F.vcu * 8 + F.wave, NGW = F.G * 8, lane = F.lane;
    const bf16* Y = (const bf16*)(F.ws + WS_Y); float* rstd = (float*)(F.ws + WS_RSTD_A);
    f32x4 gf[4];
    if (mode == 1) {
#pragma unroll
        for (int hf = 0; hf < 2; ++hf) { gf[2 * hf] = *(const f32x4*)(args.in[I_NORM_FINAL] + hf * 512 + 8 * lane); gf[2 * hf + 1] = *(const f32x4*)(args.in[I_NORM_FINAL] + hf * 512 + 8 * lane + 4); }
    }
    for (int t0 = gw; t0 < NTOK; t0 += 2 * NGW) {
        u32x4 hv[2][2], y0[2][2], y1[2][2];
#pragma unroll
        for (int q = 0; q < 2; ++q) { const int t = (t0 + q * NGW < NTOK) ? t0 + q * NGW : t0;
#pragma unroll
            for (int hf = 0; hf < 2; ++hf) { const size_t off = hf * 512 + 8 * lane;
                hv[q][hf] = *(const u32x4*)(H + (size_t)t * 1024 + off); y0[q][hf] = *(const u32x4*)(Y + (size_t)(2 * t) * 1024 + off); y1[q][hf] = *(const u32x4*)(Y + (size_t)(2 * t + 1) * 1024 + off); } }
#pragma unroll
        for (int q = 0; q < 2; ++q) { const int t = t0 + q * NGW; if (t >= NTOK) break;
            f32x4 v[4]; float ss = 0.f;
#pragma unroll
            for (int hf = 0; hf < 2; ++hf) {
                f32x4 a, b, c, d, e, f; unpack8(hv[q][hf], a, b); unpack8(y0[q][hf], c, d); unpack8(y1[q][hf], e, f); a += c + e; b += d + f; v[2 * hf] = a; v[2 * hf + 1] = b;
                ss += (a[0] * a[0] + a[1] * a[1]) + (a[2] * a[2] + a[3] * a[3]) + (b[0] * b[0] + b[1] * b[1]) + (b[2] * b[2] + b[3] * b[3]); }
            ss = wave_sum(ss);
            const float rs = __builtin_amdgcn_rsqf(ss * (1.0f / 1024.0f) + EPS);
            if (mode == 0) {
#pragma unroll
                for (int hf = 0; hf < 2; ++hf) *(u32x4*)(Hout + (size_t)t * 1024 + hf * 512 + 8 * lane) = pack8(v[2 * hf], v[2 * hf + 1]);
                if (lane == 0) rstd[t] = rs;
            } else {
#pragma unroll
                for (int hf = 0; hf < 2; ++hf) { float* op = outf + (size_t)t * 1024 + hf * 512 + 8 * lane; *(f32x4*)op = v[2 * hf] * gf[2 * hf] * rs; *(f32x4*)(op + 4) = v[2 * hf + 1] * gf[2 * hf + 1] * rs; }
            }
        }
    }
}

__device__ __forceinline__ void phase_conv(Frame& F, const Args& args, const bf16* XB, bf16* XC) {
    const int gw = F.vcu * 8 + F.wave, NGW = F.G * 8, lane = F.lane;
    const float* cw = args.in[I_RG_CONV_W]; const float* cbv = args.in[I_RG_CONV_B];
    for (int hf = 0; hf < 2; ++hf) {
        const int c0 = hf * 512 + 8 * lane;
        f32x4 w[4][2], cb[2];
#pragma unroll
        for (int k = 0; k < 4; ++k) { w[k][0] = *(const f32x4*)(cw + k * 1024 + c0); w[k][1] = *(const f32x4*)(cw + k * 1024 + c0 + 4); }
        cb[0] = *(const f32x4*)(cbv + c0); cb[1] = *(const f32x4*)(cbv + c0 + 4);
        for (int it = gw; it < NB * (SEQ / 16); it += NGW) {
            const int b = it >> 7, s0 = (it & 127) * 16; const bf16* xp = XB + (size_t)b * SEQ * D + c0; bf16* op = XC + (size_t)b * SEQ * D + c0;
            f32x4 xm[3][2];
#pragma unroll
            for (int j = 0; j < 3; ++j) { const int s = s0 - 3 + j; if (s >= 0) { const u32x4 v = *(const u32x4*)(xp + (size_t)s * D); unpack8(v, xm[j][0], xm[j][1]); } else { xm[j][0] = (f32x4){0.f, 0.f, 0.f, 0.f}; xm[j][1] = xm[j][0]; } }
#pragma unroll 4
            for (int s = s0; s < s0 + 16; ++s) { const u32x4 v = *(const u32x4*)(xp + (size_t)s * D); f32x4 x0, x1; unpack8(v, x0, x1);
                const f32x4 o0 = cb[0] + w[0][0] * xm[0][0] + w[1][0] * xm[1][0] + w[2][0] * xm[2][0] + w[3][0] * x0;
                const f32x4 o1 = cb[1] + w[0][1] * xm[0][1] + w[1][1] * xm[1][1] + w[2][1] * xm[2][1] + w[3][1] * x1;
                *(u32x4*)(op + (size_t)s * D) = pack8(o0, o1);
                xm[0][0] = xm[1][0]; xm[0][1] = xm[1][1]; xm[1][0] = xm[2][0]; xm[1][1] = xm[2][1]; xm[2][0] = x0; xm[2][1] = x1; }
        }
    }
}

constexpr int NSEG = 16, SEGL = SEQ / NSEG;
__device__ __forceinline__ void phase_scan1(Frame& F) {
    const int gw = F.vcu * 8 + F.wave, NGW = F.G * 8, lane = F.lane;
    const bf16* LA = (const bf16*)(F.ob + OB_LOGA); const bf16* BT = (const bf16*)(F.ob + OB_BT);
    float* AGS = (float*)(F.ws + WS_AGS); float* AGB = (float*)(F.ws + WS_AGB);
    for (int it = gw; it < NB * NSEG * 8; it += NGW) {
        const int cg = it & 7, sg = (it >> 3) & (NSEG - 1), b = it >> 7; const int ch = cg * 128 + 2 * lane;
        const size_t r0 = ((size_t)b * SEQ + sg * SEGL) * D + ch;
        float h0 = 0.f, h1 = 0.f, s0 = 0.f, s1 = 0.f;
#pragma unroll 16
        for (int s = 0; s < SEGL; ++s) { const unsigned lv = *(const unsigned*)(LA + r0 + (size_t)s * D), bv = *(const unsigned*)(BT + r0 + (size_t)s * D);
            const float l0 = bflo(lv), l1 = bfhi(lv); s0 += l0; s1 += l1;
            h0 = fast_exp2(l0 * LOG2E) * h0 + bflo(bv); h1 = fast_exp2(l1 * LOG2E) * h1 + bfhi(bv); }
        const size_t ao = ((size_t)b * NSEG + sg) * 1024 + ch;
        *(f32x2*)(AGS + ao) = (f32x2){s0, s1}; *(f32x2*)(AGB + ao) = (f32x2){h0, h1};
    }
}
__device__ __forceinline__ void scan2_item(const bf16* __restrict__ LA, const bf16* __restrict__ BT, const bf16* __restrict__ GATE, bf16* __restrict__ YRG, const float* __restrict__ AGS, const float* __restrict__ AGB, int it, int lane) {
    const int cg = it & 7, sg = (it >> 3) & (NSEG - 1), b = it >> 7; const int ch = cg * 128 + 2 * lane;
    f32x2 as[NSEG - 1], ab[NSEG - 1];
#pragma unroll
    for (int c = 0; c < NSEG - 1; ++c) { const size_t ao = ((size_t)b * NSEG + c) * 1024 + ch; as[c] = *(const f32x2*)(AGS + ao); ab[c] = *(const f32x2*)(AGB + ao); }
    float h0 = 0.f, h1 = 0.f;
#pragma unroll
    for (int c = 0; c < NSEG - 1; ++c) if (c < sg) { h0 = fast_exp2(as[c].x * LOG2E) * h0 + ab[c].x; h1 = fast_exp2(as[c].y * LOG2E) * h1 + ab[c].y; }
    const size_t r0 = ((size_t)b * SEQ + sg * SEGL) * D + ch;
#pragma nounroll
    for (int sb = 0; sb < SEGL; sb += 16) {
        unsigned lv[16], bv[16], gv[16];
#pragma unroll
        for (int k = 0; k < 16; ++k) { const size_t o = r0 + (size_t)(sb + k) * D; lv[k] = *(const unsigned*)(LA + o); bv[k] = *(const unsigned*)(BT + o); gv[k] = *(const unsigned*)(GATE + o); }
#pragma unroll
        for (int k = 0; k < 16; ++k) { h0 = fast_exp2(bflo(lv[k]) * LOG2E) * h0 + bflo(bv[k]); h1 = fast_exp2(bfhi(lv[k]) * LOG2E) * h1 + bfhi(bv[k]);
            *(unsigned*)(YRG + r0 + (size_t)(sb + k) * D) = cvt_pk_bf16(h0 * bflo(gv[k]), h1 * bfhi(gv[k])); }
    }
}
__device__ __forceinline__ void phase_scan2(Frame& F, const bf16* GATE, bf16* YRG) {
    const int gw = F.vcu * 8 + F.wave, NGW = F.G * 8;
    for (int it = gw; it < NB * NSEG * 8; it += NGW)
        scan2_item((const bf16*)(F.ob + OB_LOGA), (const bf16*)(F.ob + OB_BT), GATE, YRG, (const float*)(F.ws + WS_AGS), (const float*)(F.ws + WS_AGB), it, F.lane);
}

#if MK_PER_PHASE
#define GRID_BAR() do { } while (0)
#else
#if MK_TSEL >= 0
#define GRID_BAR() do { volatile LAS unsigned* _m = (volatile LAS unsigned*)(F.lds + MISC_OFF); const unsigned _t0 = (unsigned)__builtin_amdgcn_s_memrealtime(); xcd_barrier(bar); \
    if (threadIdx.x == 0) { const unsigned _k = _m[16]; const unsigned _t1 = (unsigned)__builtin_amdgcn_s_memrealtime(); if ((int)_k == MK_TSEL && !MK_GMODE) _m[18] = MK_TWAIT ? (_t1 - _t0) : (_t0 - _m[17]); _m[17] = _t1; _m[16] = _k + 1u; } } while (0)
#else
#define GRID_BAR() xcd_barrier(bar)
#endif
#endif
#ifndef MK_MASK
#define MK_MASK 0x1fffffu
#endif
#define IN(k) ((((MK_MASK) >> (k)) & 1u) && lo <= (k) && (k) < hi)
#define SEAM(k) do { if (lo <= (k) + 1 && (k) + 1 < hi) GRID_BAR(); } while (0)
#ifndef MK_DUP
#define MK_DUP 0u
#endif

template <int L>
__device__ __forceinline__ void mvw_gemm(Frame& F) {
    unsigned char* ws = F.ws;
    SchedMVW S{F.G, (int)blockIdx.x, (const char*)(ws + WS_K) + (size_t)L * 8388608, (const char*)(ws + WS_V) + (size_t)L * 8388608,
               (const char*)(ws + WS_W_Q) + (size_t)L * 2097152, (const char*)(ws + WS_W_OT) + (size_t)L * 2097152, (char*)(ws + WS_BS), (char*)(ws + WS_BO)};
    pg8::EpiMVW E{};
    pg8::gemm_phase<pg8::EpiMVW, SchedMVW, false>(F.lds + RING_OFF, 256, 2048u, 2048u, S, E, (LAS int*)(F.lds + TAB_OFF));
}
template <int L>
__device__ __forceinline__ void layer_phases(Frame& F, const Args& args, const XcdBarrier& bar, const int lo, const int hi) {
    unsigned char* ws = F.ws;
    LAS int* tab = (LAS int*)(F.lds + TAB_OFF); LAS float* tab2 = (LAS float*)(F.lds + TAB2_OFF);
    float* ss16 = (float*)(ws + WS_SS16);
    constexpr int ps = (L == 0) ? 3 : 15;
    if constexpr (L == 0) {
        if (IN(2)) {
            mvw_gemm<0>(F);
            SchedDense S{F.G, (int)blockIdx.x, 4, (const char*)(F.ob + OB_P0), (size_t)256 * 2048, (size_t)512, 1, (const char*)(ws + WS_W_POOL), (size_t)131072, 0, 256};
            pg8::EpiPool E{args.in[I_X], args.in[I_POOL_SCALE], (bf16*)(ws + WS_HA), ss16, (unsigned char*)(F.ob + OB_HMIX8)};
            pg8::gemm_phase<pg8::EpiPool, SchedDense, false>(F.lds + RING_OFF, 256, 2048u, 512u, S, E, tab);
            SEAM(2);
        }
    } else {
        const bf16* h3 = (const bf16*)(ws + WS_HA);
        bf16* XB = (bf16*)(ws + WS_HB); bf16* GATE = (bf16*)(ws + WS_Y); bf16* XC = (bf16*)(ws + WS_Y + 64 * MiB); bf16* YRG = (bf16*)(ws + WS_HB); bf16* HC = (bf16*)(ws + WS_Y);
        if (IN(9)) {
            SchedDense S{F.G, (int)blockIdx.x, 8, (const char*)h3, (size_t)256 * 2048, 0, 1, (const char*)(ws + WS_W_IN), (size_t)256 * 2048, 0, 256};
            fill_row_scale(S, F, (const float*)(ws + WS_RSTD_A), 1);
            pg8::EpiIn E{XB, GATE, tab2};
            pg8::gemm_phase<pg8::EpiIn, SchedDense, false>(F.lds + RING_OFF, 1024, 2048u, 2048u, S, E, tab);
            SEAM(9);
        }
        if (IN(10)) { phase_conv(F, args, XB, XC); SEAM(10); }
        if (IN(11)) {
            SchedDense S{F.G, (int)blockIdx.x, 8, (const char*)XC, (size_t)256 * 2048, (size_t)512, 2, (const char*)(ws + WS_W_GATE), (size_t)131072, 0, 128};
            pg8::EpiGates E{XC, (bf16*)(F.ob + OB_LOGA), (bf16*)(F.ob + OB_BT), args.in[I_RG_B_GATE], (const float*)(ws + WS_SPL)};
            pg8::gemm_phase<pg8::EpiGates, SchedDense, false>(F.lds + RING_OFF, 256, 2048u, 512u, S, E, tab);
            SEAM(11);
        }
        if (IN(12)) { phase_scan1(F); SEAM(12); }
        if (IN(13)) { phase_scan2(F, GATE, YRG); SEAM(13); }
        if (IN(14)) {
            SchedDense S{F.G, (int)blockIdx.x, 4, (const char*)YRG, (size_t)256 * 2048, 0, 1, (const char*)(ws + WS_W_OUT), (size_t)256 * 2048, 0, 256};
            pg8::EpiRes<true> E{h3, HC, ss16, (unsigned char*)(F.ob + OB_HMIX8), 1.0f};
            pg8::gemm_phase<pg8::EpiRes<true>, SchedDense, false>(F.lds + RING_OFF, 1024, 2048u, 2048u, S, E, tab);
            SEAM(14);
        }
    }
    const bf16* hmix = (L == 0) ? (const bf16*)(ws + WS_HA) : (const bf16*)(ws + WS_Y);
    bf16* hatt = (L == 0) ? (bf16*)(ws + WS_HB) : (bf16*)(ws + WS_HA);
    unsigned char* PATT = (unsigned char*)(F.ob + OB_PATT);
    if (IN(ps)) {
        SchedDense S{F.G, (int)blockIdx.x, 4, (const char*)(F.ob + OB_HMIX8), (size_t)256 * 1024, 0, 1, (const char*)(ws + WS_BS), (size_t)256 * 1024, (size_t)1048576, 256};
        fill_row_scale(S, F, ss16, 0);
        pg8::EpiS E{PATT, tab2, (LAS f32x2*)(F.lds + XCH_OFF)};
        pg8::gemm_phase<pg8::EpiS, SchedDense, false, true>(F.lds + RING_OFF, 1024, 1024u, 1024u, S, E, tab);
        SEAM(ps);
    }
    if (IN(ps + 1)) {
        SchedDense S{F.G, (int)blockIdx.x, 4, (const char*)PATT, (size_t)256 * 1024, 0, 1, (const char*)(ws + WS_BO), (size_t)256 * 1024, (size_t)1048576, 256};
        pg8::EpiRes<false> E{hmix, hatt, ss16, (unsigned char*)(ws + WS_H8), 1.0f / (P8_SCALE * BO8_SCALE)};
        pg8::gemm_phase<pg8::EpiRes<false>, SchedDense, false, true>(F.lds + RING_OFF, 1024, 1024u, 1024u, S, E, tab);
        SEAM(ps + 1);
    }
    if (IN(ps + 2)) {
        phase_router(F, args, L, hatt);
        if constexpr (L == 0) { __syncthreads(); mvw_gemm<1>(F); }
        SEAM(ps + 2);
    }
    if (IN(ps + 3)) {
        SchedMoE S; moe_sched_init(S, F, L); S.A = (const char*)(ws + WS_H8); S.atile = 0; S.B = (const char*)(ws + WS_W_GU) + (size_t)L * 16777216; S.bexp = 1048576; S.bpn = (size_t)256 * 1024;
        moe_fill_tables(S, F, L, 0);
        pg8::EpiGU E{(unsigned char*)(F.ob + OB_HMID), tab2};
        pg8::gemm_phase<pg8::EpiGU, SchedMoE, true, true>(F.lds + RING_OFF, 1024, 1024u, 1024u, S, E, tab);
        SEAM(ps + 3);
    }
    if (IN(ps + 4)) {
        SchedMoE S; moe_sched_init(S, F, L); S.A = (const char*)(F.ob + OB_HMID); S.atile = (size_t)256 * 512; S.B = (const char*)(ws + WS_W_DOWN) + (size_t)L * 8388608; S.bexp = 524288; S.bpn = (size_t)256 * 512;
        moe_fill_tables(S, F, L, 1);
        pg8::EpiDown E{(bf16*)(ws + WS_Y), tab, tab2};
        pg8::gemm_phase<pg8::EpiDown, SchedMoE, false, true>(F.lds + RING_OFF, 512, 512u, 512u, S, E, tab);
        SEAM(ps + 4);
    }
    if (IN(ps + 5)) {
        if constexpr (L == 0) { phase_combine(F, args, 0, hatt, (bf16*)(ws + WS_HA), nullptr); SEAM(ps + 5); }
        else phase_combine(F, args, 1, hatt, nullptr, args.out);
    }
}

__global__ void __launch_bounds__(512, 2) hybrid_fwd(Args args) {
    extern __shared__ __attribute__((aligned(16))) unsigned char lds[];
    Frame F;
    F.lds = (LAS unsigned char*)lds;
    F.tid = threadIdx.x; F.lane = F.tid & 63; F.wave = __builtin_amdgcn_readfirstlane(F.tid >> 6);
    F.G = gridDim.x; { const int bx = blockIdx.x; F.vcu = (F.G % 8 == 0) ? (bx % 8) * (F.G / 8) + bx / 8 : bx; }
    F.ws = args.ws; F.ob = (unsigned char*)args.out;
    volatile LAS unsigned* MISC = (volatile LAS unsigned*)(F.lds + MISC_OFF);
    for (int u = F.tid; u < (LDS_BYTES - MISC_OFF) / 4; u += 512) ((LAS unsigned*)(F.lds + MISC_OFF))[u] = 0u;
    __syncthreads();
    unsigned* ctl = (unsigned*)(F.ws + WS_CTL);
#if MK_PER_PHASE
    XcdBarrier bar; bar.bar = ctl + CW_BAR; bar.x = 0; bar.st = nullptr;
#else
    XcdBarrier bar = xcd_barrier_post(ctl + CW_BAR, MISC + 8);
#endif
    const int lo = args.ph_lo, hi = args.ph_hi;
    unsigned char* ws = F.ws;
    LAS int* tab = (LAS int*)(F.lds + TAB_OFF);
#if MK_TSEL >= 0
    if (threadIdx.x == 0) MISC[17] = (unsigned)__builtin_amdgcn_s_memrealtime();
#endif

    if (IN(0)) { phase_prologue(F, args); SEAM(0); }
    if (IN(1)) {
        phase_pool_p(F, args);
        __syncthreads();
        SchedKV S{F.G, (int)blockIdx.x, (const char*)(ws + WS_MEMN), (const char*)(ws + WS_W_KV), (char*)(ws + WS_K), (char*)(ws + WS_V)};
        pg8::EpiPlain E{1024};
        pg8::gemm_phase<pg8::EpiPlain, SchedKV, false>(F.lds + RING_OFF, 1024, 2048u, 2048u, S, E, tab);
        SEAM(1);
    }
    layer_phases<0>(F, args, bar, lo, hi);
    layer_phases<1>(F, args, bar, lo, hi);
#if MK_TSEL >= 0
    if ((int)blockIdx.x == MK_TBLK && threadIdx.x == 0) { const unsigned long long w = (unsigned long long)MISC[18] * MK_TAMP, t0 = __builtin_amdgcn_s_memrealtime();
        while (__builtin_amdgcn_s_memrealtime() - t0 < w) __builtin_amdgcn_s_sleep(8); }
#endif
}
#undef IN
#undef SEAM

extern "C" void kernel_launch(void* const* d_in, const int* in_sizes, int n_in, void* d_out, int out_size, void* d_ws, size_t ws_size, hipStream_t stream) {
    static int grid = 0;
    if (grid == 0) {
        if (n_in != 25 || out_size != NTOK * D || ws_size < WS_END) { fprintf(stderr, "kernel_launch: unexpected shapes (n_in %d, out %d, ws %zu)\n", n_in, out_size, ws_size); grid = -1; return; }
        int dev = 0, cus = 0, per_cu = 0;
        if (hipGetDevice(&dev) != hipSuccess || hipDeviceGetAttribute(&cus, hipDeviceAttributeMultiprocessorCount, dev) != hipSuccess) { grid = -1; return; }
        if (hipFuncSetAttribute((const void*)hybrid_fwd, hipFuncAttributeMaxDynamicSharedMemorySize, LDS_BYTES) != hipSuccess) { fprintf(stderr, "kernel_launch: hipFuncSetAttribute failed\n"); grid = -1; return; }
        if (hipOccupancyMaxActiveBlocksPerMultiprocessor(&per_cu, (const void*)hybrid_fwd, 512, LDS_BYTES) != hipSuccess || per_cu < 1) fprintf(stderr, "kernel_launch: occupancy query reports %d\n", per_cu);
        (void)hipGetLastError();
        grid = cus;
    }
    if (grid < 0) return;
    (void)hipMemsetAsync((char*)d_ws + WS_CTL, 0, CTL_ZERO_BYTES, stream);
    Args a{};
    for (int i = 0; i < 25; ++i) a.in[i] = (const float*)d_in[i];
    a.out = (float*)d_out; a.ws = (unsigned char*)d_ws; a.dup = 0; a.pad = 0;
#if MK_PER_PHASE
    for (int p = 0; p < NPH; ++p) for (int r = 0; r < ((((MK_DUP) >> p) & 1u) ? 2 : 1); ++r) {
        if (r == 1 && (p == 5 || p == 17)) (void)hipMemsetAsync((char*)d_ws + WS_CTL + (size_t)(CW_CNT + (p == 17 ? 1 : 0) * 16 * 64) * 4, 0, 16 * 64 * 4, stream);
        a.ph_lo = p; a.ph_hi = p + 1; hipLaunchKernelGGL(hybrid_fwd, dim3(grid), dim3(512), LDS_BYTES, stream, a); }
#else
    a.ph_lo = 0; a.ph_hi = NPH; hipLaunchKernelGGL(hybrid_fwd, dim3(grid), dim3(512), LDS_BYTES, stream, a);
#endif
}
```

```cpp
#include <hip/hip_runtime.h>
#include <cstdio>
#include <cstdint>

#ifndef MK_KREP
#define MK_KREP 1
#endif
#ifndef MK_TSEL
#define MK_TSEL -1
#endif
#ifndef MK_TBLK
#define MK_TBLK 0
#endif
#ifndef MK_TAMP
#define MK_TAMP 8
#endif
#ifndef MK_TWAIT
#define MK_TWAIT 0
#endif
#ifndef MK_GMODE
#define MK_GMODE 0
#endif
#ifndef MK_WGM_GATES
#define MK_WGM_GATES 4
#endif
#ifndef MK_WGM_IN
#define MK_WGM_IN 16
#endif
#ifndef MK_WGM_ATT
#define MK_WGM_ATT 8
#endif
#ifndef MK_IN8
#define MK_IN8 1
#endif
#ifndef MK_STAGGER
#define MK_STAGGER 1
#endif
#ifndef MK_WGM_MOE
#define MK_WGM_MOE 8
#endif
#ifndef MK_WGM_K256
#define MK_WGM_K256 4
#endif
#ifndef MK_PER_PHASE
#define MK_PER_PHASE 0
#endif

#define GAS __attribute__((address_space(1)))
#define LAS __attribute__((address_space(3)))
typedef unsigned short bf16;
typedef short bf16x8 __attribute__((ext_vector_type(8)));
typedef float f32x4 __attribute__((ext_vector_type(4)));
typedef float f32x2 __attribute__((ext_vector_type(2)));
typedef unsigned u32x4 __attribute__((ext_vector_type(4)));
typedef unsigned u32x2 __attribute__((ext_vector_type(2)));

constexpr int NB = 16, SEQ = 2048, D = 1024, NTOK = NB * SEQ, MEML = 256, NMR = NB * MEML;
constexpr int NEXP = 16, DE = 512;
constexpr float EPS = 1e-6f;
constexpr float LOG2E = 1.4426950408889634f;
constexpr int NPH = 21;
constexpr float W8_GU_SCALE = 32.0f, W8_DOWN_SCALE = 16.0f, H8_MID_SCALE = 4.0f, W8_IN_SCALE = 32.0f;
constexpr float P8_SCALE = 256.0f, BO8_SCALE = 4.0f, BS8_SCALE = 16.0f;
constexpr float Y8_SCALE = 16.0f;
constexpr float LA8_SCALE = 256.0f, BT8_SCALE = 8.0f;

constexpr size_t MiB = 1u << 20;
constexpr size_t WS_CTL = 0, CTL_ZERO_BYTES = 1 * MiB;
constexpr int CW_BAR = 4096;
constexpr int CW_GRP = 32768;
constexpr int CW_GXCC = 40960;
constexpr int CW_CNT = 16384;
constexpr size_t WS_RSTD_A = 1 * MiB;
constexpr size_t WS_RSTD_B = 1 * MiB + 128 * 1024;
constexpr size_t WS_RSTD_X = 1 * MiB + 256 * 1024;
constexpr size_t WS_SS16 = 2 * MiB;
constexpr size_t WS_WRB = 4 * MiB;
constexpr size_t WS_SPL = 4 * MiB + 256 * 1024;
constexpr size_t WS_GW = 5 * MiB;
constexpr size_t WS_LIST = 6 * MiB;
constexpr size_t WS_W_POOL = 8 * MiB;
constexpr size_t WS_W_GATE = 8 * MiB + 512 * 1024;
constexpr size_t WS_W_OUT = 10 * MiB;
constexpr size_t WS_W_IN = 12 * MiB;
constexpr size_t WS_W_Q = 16 * MiB;
constexpr size_t WS_W_OT = 20 * MiB;
constexpr size_t WS_W_KV = 24 * MiB;
constexpr size_t WS_W_DOWN = 32 * MiB;
constexpr size_t WS_W_GU = 64 * MiB;
constexpr size_t WS_H8B = 96 * MiB;
constexpr size_t WS_K = 128 * MiB;
constexpr size_t WS_V = 144 * MiB;
constexpr size_t WS_BS = 160 * MiB;
constexpr size_t WS_BO = 192 * MiB;
constexpr size_t WS_HA = 224 * MiB;
constexpr size_t WS_HB = 288 * MiB;
constexpr size_t WS_MEMN = 352 * MiB;
constexpr size_t WS_AGS = 368 * MiB;
constexpr size_t WS_AGB = 372 * MiB;
constexpr size_t WS_Y = 384 * MiB;
constexpr size_t WS_END = 512 * MiB;
constexpr size_t OB_P0 = 0, OB_PATT = 64 * MiB, OB_HMID = 0, OB_LOGA = 0, OB_BT = 64 * MiB, OB_HMIX8 = 96 * MiB;
constexpr size_t WS_H8 = WS_Y + 64 * MiB;

constexpr int RING_OFF = 0, RING_BYTES = 131072;
constexpr int XCH_OFF = 131072;
constexpr int TAB_OFF = 139264;
constexpr int TAB2_OFF = 147456;
constexpr int MISC_OFF = 155648;
constexpr int LDS_BYTES = 155904;
constexpr int MAXU = 8;

#define LDS_WAIT() asm volatile("s_waitcnt lgkmcnt(0)" ::: "memory")
#define VM_WAIT() asm volatile("s_waitcnt vmcnt(0)" ::: "memory")

__device__ __forceinline__ unsigned f2bf(float f) { unsigned u = __builtin_bit_cast(unsigned, f); return (u + 0x7fffu + ((u >> 16) & 1u)) >> 16; }
__device__ __forceinline__ unsigned pk2(float lo, float hi) { return f2bf(lo) | (f2bf(hi) << 16); }
__device__ __forceinline__ float bflo(unsigned w) { return __builtin_bit_cast(float, w << 16); }
__device__ __forceinline__ float bfhi(unsigned w) { return __builtin_bit_cast(float, w & 0xffff0000u); }
__device__ __forceinline__ unsigned cvt_pk_bf16(float lo, float hi) { unsigned r; asm volatile("v_cvt_pk_bf16_f32 %0, %1, %2" : "=v"(r) : "v"(lo), "v"(hi)); return r; }
__device__ __forceinline__ u32x4 pack8(f32x4 a, f32x4 b) { u32x4 w; w.x = cvt_pk_bf16(a[0], a[1]); w.y = cvt_pk_bf16(a[2], a[3]); w.z = cvt_pk_bf16(b[0], b[1]); w.w = cvt_pk_bf16(b[2], b[3]); return w; }
__device__ __forceinline__ void unpack8(u32x4 w, f32x4& a, f32x4& b) { a[0] = bflo(w.x); a[1] = bfhi(w.x); a[2] = bflo(w.y); a[3] = bfhi(w.y); b[0] = bflo(w.z); b[1] = bfhi(w.z); b[2] = bflo(w.w); b[3] = bfhi(w.w); }
__device__ __forceinline__ u32x2 pack8_fp8(f32x4 a, f32x4 b) {
#pragma unroll
    for (int j = 0; j < 4; ++j) { a[j] = __builtin_amdgcn_fmed3f(a[j], -384.0f, 384.0f); b[j] = __builtin_amdgcn_fmed3f(b[j], -384.0f, 384.0f); }
    int lo = 0, hi = 0;
    lo = __builtin_amdgcn_cvt_pk_fp8_f32(a[0], a[1], lo, false); lo = __builtin_amdgcn_cvt_pk_fp8_f32(a[2], a[3], lo, true);
    hi = __builtin_amdgcn_cvt_pk_fp8_f32(b[0], b[1], hi, false); hi = __builtin_amdgcn_cvt_pk_fp8_f32(b[2], b[3], hi, true);
    return (u32x2){(unsigned)lo, (unsigned)hi};
}
__device__ __forceinline__ void unpack8_fp8(u32x2 w, f32x4& a, f32x4& b) {
    const f32x2 p0 = __builtin_amdgcn_cvt_pk_f32_fp8((int)w.x, false), p1 = __builtin_amdgcn_cvt_pk_f32_fp8((int)w.x, true), p2 = __builtin_amdgcn_cvt_pk_f32_fp8((int)w.y, false), p3 = __builtin_amdgcn_cvt_pk_f32_fp8((int)w.y, true);
    a = (f32x4){p0.x, p0.y, p1.x, p1.y}; b = (f32x4){p2.x, p2.y, p3.x, p3.y};
}
__device__ __forceinline__ float wave_sum(float v) {
    v += __builtin_bit_cast(float, __builtin_amdgcn_update_dpp(0, __builtin_bit_cast(int, v), 0xB1, 0xF, 0xF, false));
    v += __builtin_bit_cast(float, __builtin_amdgcn_update_dpp(0, __builtin_bit_cast(int, v), 0x4E, 0xF, 0xF, false));
    v += __builtin_bit_cast(float, __builtin_amdgcn_update_dpp(0, __builtin_bit_cast(int, v), 0x141, 0xF, 0xF, false));
    v += __builtin_bit_cast(float, __builtin_amdgcn_update_dpp(0, __builtin_bit_cast(int, v), 0x140, 0xF, 0xF, false));
    v += __shfl_xor(v, 16); v += __shfl_xor(v, 32);
    return v;
}
__device__ __forceinline__ float fast_exp2(float x) { return __builtin_amdgcn_exp2f(x); }
__device__ __forceinline__ float fast_rcp(float x) { return __builtin_amdgcn_rcpf(x); }
__device__ __forceinline__ float sigmoidf_(float x) { return fast_rcp(1.0f + fast_exp2(-x * LOG2E)); }

namespace pg8 {
constexpr int BM = 256, BK = 64, HALF = 128, HTB = HALF * BK * 2, STAGE_BYTES = 8 * HTB, NXCD = 8, WGM = 8;
__host__ __device__ __forceinline__ int lds_byte(int r, int c) { const int st = (r >> 4) * 2 + (c >> 5), rr = r & 15, cc = c & 31, ob = rr * 64 + cc * 2; return st * 1024 + (ob ^ (((ob >> 9) & 1) << 5)); }
__host__ __device__ __forceinline__ void stage_rc(int b, int& R, int& C) { const int st = b / 1024, sb = b % 1024, swz = sb ^ (((sb >> 9) & 1) << 5); R = (st >> 1) * 16 + swz / 64; C = (st & 1) * 32 + (swz % 64) / 2; }
__host__ __device__ __forceinline__ int perm32(int rho) { const int n = rho >> 4, i = rho & 15; return 8 * (i >> 2) + 4 * n + (i & 3); }

struct Unit { const char* A; const char* B; char* C; int row0, col0, aux; };

__device__ __forceinline__ bool tile_of(int i, int G, int c, int nM, int nN, int& pm, int& pn, const int wgm = WGM) {
    const int nwg = nM * nN; const long L = (long)i * G + c; if (L >= nwg) return false;
    int wgid = (int)L; { const int q = nwg / NXCD, r = nwg % NXCD, xcd = wgid % NXCD, off = wgid / NXCD; wgid = (xcd < r ? xcd * (q + 1) : r * (q + 1) + (xcd - r) * q) + off; }
    const int nig = wgm * nN, gid = wgid / nig, fm = gid * wgm, gsz = (nM - fm) < wgm ? (nM - fm) : wgm;
    pm = fm + ((wgid % nig) % gsz); pn = (wgid % nig) / gsz; return true;
}

typedef int i32x8 __attribute__((ext_vector_type(8)));
typedef int i32x4_t __attribute__((ext_vector_type(4)));
template <class Epi, class Sched, bool GATHER, bool F8 = false>
__device__ __forceinline__ void gemm_phase(LAS unsigned char* lds, const int K, const unsigned lda, const unsigned ldb, const Sched& S, const Epi& E, const LAS int* tab) {
    const int tid = threadIdx.x, wid = __builtin_amdgcn_readfirstlane(tid >> 6), lane = tid & 63, wr = wid >> 2, wc = wid & 3, fr = lane & 15, fq = lane >> 4;
    const int nt = F8 ? K / 128 : K / BK;
    unsigned vA[2], vB[2], vG[2][2]; int rA[2]; unsigned cA2[2];
#pragma unroll
    for (int i = 0; i < 2; ++i) { int R, C; stage_rc(tid * 16 + i * 8192, R, C); const int Rb = (R & ~31) + perm32(R & 31);
        vA[i] = (unsigned)R * lda + (unsigned)C * 2u; vB[i] = (unsigned)Rb * ldb + (unsigned)C * 2u; rA[i] = R; cA2[i] = (unsigned)C * 2u; vG[0][i] = 0; vG[1][i] = 0; }
    const size_t kstep = (size_t)(BK * 2);
    const size_t hsA = (size_t)HALF * lda, hsB = (size_t)HALF * ldb;
    const unsigned ldsw = (unsigned)wid * 1024u;
    const int aoff = lds_byte(wr * 64 + fr, fq * 8), boff = lds_byte(wc * 32 + fr, fq * 8);
#define PG8_SA(b, h) (((b) * 2 + (h)) * HTB)
#define PG8_SB(b, h) ((4 + (b) * 2 + (h)) * HTB)
#define PG8_STAGE_B(bufoff, gbase) do { _Pragma("unroll") for (int _i = 0; _i < 2; ++_i) \
        __builtin_amdgcn_global_load_lds((const unsigned*)((const char*)(gbase) + vB[_i]), (LAS unsigned*)(lds + (bufoff) + ldsw + _i * 8192), 16, 0, 0); } while (0)
#define PG8_STAGE_A(bufoff, gbase, h) do { _Pragma("unroll") for (int _i = 0; _i < 2; ++_i) { \
        if constexpr (GATHER) __builtin_amdgcn_global_load_lds((const unsigned*)((const char*)(gbase) + vG[h][_i]), (LAS unsigned*)(lds + (bufoff) + ldsw + _i * 8192), 16, 0, 0); \
        else __builtin_amdgcn_global_load_lds((const unsigned*)((const char*)(gbase) + (h) * hsA + vA[_i]), (LAS unsigned*)(lds + (bufoff) + ldsw + _i * 8192), 16, 0, 0); } } while (0)
#define PG8_LOADG(ui_) do { const int _u = ((ui_) < MAXU ? (ui_) : (MAXU - 1)) * 256; _Pragma("unroll") for (int _h = 0; _h < 2; ++_h) _Pragma("unroll") for (int _i = 0; _i < 2; ++_i) \
        vG[_h][_i] = (unsigned)tab[_u + rA[_i] + 128 * _h] * lda + cA2[_i]; } while (0)
#define PG8_LDA(dst, b, h) do { if constexpr (F8) { _Pragma("unroll") for (int m = 0; m < 4; ++m) dst##8[m] = __builtin_shufflevector(*(const LAS i32x4_t*)(lds + PG8_SA(b, h) + aoff + m * 2048), *(const LAS i32x4_t*)(lds + PG8_SA(b, h) + aoff + m * 2048 + 1024), 0, 1, 2, 3, 4, 5, 6, 7); } \
        else { _Pragma("unroll") for (int m = 0; m < 4; ++m) _Pragma("unroll") for (int k = 0; k < 2; ++k) dst[m][k] = *(const LAS bf16x8*)(lds + PG8_SA(b, h) + aoff + m * 2048 + k * 1024); } } while (0)
#define PG8_LDB(dst, b, h) do { if constexpr (F8) { _Pragma("unroll") for (int n = 0; n < 2; ++n) dst##8[n] = __builtin_shufflevector(*(const LAS i32x4_t*)(lds + PG8_SB(b, h) + boff + n * 2048), *(const LAS i32x4_t*)(lds + PG8_SB(b, h) + boff + n * 2048 + 1024), 0, 1, 2, 3, 4, 5, 6, 7); } \
        else { _Pragma("unroll") for (int n = 0; n < 2; ++n) _Pragma("unroll") for (int k = 0; k < 2; ++k) dst[n][k] = *(const LAS bf16x8*)(lds + PG8_SB(b, h) + boff + n * 2048 + k * 1024); } } while (0)
#define PG8_MMA(ai, bj, At, Bt) do { __builtin_amdgcn_s_setprio(1); _Pragma("unroll") for (int m = 0; m < 4; ++m) _Pragma("unroll") for (int n = 0; n < 2; ++n) { \
        if constexpr (F8) { asm volatile("v_mfma_f32_16x16x128_f8f6f4 %0, %1, %2, %0" : "+v"(acc[ai][bj][m][n]) : "v"(Bt##8[n]), "v"(At##8[m])); } \
        else { _Pragma("unroll") for (int k = 0; k < 2; ++k) acc[ai][bj][m][n] = __builtin_amdgcn_mfma_f32_16x16x32_bf16(Bt[n][k], At[m][k], acc[ai][bj][m][n], 0, 0, 0); } } \
        __builtin_amdgcn_s_setprio(0); } while (0)
#define PG8_WAIT_V(n) asm volatile("s_waitcnt vmcnt(" #n ")" ::: "memory")
#define PG8_WAIT_L(n) asm volatile("s_waitcnt lgkmcnt(" #n ")" ::: "memory")
#define PG8_BAR __builtin_amdgcn_s_barrier()
#define PG8_SCHED __builtin_amdgcn_sched_barrier(0)
#if MK_GMODE
    volatile LAS unsigned* _gm = (volatile LAS unsigned*)(lds + 155648);
    const bool _gsel = (threadIdx.x == 0) && ((int)_gm[16] == MK_TSEL);
    unsigned _gt = (unsigned)__builtin_amdgcn_s_memrealtime(); unsigned _gacc = 0;
#define PG8_GSTAMP(mode_) do { if (_gsel) { const unsigned _n = (unsigned)__builtin_amdgcn_s_memrealtime(); if (MK_GMODE == (mode_)) _gacc += _n - _gt; _gt = _n; } } while (0)
#else
#define PG8_GSTAMP(mode_) do { } while (0)
#endif
    Unit cur, nxt; int ui = 0;
    if (!S.next(0, cur)) return;
    f32x4 acc[2][2][4][2];
#pragma unroll
    for (int a = 0; a < 2; ++a)
#pragma unroll
        for (int b = 0; b < 2; ++b)
#pragma unroll
            for (int m = 0; m < 4; ++m)
#pragma unroll
                for (int n = 0; n < 2; ++n) acc[a][b][m][n] = (f32x4){0.f, 0.f, 0.f, 0.f};
    bf16x8 At[4][2], B0[2][2], B1[2][2]; i32x8 At8[4], B08[2], B18[2];
    const char* cA = cur.A; const char* cB = cur.B;
    if constexpr (GATHER) { PG8_LOADG(0); }
    PG8_STAGE_B(PG8_SB(0, 0), cB); PG8_STAGE_B(PG8_SB(0, 1), cB + hsB); PG8_STAGE_A(PG8_SA(0, 0), cA, 0); PG8_STAGE_A(PG8_SA(0, 1), cA, 1);
    if (wr == 1) PG8_BAR;
    PG8_WAIT_V(2); PG8_BAR;
    PG8_STAGE_B(PG8_SB(1, 0), cB + kstep); PG8_STAGE_A(PG8_SA(1, 0), cA + kstep, 0); PG8_STAGE_B(PG8_SB(1, 1), cB + hsB + kstep);
    PG8_WAIT_V(6); PG8_BAR;
    PG8_GSTAMP(1);
    for (;;) {
        const bool has_next = S.next(ui + 1, nxt);
        const char* nA = has_next ? nxt.A : cA; const char* nB = has_next ? nxt.B : cB;
#pragma nounroll
        for (int t = 0; t < nt * MK_KREP; t += 2) {
            const bool last = (t == nt * MK_KREP - 2);
            const char* a1 = cA + (size_t)(MK_KREP == 1 ? (t + 1) : ((t + 1) % nt)) * kstep;
            const int t2 = (MK_KREP == 1) ? (t + 2) : ((t + 2) % nt);
            const char* a2 = last ? nA : cA + (size_t)t2 * kstep; const char* b2 = last ? nB : cB + (size_t)t2 * kstep;
            const char* a3 = a2 + kstep; const char* b3 = b2 + kstep;
            PG8_LDB(B0, 0, 0); PG8_LDB(B1, 0, 1); PG8_SCHED; PG8_LDA(At, 0, 0); PG8_STAGE_A(PG8_SA(1, 1), a1, 1);
            PG8_WAIT_V(8); PG8_WAIT_L(0); PG8_BAR; PG8_MMA(0, 0, At, B0); PG8_MMA(0, 1, At, B1); PG8_BAR; PG8_SCHED;
            if constexpr (GATHER) { if (last && has_next) { PG8_LOADG(ui + 1); } }
            PG8_LDA(At, 0, 1); PG8_STAGE_B(PG8_SB(0, 0), b2); PG8_STAGE_B(PG8_SB(0, 1), b2 + hsB); PG8_STAGE_A(PG8_SA(0, 0), a2, 0);
            PG8_WAIT_V(8); PG8_WAIT_L(0); PG8_BAR; PG8_MMA(1, 0, At, B0); PG8_MMA(1, 1, At, B1); PG8_BAR; PG8_SCHED;
            PG8_LDB(B0, 1, 0); PG8_LDB(B1, 1, 1); PG8_SCHED; PG8_LDA(At, 1, 0); PG8_STAGE_A(PG8_SA(0, 1), a2, 1);
            PG8_WAIT_V(8); PG8_WAIT_L(0); PG8_BAR; PG8_MMA(0, 0, At, B0); PG8_MMA(0, 1, At, B1); PG8_BAR; PG8_SCHED;
            PG8_LDA(At, 1, 1); PG8_STAGE_B(PG8_SB(1, 0), b3); PG8_STAGE_B(PG8_SB(1, 1), b3 + hsB); PG8_STAGE_A(PG8_SA(1, 0), a3, 0);
            PG8_WAIT_V(8); PG8_WAIT_L(0); PG8_BAR; PG8_MMA(1, 0, At, B0); PG8_MMA(1, 1, At, B1); PG8_BAR; PG8_SCHED;
        }
        if (wr == 0) PG8_BAR;
        PG8_GSTAMP(4);
        if constexpr (F8) asm volatile("s_nop 15\n\ts_nop 15\n\ts_nop 15\n\ts_nop 15" ::: "memory");
        if (MK_KREP != 1) {
#pragma unroll
            for (int a = 0; a < 2; ++a)
#pragma unroll
                for (int b = 0; b < 2; ++b)
#pragma unroll
                    for (int m = 0; m < 4; ++m)
#pragma unroll
                        for (int n = 0; n < 2; ++n) acc[a][b][m][n] *= (1.0f / MK_KREP);
        }
        E(acc, cur, wr, wc, fr, fq);
        PG8_GSTAMP(2);
        if (!has_next) break;
#pragma unroll
        for (int a = 0; a < 2; ++a)
#pragma unroll
            for (int b = 0; b < 2; ++b)
#pragma unroll
                for (int m = 0; m < 4; ++m)
#pragma unroll
                    for (int n = 0; n < 2; ++n) acc[a][b][m][n] = (f32x4){0.f, 0.f, 0.f, 0.f};
        cur = nxt; cA = nA; cB = nB; ++ui;
        if (wr == 1) PG8_BAR;
    }
    PG8_WAIT_V(0);
    PG8_BAR;
    PG8_GSTAMP(3);
#if MK_GMODE
    if (_gsel) _gm[18] = _gacc;
#endif
#undef PG8_GSTAMP
#undef PG8_SA
#undef PG8_SB
#undef PG8_STAGE_A
#undef PG8_STAGE_B
#undef PG8_LOADG
#undef PG8_LDA
#undef PG8_LDB
#undef PG8_MMA
#undef PG8_WAIT_V
#undef PG8_WAIT_L
#undef PG8_BAR
#undef PG8_SCHED
}

typedef f32x4 Acc[2][2][4][2];
#ifndef MK_EPI_SC1
#define MK_EPI_SC1 0
#endif
__device__ __forceinline__ void st16(bf16* p, u32x4 v) {
#if MK_EPI_SC1
    asm volatile("global_store_dwordx4 %0, %1, off sc1\n\ts_nop 1" :: "v"(p), "v"(v) : "memory");
#else
    *(u32x4*)p = v;
#endif
}

struct EpiPlain {
    int ldc;
    __device__ __forceinline__ void operator()(Acc& acc, const Unit& u, int wr, int wc, int fr, int fq) const {
        bf16* base = (bf16*)u.C + (size_t)(wr * 64 + fr) * ldc + wc * 32 + 8 * fq;
#pragma unroll
        for (int ai = 0; ai < 2; ++ai)
#pragma unroll
            for (int m = 0; m < 4; ++m) { bf16* rowp = base + (size_t)(ai * 128 + m * 16) * ldc;
#pragma unroll
                for (int bj = 0; bj < 2; ++bj) st16(rowp + bj * 128, pack8(acc[ai][bj][m][0], acc[ai][bj][m][1])); }
    }
};
struct EpiMVW {
    __device__ __forceinline__ void operator()(Acc& acc, const Unit& u, int wr, int wc, int fr, int fq) const {
        const float sc = u.col0 ? BO8_SCALE : BS8_SCALE;
        unsigned char* base = (unsigned char*)u.C + (size_t)(wr * 64 + fr) * 1024 + wc * 32 + 8 * fq;
#pragma unroll
        for (int ai = 0; ai < 2; ++ai)
#pragma unroll
            for (int m = 0; m < 4; ++m) { unsigned char* rowp = base + (size_t)(ai * 128 + m * 16) * 1024;
#pragma unroll
                for (int bj = 0; bj < 2; ++bj) *(u32x2*)(rowp + bj * 128) = pack8_fp8(acc[ai][bj][m][0] * sc, acc[ai][bj][m][1] * sc); }
    }
};
template <bool STATS> struct EpiRes {
    const bf16* hin; bf16* hout; float* ss16; unsigned char* h8; float ascale;
    __device__ __forceinline__ void operator()(Acc& acc, const Unit& u, int wr, int wc, int fr, int fq) const {
        const size_t ro0 = (size_t)(u.row0 + wr * 64 + fr) * 1024 + u.col0 + wc * 32 + 8 * fq;
        u32x4 hv[2][4][2];
#pragma unroll
        for (int ai = 0; ai < 2; ++ai)
#pragma unroll
            for (int m = 0; m < 4; ++m)
#pragma unroll
                for (int bj = 0; bj < 2; ++bj) hv[ai][m][bj] = *(const u32x4*)(hin + ro0 + (size_t)(ai * 128 + m * 16) * 1024 + bj * 128);
#pragma unroll
        for (int ai = 0; ai < 2; ++ai)
#pragma unroll
            for (int m = 0; m < 4; ++m) { const int row = u.row0 + ai * 128 + wr * 64 + m * 16 + fr; const size_t ro = ro0 + (size_t)(ai * 128 + m * 16) * 1024; float s = 0.f;
#pragma unroll
                for (int bj = 0; bj < 2; ++bj) { f32x4 a, b; unpack8(hv[ai][m][bj], a, b); a += acc[ai][bj][m][0] * ascale; b += acc[ai][bj][m][1] * ascale;
                    if constexpr (STATS) s += (a[0] * a[0] + a[1] * a[1]) + (a[2] * a[2] + a[3] * a[3]) + (b[0] * b[0] + b[1] * b[1]) + (b[2] * b[2] + b[3] * b[3]);
                    st16(hout + ro + bj * 128, pack8(a, b)); if (h8) *(u32x2*)(h8 + ro + bj * 128) = pack8_fp8(a, b); }
                if constexpr (STATS) { s += __shfl_xor(s, 16); s += __shfl_xor(s, 32);
                    if (fq == 0) ss16[(size_t)row * 16 + (u.col0 >> 8) * 4 + wc] = s; } }
    }
};
struct EpiPool {
    const float* x; const float* scale; bf16* hout; float* ss16; unsigned char* h8;
    __device__ __forceinline__ void operator()(Acc& acc, const Unit& u, int wr, int wc, int fr, int fq) const {
        const int cb = u.col0 + wc * 32 + 8 * fq;
        f32x4 sc[2][2];
#pragma unroll
        for (int bj = 0; bj < 2; ++bj) { sc[bj][0] = *(const f32x4*)(scale + cb + bj * 128); sc[bj][1] = *(const f32x4*)(scale + cb + bj * 128 + 4); }
        float ssum[2][4];
#pragma unroll
        for (int ai = 0; ai < 2; ++ai) {
            f32x4 xv[4][2][2];
#pragma unroll
            for (int m = 0; m < 4; ++m)
#pragma unroll
                for (int bj = 0; bj < 2; ++bj) { const float* xp = x + (size_t)(u.row0 + ai * 128 + wr * 64 + m * 16 + fr) * 1024 + cb + bj * 128; xv[m][bj][0] = *(const f32x4*)xp; xv[m][bj][1] = *(const f32x4*)(xp + 4); }
#pragma unroll
            for (int m = 0; m < 4; ++m) { const int row = u.row0 + ai * 128 + wr * 64 + m * 16 + fr; const size_t ro = (size_t)row * 1024 + cb; float s = 0.f;
#pragma unroll
                for (int bj = 0; bj < 2; ++bj) { f32x4 a = xv[m][bj][0], b = xv[m][bj][1];
                    a += acc[ai][bj][m][0] * sc[bj][0]; b += acc[ai][bj][m][1] * sc[bj][1];
                    s += (a[0] * a[0] + a[1] * a[1]) + (a[2] * a[2] + a[3] * a[3]) + (b[0] * b[0] + b[1] * b[1]) + (b[2] * b[2] + b[3] * b[3]);
                    st16(hout + ro + bj * 128, pack8(a, b)); *(u32x2*)(h8 + ro + bj * 128) = pack8_fp8(a, b); }
                s += __shfl_xor(s, 16); s += __shfl_xor(s, 32); ssum[ai][m] = s; }
        }
        if (fq == 0) {
#pragma unroll
            for (int ai = 0; ai < 2; ++ai)
#pragma unroll
                for (int m = 0; m < 4; ++m) ss16[(size_t)(u.row0 + ai * 128 + wr * 64 + m * 16 + fr) * 16 + (u.col0 >> 8) * 4 + wc] = ssum[ai][m];
        }
    }
};
struct EpiS {
    unsigned char* P; const LAS float* tab2; LAS f32x2* xch;
    __device__ __forceinline__ void operator()(Acc& acc, const Unit& u, int wr, int wc, int fr, int fq) const {
        float mxs[2][4];
#pragma unroll
        for (int ai = 0; ai < 2; ++ai)
#pragma unroll
            for (int m = 0; m < 4; ++m) { const int rl = ai * 128 + wr * 64 + m * 16 + fr; const int row = u.row0 + rl;
                const float rs = tab2[(u.aux < MAXU ? u.aux : MAXU - 1) * 256 + rl] * (1.0f / BS8_SCALE);
                float mx = -3.0e38f;
#pragma unroll
                for (int bj = 0; bj < 2; ++bj)
#pragma unroll
                    for (int n = 0; n < 2; ++n) { f32x4 v = acc[ai][bj][m][n] * rs; acc[ai][bj][m][n] = v; mx = fmaxf(mx, fmaxf(fmaxf(v[0], v[1]), fmaxf(v[2], v[3]))); }
                mx = fmaxf(mx, __shfl_xor(mx, 16)); mx = fmaxf(mx, __shfl_xor(mx, 32));
                float l = 0.f;
#pragma unroll
                for (int bj = 0; bj < 2; ++bj)
#pragma unroll
                    for (int n = 0; n < 2; ++n) { f32x4 v = acc[ai][bj][m][n]; f32x4 e; e[0] = fast_exp2(v[0] - mx); e[1] = fast_exp2(v[1] - mx); e[2] = fast_exp2(v[2] - mx); e[3] = fast_exp2(v[3] - mx);
                        acc[ai][bj][m][n] = e; l += (e[0] + e[1]) + (e[2] + e[3]); }
                l += __shfl_xor(l, 16); l += __shfl_xor(l, 32);
                if (fq == 0) xch[rl * 4 + wc] = (f32x2){mx, l};
                mxs[ai][m] = mx; }
        asm volatile("s_waitcnt lgkmcnt(0)" ::: "memory"); __builtin_amdgcn_s_barrier(); asm volatile("" ::: "memory");
#pragma unroll
        for (int ai = 0; ai < 2; ++ai)
#pragma unroll
            for (int m = 0; m < 4; ++m) { const int rl = ai * 128 + wr * 64 + m * 16 + fr; const int row = u.row0 + rl;
                const f32x2 p0 = xch[rl * 4 + 0], p1 = xch[rl * 4 + 1], p2 = xch[rl * 4 + 2], p3 = xch[rl * 4 + 3];
                const float M = fmaxf(fmaxf(p0.x, p1.x), fmaxf(p2.x, p3.x));
                const float L = (p0.y * fast_exp2(p0.x - M) + p1.y * fast_exp2(p1.x - M)) + (p2.y * fast_exp2(p2.x - M) + p3.y * fast_exp2(p3.x - M));
                const float f = fast_exp2(mxs[ai][m] - M) * fast_rcp(L) * P8_SCALE;
                unsigned char* rowp = P + (size_t)row * 1024 + u.col0 + wc * 32 + 8 * fq;
#pragma unroll
                for (int bj = 0; bj < 2; ++bj) *(u32x2*)(rowp + bj * 128) = pack8_fp8(acc[ai][bj][m][0] * f, acc[ai][bj][m][1] * f); }
    }
};
struct EpiGU {
    unsigned char* hmid; const LAS float* tab2;
    __device__ __forceinline__ void operator()(Acc& acc, const Unit& u, int wr, int wc, int fr, int fq) const {
        const int ub = (u.aux < MAXU ? u.aux : MAXU - 1) * 256;
#pragma unroll
        for (int ai = 0; ai < 2; ++ai)
#pragma unroll
            for (int m = 0; m < 4; ++m) { const int rl = ai * 128 + wr * 64 + m * 16 + fr; const float rs = tab2[ub + rl] * (1.0f / W8_GU_SCALE);
                f32x4 o[2];
#pragma unroll
                for (int n = 0; n < 2; ++n)
#pragma unroll
                    for (int j = 0; j < 4; ++j) { const float g = acc[ai][0][m][n][j] * rs, uu = acc[ai][1][m][n][j] * rs; o[n][j] = g * sigmoidf_(g) * uu * H8_MID_SCALE; }
                *(u32x2*)(hmid + (size_t)(u.row0 + rl) * 512 + (u.col0 >> 1) + wc * 32 + 8 * fq) = pack8_fp8(o[0], o[1]); }
    }
};
struct EpiDown {
    unsigned char* y; const LAS int* tab; const LAS float* tab2;
    __device__ __forceinline__ void operator()(Acc& acc, const Unit& u, int wr, int wc, int fr, int fq) const {
        const int ub = (u.aux < MAXU ? u.aux : MAXU - 1) * 256;
#pragma unroll
        for (int ai = 0; ai < 2; ++ai)
#pragma unroll
            for (int m = 0; m < 4; ++m) { const int rl = ai * 128 + wr * 64 + m * 16 + fr; const int slot = tab[ub + rl]; const float w = tab2[ub + rl] * (Y8_SCALE / (W8_DOWN_SCALE * H8_MID_SCALE));
                if (slot >= 0) { unsigned char* rowp = y + (size_t)slot * 1024 + u.col0 + wc * 32 + 8 * fq;
#pragma unroll
                    for (int bj = 0; bj < 2; ++bj) *(u32x2*)(rowp + bj * 128) = pack8_fp8(acc[ai][bj][m][0] * w, acc[ai][bj][m][1] * w); } }
    }
};
struct EpiIn {
    bf16* xb; bf16* gate; const LAS float* tab2;
    __device__ __forceinline__ void operator()(Acc& acc, const Unit& u, int wr, int wc, int fr, int fq) const {
        const bool isg = u.col0 >= 1024; bf16* dst = isg ? gate : xb; const int c0 = (u.col0 & 1023) + wc * 32 + 8 * fq;
#pragma unroll
        for (int ai = 0; ai < 2; ++ai)
#pragma unroll
            for (int m = 0; m < 4; ++m) { const int rl = ai * 128 + wr * 64 + m * 16 + fr; const int row = u.row0 + rl; const float rs = tab2[(u.aux < MAXU ? u.aux : MAXU - 1) * 256 + rl] * (MK_IN8 ? 1.0f / W8_IN_SCALE : 1.0f);
#pragma unroll
                for (int bj = 0; bj < 2; ++bj) { f32x4 o[2];
#pragma unroll
                    for (int n = 0; n < 2; ++n)
#pragma unroll
                        for (int j = 0; j < 4; ++j) { float v = acc[ai][bj][m][n][j] * rs; if (isg) { const float t = 1.5957691216057308f * (v + 0.044715f * v * v * v); v = v * sigmoidf_(t); } o[n][j] = v; }
                    st16(dst + (size_t)row * 1024 + c0 + bj * 128, pack8(o[0], o[1])); } }
    }
};
struct EpiGates {
    const bf16* xc; unsigned char* loga; unsigned char* bt; const float* bgate; const float* spl;
    __device__ __forceinline__ void operator()(Acc& acc, const Unit& u, int wr, int wc, int fr, int fq) const {
        const int ch = u.col0 + wc * 32 + 8 * fq;
        const int hh = u.col0 >> 8, cin = (u.col0 & 255) + wc * 32 + 8 * fq;
        f32x4 br[2], bi[2], sp[2];
#pragma unroll
        for (int n = 0; n < 2; ++n) { br[n] = *(const f32x4*)(bgate + hh * 512 + cin + 4 * n); bi[n] = *(const f32x4*)(bgate + hh * 512 + 256 + cin + 4 * n); sp[n] = *(const f32x4*)(spl + ch + 4 * n); }
        u32x4 xv[2][4];
#pragma unroll
        for (int ai = 0; ai < 2; ++ai)
#pragma unroll
            for (int m = 0; m < 4; ++m) xv[ai][m] = *(const u32x4*)(xc + (size_t)(u.row0 + ai * 128 + wr * 64 + m * 16 + fr) * 1024 + ch);
#pragma unroll
        for (int ai = 0; ai < 2; ++ai)
#pragma unroll
            for (int m = 0; m < 4; ++m) { const int row = u.row0 + ai * 128 + wr * 64 + m * 16 + fr; const size_t ro = (size_t)row * 1024 + ch;
                f32x4 x[2]; unpack8(xv[ai][m], x[0], x[1]);
                f32x4 la[2], bb[2];
#pragma unroll
                for (int n = 0; n < 2; ++n)
#pragma unroll
                    for (int j = 0; j < 4; ++j) { const float er = 1.0f + fast_exp2(fminf(-(acc[ai][0][m][n][j] + br[n][j]) * LOG2E, 60.f)), ei = 1.0f + fast_exp2(fminf(-(acc[ai][1][m][n][j] + bi[n][j]) * LOG2E, 60.f));
                        const float q = fast_rcp(er * ei); const float r = q * ei, ig = q * er;
                        const float l = -8.0f * r * sp[n][j]; const float a2 = fast_exp2(2.0f * LOG2E * l); const float mult = __builtin_amdgcn_sqrtf(fmaxf(1.0f - a2, 0.f));
                        la[n][j] = l; bb[n][j] = mult * ig * x[n][j]; }
                *(u32x2*)(loga + ro) = pack8_fp8(la[0] * LA8_SCALE, la[1] * LA8_SCALE); *(u32x2*)(bt + ro) = pack8_fp8(bb[0] * BT8_SCALE, bb[1] * BT8_SCALE); }
    }
};
}

#define XB_TMO      128
#define XB_XCNT(j)  (256  + 64 * (j))
#define XB_XSUB(j)  (1280 + 64 * (j))
#define XB_XGEN(j)  (2304 + 64 * (j))
#define XB_TOP      3328
#define XB_TOPGEN   3392
#define XCD_BAR_WORDS 3456
#define XB_SPIN_CAP (1u << 18)

__device__ __forceinline__ unsigned xb_ld(unsigned* p)              { return __hip_atomic_load(p, __ATOMIC_RELAXED, __HIP_MEMORY_SCOPE_AGENT); }
__device__ __forceinline__ unsigned xb_add(unsigned* p, unsigned v) { return __hip_atomic_fetch_add(p, v, __ATOMIC_RELAXED, __HIP_MEMORY_SCOPE_AGENT); }
__device__ __forceinline__ unsigned xb_xcc_id() { return (unsigned)__builtin_amdgcn_s_getreg((3 << 11) | 20) & 0xFu; }
#define XB_SPIN(cond, bar) do { unsigned _sp = 0; while (cond) { __builtin_amdgcn_s_sleep(1); \
    if ((++_sp & 255u) == 0u) { if (xb_ld(&(bar)[XB_TMO])) break; if (_sp > XB_SPIN_CAP) { atomicAdd(&(bar)[XB_TMO], 1u); break; } } } } while (0)

struct XcdBarrier { unsigned* bar; unsigned x; volatile LAS unsigned* st; };

__device__ __forceinline__ XcdBarrier xcd_barrier_post(unsigned* bar, volatile LAS unsigned* st) {
    XcdBarrier b; b.bar = bar; b.x = xb_xcc_id(); b.st = st;
    if (threadIdx.x == 0) (void)xb_add(&bar[XB_XCNT(b.x)], 1u);
    return b;
}
__device__ __forceinline__ void xcd_barrier_complete(unsigned* bar, unsigned x, unsigned& nloc, unsigned& nx) {
    const unsigned G = gridDim.x * gridDim.y * gridDim.z;
    unsigned sum, cnt, mine, sp = 0u;
    for (;;) {
        sum = 0u; cnt = 0u; mine = 0u;
#pragma unroll
        for (unsigned j = 0; j < 16; ++j) { const unsigned c = xb_ld(&bar[XB_XCNT(j)]); sum += c; cnt += (c > 0u) ? 1u : 0u; mine = (j == x) ? c : mine; }
        if (sum == G) break;
        __builtin_amdgcn_s_sleep(1);
        if ((++sp & 255u) == 0u) { if (xb_ld(&bar[XB_TMO])) break; if (sp > XB_SPIN_CAP) { atomicAdd(&bar[XB_TMO], 1u); break; } }
    }
    nloc = mine > 0u ? mine : 1u; nx = cnt > 0u ? cnt : 1u;
}
__device__ __forceinline__ void xcd_barrier(const XcdBarrier& b) {
    asm volatile("s_waitcnt vmcnt(0)" ::: "memory");
    __syncthreads();
    if (threadIdx.x == 0) {
        unsigned* bar = b.bar;
        __builtin_amdgcn_s_waitcnt(0);
        unsigned nloc = b.st[0], nx = b.st[1];
        if (nloc == 0u) { xcd_barrier_complete(bar, b.x, nloc, nx); b.st[0] = nloc; b.st[1] = nx; }
        const unsigned old = xb_add(&bar[XB_XSUB(b.x)], 1u);
        const unsigned gen = old / nloc;
        if (old + 1u == (gen + 1u) * nloc) {
            __builtin_amdgcn_fence(__ATOMIC_RELEASE, "agent");
            asm volatile("s_waitcnt vmcnt(0)" ::: "memory");
            const unsigned og = xb_add(&bar[XB_TOP], 1u);
            asm volatile("buffer_inv sc1" ::: "memory");
            const unsigned tg = og / nx;
            if (og + 1u == (tg + 1u) * nx) xb_add(&bar[XB_TOPGEN], 1u);
            else XB_SPIN(xb_ld(&bar[XB_TOPGEN]) == tg, bar);
            xb_add(&bar[XB_XGEN(b.x)], 1u);
            asm volatile("s_waitcnt vmcnt(0)" ::: "memory");
        } else {
            asm volatile("buffer_inv sc1" ::: "memory");
            XB_SPIN(xb_ld(&bar[XB_XGEN(b.x)]) == gen, bar);
            asm volatile("s_waitcnt vmcnt(0)" ::: "memory");
        }
    }
    __syncthreads();
}

struct Args { const float* in[25]; float* out; unsigned char* ws; int ph_lo, ph_hi; unsigned dup, pad; };
struct Frame {
    LAS unsigned char* lds;
    int tid, lane, wave, G, vcu; unsigned gep; bool guni;
    unsigned char* ws; unsigned char* ob;
};
enum { I_X = 0, I_MEM, I_POOL_W, I_POOL_SCALE, I_RG_W_IN, I_RG_CONV_W, I_RG_CONV_B, I_RG_W_GATE, I_RG_B_GATE, I_RG_LAMBDA, I_RG_W_OUT, I_XA_WQ, I_XA_WKV, I_XA_WO,
       I_MOE_WG, I_MOE_BG, I_MOE_WE, I_MOE_BE, I_MOE_W_GU, I_MOE_W_DOWN, I_NORM_MIX, I_NORM_XATTN, I_NORM_MEM, I_NORM_MOE, I_NORM_FINAL };

__device__ __forceinline__ void group_barrier(unsigned* ctl, const unsigned ep, const unsigned gsz, const bool uni) {
    asm volatile("s_waitcnt vmcnt(0)" ::: "memory");
    __syncthreads();
    if (threadIdx.x == 0) {
        unsigned* cnt = ctl + CW_GRP + (blockIdx.x & 7u) * 64u; unsigned* gen = cnt + 1024; unsigned* bar = ctl + CW_BAR;
        if (uni) {
            const unsigned old = xb_add(cnt, 1u);
            asm volatile("buffer_inv sc1" ::: "memory");
            if (old + 1u == gsz * ep) __hip_atomic_store(gen, ep, __ATOMIC_RELAXED, __HIP_MEMORY_SCOPE_AGENT);
            else XB_SPIN(xb_ld(gen) < ep, bar);
            asm volatile("s_waitcnt vmcnt(0)" ::: "memory");
        } else {
            __builtin_amdgcn_fence(__ATOMIC_RELEASE, "agent");
            asm volatile("s_waitcnt vmcnt(0)" ::: "memory");
            (void)xb_add(cnt, 1u);
            XB_SPIN(xb_ld(cnt) < gsz * ep, bar);
            __builtin_amdgcn_fence(__ATOMIC_ACQUIRE, "agent");
            asm volatile("s_waitcnt vmcnt(0)" ::: "memory");
        }
    }
    __syncthreads();
}

__device__ __forceinline__ void tr_item(const float* W, int ldw, int k0, int scol0, const float* gain, void* out, int ldo, int orow0, LAS float* scr, int lane, int f8 = 0, float scl = 1.0f) {
    f32x4 v[8];
    const int kq = lane >> 3, n4 = (lane & 7) * 4;
#pragma unroll
    for (int i = 0; i < 8; ++i) v[i] = *(const f32x4*)(W + (size_t)(k0 + 8 * i + kq) * ldw + scol0 + n4);
    if (gain) {
#pragma unroll
        for (int i = 0; i < 8; ++i) v[i] *= gain[k0 + 8 * i + kq] * scl;
    } else if (f8) {
#pragma unroll
        for (int i = 0; i < 8; ++i) v[i] *= scl;
    }
#pragma unroll
    for (int i = 0; i < 8; ++i) { LAS float* d = scr + (8 * i + kq) * 33 + n4; d[0] = v[i][0]; d[1] = v[i][1]; d[2] = v[i][2]; d[3] = v[i][3]; }
    LDS_WAIT(); asm volatile("" ::: "memory");
    const int c = lane & 7;
#pragma unroll
    for (int j = 0; j < 4; ++j) { const int n = (lane >> 3) + 8 * j; const LAS float* s = scr + (8 * c) * 33 + n;
        if (f8) { *(u32x2*)((unsigned char*)out + (size_t)(orow0 + n) * ldo + k0 + 8 * c) = pack8_fp8((f32x4){s[0 * 33], s[1 * 33], s[2 * 33], s[3 * 33]}, (f32x4){s[4 * 33], s[5 * 33], s[6 * 33], s[7 * 33]}); }
        else { u32x4 o; o.x = pk2(s[0 * 33], s[1 * 33]); o.y = pk2(s[2 * 33], s[3 * 33]); o.z = pk2(s[4 * 33], s[5 * 33]); o.w = pk2(s[6 * 33], s[7 * 33]);
            *(u32x4*)((bf16*)out + (size_t)(orow0 + n) * ldo + k0 + 8 * c) = o; } }
    LDS_WAIT(); asm volatile("" ::: "memory");
}
__device__ __forceinline__ void tr_job(int q, const float* W, int Kdim, int ldw, int NO, int mapmode, int mapoff, const float* gain, void* out, LAS float* scr, int lane, int f8 = 0, float scl = 1.0f) {
    const int nblk = NO / 32, kb = q / nblk, nb = q % nblk, n0 = 32 * nb;
    int sc = n0;
    if (mapmode) { const int tile = n0 >> 8, w = n0 & 255; sc = (w < 128) ? (128 * tile + w) : (mapoff + 128 * tile + (w - 128)); }
    tr_item(W, ldw, 64 * kb, sc, gain, out, Kdim, n0, scr, lane, f8, scl);
}
__device__ __forceinline__ float row_sumsq_f32(const float* row, int lane, f32x4 (&v)[4]) {
    const f32x4* xr = (const f32x4*)row + lane; float s = 0.f;
#pragma unroll
    for (int j = 0; j < 4; ++j) { v[j] = xr[64 * j]; s += (v[j][0] * v[j][0] + v[j][1] * v[j][1]) + (v[j][2] * v[j][2] + v[j][3] * v[j][3]); }
    return wave_sum(s);
}

__device__ __forceinline__ void phase_prologue(Frame& F, const Args& args, const int part) {
    LAS float* scr = (LAS float*)(F.lds + RING_OFF + F.wave * 16384);
    const int gw = F.vcu * 8 + F.wave, NGW = F.G * 8, lane = F.lane;
    unsigned char* ws = F.ws;
    const float* nmix = args.in[I_NORM_MIX]; const float* nxat = args.in[I_NORM_XATTN]; const float* nmem = args.in[I_NORM_MEM]; const float* nmoe = args.in[I_NORM_MOE];
    constexpr int J0 = 128, J1 = 1024, J2 = 256, J3 = 512, J4 = 2048, J5 = 512;
    const int NITEMS = (part == 0) ? (J0 + J4 + J5) : (J1 + J2 + J3 + J5);
    for (int it = gw; it < NITEMS; it += NGW) {
        int r = it;
        if (part == 0) {
            if (r < J0) { const int g = r / 32, q = r % 32; tr_job(q, args.in[I_POOL_W] + (size_t)g * 65536, 256, 256, 256, 0, 0, nullptr, (bf16*)(ws + WS_W_POOL) + (size_t)g * 65536, scr, lane); continue; } r -= J0;
            if (r < J4) { const int l = r / 1024, q = r % 1024; tr_job(q, args.in[I_XA_WKV] + (size_t)l * 2097152, 1024, 2048, 2048, 0, 0, nullptr, (bf16*)(ws + WS_W_KV) + (size_t)l * 2097152, scr, lane); continue; } r -= J4;
            { tr_job(r, args.in[I_XA_WO], 1024, 1024, 1024, 0, 0, nullptr, (bf16*)(ws + WS_W_OT), scr, lane); }
        } else {
            if (r < J1) { if (MK_IN8) tr_job(r, args.in[I_RG_W_IN], 1024, 2048, 2048, 0, 0, nmix + 1024, (unsigned char*)(ws + WS_W_IN), scr, lane, 1, W8_IN_SCALE);
                          else tr_job(r, args.in[I_RG_W_IN], 1024, 2048, 2048, 0, 0, nmix + 1024, (bf16*)(ws + WS_W_IN), scr, lane); continue; } r -= J1;
            if (r < J2) { const int h = r / 64, q = r % 64; tr_job(q, args.in[I_RG_W_GATE] + (size_t)h * 131072, 256, 512, 512, 1, 256, nullptr, (bf16*)(ws + WS_W_GATE) + (size_t)h * 131072, scr, lane); continue; } r -= J2;
            if (r < J3) { tr_job(r, args.in[I_RG_W_OUT], 1024, 1024, 1024, 0, 0, nullptr, (bf16*)(ws + WS_W_OUT), scr, lane); continue; } r -= J3;
            { tr_job(r, args.in[I_XA_WO] + (size_t)1048576, 1024, 1024, 1024, 0, 0, nullptr, (bf16*)(ws + WS_W_OT) + (size_t)1048576, scr, lane); }
        }
    }
    constexpr int R_WQ = 1024, R_MEMN = 2 * NMR, R_WRB = 2 * 128, R_SPL = 1;
    const int NROWS = (part == 0) ? (R_WQ + R_MEMN + R_WRB) : (R_WQ + R_SPL);
    for (int it = gw; it < NROWS; it += NGW) {
        int r = it;
        if (r < R_WQ) {
            const int l = part, d = r; r += part * 1024; const float gsc = nxat[l * 1024 + d] * (LOG2E / 16.0f);
            const f32x4* src = (const f32x4*)(args.in[I_XA_WQ] + (size_t)r * 1024) + lane; u32x2* dst = (u32x2*)((bf16*)(ws + WS_W_Q) + (size_t)r * 1024) + lane;
#pragma unroll
            for (int j = 0; j < 4; ++j) { const f32x4 v = src[64 * j] * gsc; dst[64 * j] = (u32x2){pk2(v[0], v[1]), pk2(v[2], v[3])}; }
            continue; } r -= R_WQ;
        if (part == 0 && r < R_MEMN) {
            const int l = r / NMR, row = r % NMR; f32x4 v[4]; const float ss = row_sumsq_f32(args.in[I_MEM] + (size_t)row * 1024, lane, v);
            const float rs = __builtin_amdgcn_rsqf(ss * (1.0f / 1024.0f) + EPS);
            const f32x4* gp = (const f32x4*)(nmem + l * 1024) + lane; u32x2* dst = (u32x2*)((bf16*)(ws + WS_MEMN) + (size_t)r * 1024) + lane;
#pragma unroll
            for (int j = 0; j < 4; ++j) { const f32x4 o = v[j] * gp[64 * j] * rs; dst[64 * j] = (u32x2){pk2(o[0], o[1]), pk2(o[2], o[3])}; }
            continue; } if (part == 0) r -= R_MEMN;
        if (part == 0 && r < R_WRB) {
            const int l = r >> 7, blk = r & 127;
            bf16* dst = (bf16*)(ws + WS_WRB) + (size_t)l * 65536 + blk * 512;
#pragma unroll
            for (int e8 = 0; e8 < 8; ++e8) { const int idx = blk * 512 + e8 * 64 + lane; const int jj = idx & 7, ln = (idx >> 3) & 63, ks = (idx >> 9) & 31, tl = idx >> 14;
                const int col = (tl & 1) * 16 + (ln & 15), d = 32 * ks + 8 * (ln >> 4) + jj;
                float w = 0.f;
                if (col < 4) w = args.in[I_MOE_WG][(size_t)l * 4096 + d * 4 + col];
                else if (col < 20) w = args.in[I_MOE_WE][(((size_t)l * 4 + ((col - 4) >> 2)) * 1024 + d) * 4 + ((col - 4) & 3)];
                w *= nmoe[l * 1024 + d];
                const unsigned hi = f2bf(w); const float lo = w - __builtin_bit_cast(float, hi << 16);
                dst[e8 * 64 + lane] = (bf16)((tl < 2) ? hi : f2bf(lo)); }
            continue; } r -= R_WRB;
        {
#pragma unroll
            for (int j = 0; j < 16; ++j) { const int c = j * 64 + lane; const float lam = args.in[I_RG_LAMBDA][c]; const float z = -lam;
                ((float*)(ws + WS_SPL))[c] = (z > 20.f) ? z : log1pf(expf(z)); }
        }
    }
}

__device__ __forceinline__ void conv_moe_weights(Frame& F, const Args& args, const int l) {
    LAS float* scr = (LAS float*)(F.lds + RING_OFF + F.wave * 16384);
    const int gw = F.vcu * 8 + F.wave, NGW = F.G * 8, lane = F.lane;
    unsigned char* ws = F.ws; const float* nmoe = args.in[I_NORM_MOE];
    for (int it = gw; it < 8192 + 4096; it += NGW) {
        if (it < 8192) { const int le = l * 16 + it / 512, q = it % 512; tr_job(q, args.in[I_MOE_W_GU] + (size_t)le * 1048576, 1024, 1024, 1024, 1, 512, nmoe + l * 1024, (unsigned char*)(ws + WS_W_GU) + (size_t)le * 1048576, scr, lane, 1, W8_GU_SCALE); }
        else { const int r = it - 8192; const int le = l * 16 + r / 256, q = r % 256; tr_job(q, args.in[I_MOE_W_DOWN] + (size_t)le * 524288, 512, 1024, 1024, 0, 0, nullptr, (unsigned char*)(ws + WS_W_DOWN) + (size_t)le * 524288, scr, lane, 1, W8_DOWN_SCALE); }
    }
}

template <int W> __device__ __forceinline__ void pool_step(f32x4 (&hist)[W], f32x4& sum, const f32x4 cur, const int i, const int cnt_s, const f32x4 gm, u32x2* dst) {
    sum += cur; const int cnt = cnt_s < W ? cnt_s : W; const f32x4 p = (sum * (1.0f / (float)cnt) - cur) * gm; *dst = (u32x2){pk2(p[0], p[1]), pk2(p[2], p[3])};
    hist[i % W] = cur; sum -= hist[(i + 1) % W];
}
constexpr int PBR = 2;
__device__ __forceinline__ void pool_loadn(const float* __restrict__ xb, int s, int nrow, f32x4 (&v)[PBR][4]) {
#pragma unroll
    for (int r = 0; r < PBR; ++r) if (r < nrow) {
        if (s + r >= 0) {
#pragma unroll
            for (int g = 0; g < 4; ++g) v[r][g] = *(const f32x4*)(xb + (size_t)(s + r) * D + g * 256);
        } else {
#pragma unroll
            for (int g = 0; g < 4; ++g) v[r][g] = (f32x4){0.f, 0.f, 0.f, 0.f};
        } }
#pragma unroll
    for (int r = 0; r < PBR; ++r) if (r < nrow) { float ss = 0.f;
#pragma unroll
        for (int g = 0; g < 4; ++g) ss += (v[r][g][0] * v[r][g][0] + v[r][g][1] * v[r][g][1]) + (v[r][g][2] * v[r][g][2] + v[r][g][3] * v[r][g][3]);
        const float rs = __builtin_amdgcn_rsqf(wave_sum(ss) * (1.0f / 1024.0f) + EPS);
#pragma unroll
        for (int g = 0; g < 4; ++g) v[r][g] *= rs; }
}
__device__ __forceinline__ void pool_run(const float* __restrict__ xb, bf16* __restrict__ prow, const int s0, const f32x4 (&gm)[4], const int lane) {
    f32x4 h0[2], h1[4], h2[8], h3[16], sum[4];
#pragma unroll
    for (int g = 0; g < 4; ++g) sum[g] = (f32x4){0.f, 0.f, 0.f, 0.f};
#pragma unroll
    for (int jb = 15; jb >= 1; jb -= PBR) { const int nrow = jb >= PBR ? PBR : jb; f32x4 v[PBR][4]; pool_loadn(xb, s0 - jb, nrow, v);
#pragma unroll
        for (int r = 0; r < PBR; ++r) if (r < nrow) { const int j = jb - r;
            if (j < 2) { h0[(16 - j) % 2] = v[r][0]; sum[0] += v[r][0]; }
            if (j < 4) { h1[(16 - j) % 4] = v[r][1]; sum[1] += v[r][1]; }
            if (j < 8) { h2[(16 - j) % 8] = v[r][2]; sum[2] += v[r][2]; }
            { h3[(16 - j) % 16] = v[r][3]; sum[3] += v[r][3]; } } }
#pragma unroll
    for (int ib = 0; ib < 16; ib += PBR) { f32x4 v[PBR][4]; pool_loadn(xb, s0 + ib, PBR, v);
#pragma unroll
        for (int r = 0; r < PBR; ++r) { const int i = ib + r, s = s0 + i; u32x2* dst = (u32x2*)(prow + (size_t)i * D) + lane;
            pool_step<2>(h0, sum[0], v[r][0], i, s + 1, gm[0], dst);
            pool_step<4>(h1, sum[1], v[r][1], i, s + 1, gm[1], dst + 64);
            pool_step<8>(h2, sum[2], v[r][2], i, s + 1, gm[2], dst + 128);
            pool_step<16>(h3, sum[3], v[r][3], i, s + 1, gm[3], dst + 192); } }
}
__device__ __forceinline__ void phase_pool_p(Frame& F, const Args& args) {
    const int gw = F.vcu * 8 + F.wave, NGW = F.G * 8, lane = F.lane;
    bf16* P0 = (bf16*)(F.ob + OB_P0);
    f32x4 gm[4];
#pragma unroll
    for (int g = 0; g < 4; ++g) gm[g] = *(const f32x4*)(args.in[I_NORM_MIX] + g * 256 + 4 * lane);
    for (int it = gw; it < NB * (SEQ / 16); it += NGW) {
        const int b = it >> 7, s0 = (it & 127) * 16;
        pool_run(args.in[I_X] + (size_t)b * SEQ * D + 4 * lane, P0 + ((size_t)b * SEQ + s0) * D, s0, gm, lane);
    }
}

struct SchedKV {
    int G, c; const char* A; const char* B; char* Kb; char* Vb;
    __device__ __forceinline__ bool next(int i, pg8::Unit& u) const { int pm, pn; if (!pg8::tile_of(i, G, c, 32, 8, pm, pn, 4)) return false;
        const int l = pm & 1, b = pm >> 1; u.A = A + (size_t)(l * 16 + b) * 256 * 2048; u.B = B + (size_t)l * 4194304 + (size_t)pn * 256 * 2048;
        u.C = ((pn < 4) ? Kb : Vb) + ((size_t)l * 4096 + (size_t)b * 256) * 2048 + (size_t)(pn & 3) * 512; u.row0 = (l * 16 + b) * 256; u.col0 = pn * 256; u.aux = i; return true; }
};
struct SchedMVW {
    int G, c; const char* Kl; const char* Vl; const char* Wq; const char* Wot; char* BS; char* BO;
    __device__ __forceinline__ bool next(int i, pg8::Unit& u) const { int pm, pn; if (!pg8::tile_of(i, G, c, 128, 4, pm, pn)) return false;
        const int b = pm >> 3, kind = (pm >> 2) & 1, h = pm & 3;
        if (kind == 0) { u.A = Kl + ((size_t)b * 256) * 2048 + h * 512; u.B = Wq + ((size_t)pn * 256) * 2048 + h * 512; u.C = BS + (size_t)b * 1048576 + ((size_t)h * 256) * 1024 + pn * 256; }
        else { u.A = Wot + ((size_t)pn * 256) * 2048 + h * 512; u.B = Vl + ((size_t)b * 256) * 2048 + h * 512; u.C = BO + (size_t)b * 1048576 + ((size_t)pn * 256) * 1024 + h * 256; }
        u.row0 = 0; u.col0 = kind; u.aux = i; return true; }
};
struct SchedDense {
    int G, c, nN; const char* A; size_t apan; size_t acol; int adiv; const char* B; size_t bpn; size_t bbatch; int cmul; int wgm;
    __device__ __forceinline__ bool next(int i, pg8::Unit& u) const { int pm, pn; if (!pg8::tile_of(i, G, c, NTOK / 256, nN, pm, pn, wgm)) return false;
        u.A = A + (size_t)pm * apan + (size_t)(pn / adiv) * acol; u.B = B + (size_t)pn * bpn + (size_t)(pm >> 3) * bbatch; u.C = nullptr; u.row0 = pm * 256; u.col0 = pn * cmul; u.aux = i; return true; }
};
struct SchedMoE {
    int G, c, nT; int tpre[17]; const char* A; size_t atile; const char* B; size_t bexp, bpn;
    __device__ __forceinline__ int expert_of(int tile) const { int e = 0;
#pragma unroll
        for (int k = 1; k < 16; ++k) e += (tile >= tpre[k]) ? 1 : 0;
        return e; }
    __device__ __forceinline__ int first_tile(int e) const { int t = 0;
#pragma unroll
        for (int k = 1; k < 16; ++k) t = (k == e) ? tpre[k] : t;
        return t; }
    __device__ __forceinline__ bool next(int i, pg8::Unit& u) const { int tile, pn;
        if (G == 256) {
            const int g = c & 7, rank = c >> 3, base = nT >> 3, rem = nT & 7;
            const int ng = base + (g < rem ? 1 : 0), first = g * base + (g < rem ? g : rem);
            const int j = i * 32 + rank; if (j >= ng * 4) return false;
            const int gid = j >> 5, w = j & 31, fm = gid * 8, gsz = (ng - fm) < 8 ? (ng - fm) : 8;
            tile = first + fm + (w % gsz); pn = w / gsz;
        } else if (!pg8::tile_of(i, G, c, nT, 4, tile, pn, MK_WGM_MOE)) return false;
        const int e = expert_of(tile);
        u.A = A + (size_t)tile * atile; u.B = B + (size_t)e * bexp + (size_t)pn * bpn; u.C = nullptr; u.row0 = tile * 256; u.col0 = pn * 256; u.aux = i; return true; }
};
__device__ __forceinline__ void moe_sched_init(SchedMoE& S, Frame& F, int l) {
    const unsigned* cnt = (const unsigned*)(F.ws + WS_CTL) + CW_CNT + l * 16 * 64;
    unsigned n[16];
#pragma unroll
    for (int e = 0; e < 16; ++e) n[e] = __hip_atomic_load(cnt + e * 64, __ATOMIC_RELAXED, __HIP_MEMORY_SCOPE_AGENT);
    int acc = 0;
#pragma unroll
    for (int e = 0; e < 16; ++e) { S.tpre[e] = acc; acc += ((int)__builtin_amdgcn_readfirstlane(n[e]) + 255) >> 8; }
    S.tpre[16] = acc; S.nT = acc; S.G = F.G; S.c = (int)blockIdx.x;
}
__device__ __forceinline__ void moe_fill_tables(const SchedMoE& S, Frame& F, int l, int mode) {
    const int* list = (const int*)(F.ws + WS_LIST); const float* rstd = (const float*)(F.ws + WS_RSTD_B); const float* gwv = (const float*)(F.ws + WS_GW);
    LAS int* tab = (LAS int*)(F.lds + TAB_OFF); LAS float* tab2 = (LAS float*)(F.lds + TAB2_OFF);
    const unsigned* cntp = (const unsigned*)(F.ws + WS_CTL) + CW_CNT + l * 16 * 64;
    if (F.tid < 256) {
        unsigned n[16];
#pragma unroll
        for (int e = 0; e < 16; ++e) n[e] = __hip_atomic_load(cntp + e * 64, __ATOMIC_RELAXED, __HIP_MEMORY_SCOPE_AGENT);
        int slot[MAXU]; bool valid[MAXU]; bool have[MAXU]; float aux[MAXU];
#pragma unroll
        for (int j = 0; j < MAXU; ++j) { pg8::Unit u; have[j] = S.next(j, u); slot[j] = 0; valid[j] = false;
            if (have[j]) { const int tile = u.row0 >> 8, e = S.expert_of(tile), tl = tile - S.first_tile(e), pos = tl * 256 + F.tid; int ne = (int)n[0];
#pragma unroll
                for (int k = 1; k < 16; ++k) ne = (k == e) ? (int)n[k] : ne;
                valid[j] = pos < ne;
                slot[j] = list[(size_t)e * NTOK + (valid[j] ? pos : 0)]; } }
#pragma unroll
        for (int j = 0; j < MAXU; ++j) { aux[j] = 0.f; if (have[j]) aux[j] = (mode == 0) ? rstd[slot[j] >> 1] : gwv[slot[j]]; }
#pragma unroll
        for (int j = 0; j < MAXU; ++j) if (have[j]) { tab[j * 256 + F.tid] = (mode == 0) ? (slot[j] >> 1) : (valid[j] ? slot[j] : -1); tab2[j * 256 + F.tid] = aux[j]; }
    }
    __syncthreads();
}

template <class Sched> __device__ __forceinline__ void fill_row_scale(const Sched& S, Frame& F, const float* src, int mode) {
    LAS float* tab2 = (LAS float*)(F.lds + TAB2_OFF);
    if (F.tid < 256) {
#pragma unroll
        for (int j = 0; j < MAXU; ++j) { pg8::Unit u; if (S.next(j, u)) { const int row = u.row0 + F.tid; float r;
            if (mode == 0) { const f32x4* sp = (const f32x4*)(src + (size_t)row * 16); const f32x4 qs = (sp[0] + sp[1]) + (sp[2] + sp[3]); r = __builtin_amdgcn_rsqf(((qs[0] + qs[1]) + (qs[2] + qs[3])) * (1.0f / 1024.0f) + EPS); }
            else r = src[row];
            tab2[j * 256 + F.tid] = r; } }
    }
    __syncthreads();
}

__device__ __forceinline__ void phase_router(Frame& F, const Args& args, int l, const bf16* H) {
    { const u32x4* src = (const u32x4*)(F.ws + WS_WRB + (size_t)l * 131072); LAS u32x4* dst = (LAS u32x4*)(F.lds + RING_OFF);
      u32x4 t[16];
#pragma unroll
      for (int i = 0; i < 16; ++i) t[i] = src[F.tid + 512 * i];
#pragma unroll
      for (int i = 0; i < 16; ++i) dst[F.tid + 512 * i] = t[i]; }
    __syncthreads();
    LAS float* lgs = (LAS float*)(F.lds + TAB_OFF) + F.wave * 336;
    LAS int* sel_e = (LAS int*)(F.lds + XCH_OFF); LAS float* sel_w = (LAS float*)(F.lds + XCH_OFF + 1024);
    LAS int* lcnt = (LAS int*)(F.lds + XCH_OFF + 2048); LAS int* lbase = lcnt + 16; LAS int* rnk = (LAS int*)(F.lds + XCH_OFF + 3072);
    unsigned* gcnt = (unsigned*)(F.ws + WS_CTL) + CW_CNT + l * 16 * 64;
    int* list = (int*)(F.ws + WS_LIST); float* gwv = (float*)(F.ws + WS_GW); float* rstd = (float*)(F.ws + WS_RSTD_B);
    const float* bg = args.in[I_MOE_BG] + l * 4; const float* be = args.in[I_MOE_BE] + l * 16;
    const int lane = F.lane, fr = lane & 15, fq = lane >> 4;
    for (int tb = F.vcu; tb < NTOK / 128; tb += F.G) {
        const int t0 = tb * 128 + F.wave * 16;
        const bf16* hp = H + (size_t)(t0 + fr) * 1024 + 8 * fq;
        f32x4 acc0 = {0.f, 0.f, 0.f, 0.f}, acc1 = {0.f, 0.f, 0.f, 0.f}; float ssq = 0.f;
        if (F.tid < 16) lcnt[F.tid] = 0;
#pragma unroll 16
        for (int ks = 0; ks < 32; ++ks) {
            const u32x4 av = *(const u32x4*)(hp + ks * 32);
            f32x4 x0, x1; unpack8(av, x0, x1); ssq += (x0[0] * x0[0] + x0[1] * x0[1]) + (x0[2] * x0[2] + x0[3] * x0[3]) + (x1[0] * x1[0] + x1[1] * x1[1]) + (x1[2] * x1[2] + x1[3] * x1[3]);
            const bf16x8 a = __builtin_bit_cast(bf16x8, av);
            const LAS bf16x8* bp = (const LAS bf16x8*)(F.lds + RING_OFF) + ks * 64 + lane;
            const bf16x8 b0 = bp[0], b1 = bp[2048], b2 = bp[4096], b3 = bp[6144];
            acc0 = __builtin_amdgcn_mfma_f32_16x16x32_bf16(a, b0, acc0, 0, 0, 0); acc0 = __builtin_amdgcn_mfma_f32_16x16x32_bf16(a, b2, acc0, 0, 0, 0);
            acc1 = __builtin_amdgcn_mfma_f32_16x16x32_bf16(a, b1, acc1, 0, 0, 0); acc1 = __builtin_amdgcn_mfma_f32_16x16x32_bf16(a, b3, acc1, 0, 0, 0);
        }
        ssq += __shfl_xor(ssq, 16); ssq += __shfl_xor(ssq, 32);
#pragma unroll
        for (int rg = 0; rg < 4; ++rg) { lgs[(4 * fq + rg) * 21 + fr] = acc0[rg]; if (fr < 4) lgs[(4 * fq + rg) * 21 + 16 + fr] = acc1[rg]; }
        LDS_WAIT(); asm volatile("" ::: "memory");
        if (lane < 16) {
            const float rs = __builtin_amdgcn_rsqf(ssq * (1.0f / 1024.0f) + EPS);
            const LAS float* lg = lgs + lane * 21;
            float g0 = lg[0] * rs + bg[0], g1 = lg[1] * rs + bg[1], g2 = lg[2] * rs + bg[2], g3 = lg[3] * rs + bg[3];
            int g = 0; float gm = g0; if (g1 > gm) { gm = g1; g = 1; } if (g2 > gm) { gm = g2; g = 2; } if (g3 > gm) { gm = g3; g = 3; }
            const float gp = 1.0f / (expf(g0 - gm) + expf(g1 - gm) + expf(g2 - gm) + expf(g3 - gm));
            float le[4];
#pragma unroll
            for (int k = 0; k < 4; ++k) le[k] = lg[4 + 4 * g + k] * rs + be[4 * g + k];
            int e1 = 0; float m1 = le[0];
#pragma unroll
            for (int k = 1; k < 4; ++k) if (le[k] > m1) { m1 = le[k]; e1 = k; }
            int e2 = -1; float m2 = -3.0e38f;
#pragma unroll
            for (int k = 0; k < 4; ++k) if (k != e1 && le[k] > m2) { m2 = le[k]; e2 = k; }
            const float z = expf(m2 - m1); const float q1 = 1.0f / (1.0f + z), q2 = z * q1;
            const int tl = F.wave * 16 + lane;
            sel_e[2 * tl] = 4 * g + e1; sel_e[2 * tl + 1] = 4 * g + e2; sel_w[2 * tl] = gp * q1; sel_w[2 * tl + 1] = gp * q2;
            rstd[t0 + lane] = rs;
        }
        __syncthreads();
        int my_e = 0;
        if (F.tid < 256) { my_e = sel_e[F.tid]; rnk[F.tid] = __hip_atomic_fetch_add(&lcnt[my_e], 1, __ATOMIC_RELAXED, __HIP_MEMORY_SCOPE_WORKGROUP); }
        __syncthreads();
        if (F.tid < 16) { const int n = lcnt[F.tid]; lbase[F.tid] = n ? (int)__hip_atomic_fetch_add(gcnt + F.tid * 64, (unsigned)n, __ATOMIC_RELAXED, __HIP_MEMORY_SCOPE_AGENT) : 0; }
        __syncthreads();
        if (F.tid < 256) { const int pos = lbase[my_e] + rnk[F.tid]; const int slot = tb * 256 + F.tid; list[(size_t)my_e * NTOK + pos] = slot; gwv[slot] = sel_w[F.tid]; }
        __syncthreads();
    }
}

__device__ __forceinline__ void phase_combine(Frame& F, const Args& args, int mode, const bf16* H, bf16* Hout, float* outf, unsigned char* h8c) {
    const int gw = F.vcu * 8 + F.wave, NGW = F.G * 8, lane = F.lane;
    const unsigned char* Y = (const unsigned char*)(F.ws + WS_Y); float* rstd = (float*)(F.ws + WS_RSTD_A);
    f32x4 gf[4];
    if (mode == 1) {
#pragma unroll
        for (int hf = 0; hf < 2; ++hf) { gf[2 * hf] = *(const f32x4*)(args.in[I_NORM_FINAL] + hf * 512 + 8 * lane); gf[2 * hf + 1] = *(const f32x4*)(args.in[I_NORM_FINAL] + hf * 512 + 8 * lane + 4); }
    }
    const bool part = (F.G == 256);
    for (int t0 = gw; t0 < NTOK; t0 += 2 * NGW) {
        u32x4 hv[2][2]; u32x2 y0[2][2], y1[2][2];
#pragma unroll
        for (int q = 0; q < 2; ++q) { int t = (t0 + q * NGW < NTOK) ? t0 + q * NGW : t0; if (part) t = ((t & 2047) >> 8) * 4096 + (t & 255) + 256 * (t >> 11);
#pragma unroll
            for (int hf = 0; hf < 2; ++hf) { const size_t off = hf * 512 + 8 * lane;
                hv[q][hf] = *(const u32x4*)(H + (size_t)t * 1024 + off); y0[q][hf] = *(const u32x2*)(Y + (size_t)(2 * t) * 1024 + off); y1[q][hf] = *(const u32x2*)(Y + (size_t)(2 * t + 1) * 1024 + off); } }
#pragma unroll
        for (int q = 0; q < 2; ++q) { int t = t0 + q * NGW; if (t >= NTOK) break;
            if (part) t = ((t & 2047) >> 8) * 4096 + (t & 255) + 256 * (t >> 11);
            f32x4 v[4]; float ss = 0.f;
#pragma unroll
            for (int hf = 0; hf < 2; ++hf) {
                f32x4 a, b, c, d, e, f; unpack8(hv[q][hf], a, b); unpack8_fp8(y0[q][hf], c, d); unpack8_fp8(y1[q][hf], e, f); a += (c + e) * (1.0f / Y8_SCALE); b += (d + f) * (1.0f / Y8_SCALE); v[2 * hf] = a; v[2 * hf + 1] = b;
                ss += (a[0] * a[0] + a[1] * a[1]) + (a[2] * a[2] + a[3] * a[3]) + (b[0] * b[0] + b[1] * b[1]) + (b[2] * b[2] + b[3] * b[3]); }
            ss = wave_sum(ss);
            const float rs = __builtin_amdgcn_rsqf(ss * (1.0f / 1024.0f) + EPS);
            if (mode == 0) {
#pragma unroll
                for (int hf = 0; hf < 2; ++hf) { *(u32x4*)(Hout + (size_t)t * 1024 + hf * 512 + 8 * lane) = pack8(v[2 * hf], v[2 * hf + 1]);
                    if (MK_IN8) *(u32x2*)(h8c + (size_t)t * 1024 + hf * 512 + 8 * lane) = pack8_fp8(v[2 * hf], v[2 * hf + 1]); }
                if (lane == 0) rstd[t] = rs;
            } else {
#pragma unroll
                for (int hf = 0; hf < 2; ++hf) { float* op = outf + (size_t)t * 1024 + hf * 512 + 8 * lane; *(f32x4*)op = v[2 * hf] * gf[2 * hf] * rs; *(f32x4*)(op + 4) = v[2 * hf + 1] * gf[2 * hf + 1] * rs; }
            }
        }
    }
}

__device__ __forceinline__ void phase_conv(Frame& F, const Args& args, const bf16* XB, bf16* XC) {
    const int gw = F.vcu * 8 + F.wave, NGW = F.G * 8, lane = F.lane;
    const float* cw = args.in[I_RG_CONV_W]; const float* cbv = args.in[I_RG_CONV_B];
    for (int hf = 0; hf < 2; ++hf) {
        const int c0 = hf * 512 + 8 * lane;
        f32x4 w[4][2], cb[2];
#pragma unroll
        for (int k = 0; k < 4; ++k) { w[k][0] = *(const f32x4*)(cw + k * 1024 + c0); w[k][1] = *(const f32x4*)(cw + k * 1024 + c0 + 4); }
        cb[0] = *(const f32x4*)(cbv + c0); cb[1] = *(const f32x4*)(cbv + c0 + 4);
        for (int it = gw; it < NB * (SEQ / 16); it += NGW) {
            const int b = it >> 7, s0 = (it & 127) * 16; const bf16* xp = XB + (size_t)b * SEQ * D + c0; bf16* op = XC + (size_t)b * SEQ * D + c0;
            u32x4 v[19];
#pragma unroll
            for (int j = 0; j < 19; ++j) { const int s = s0 - 3 + j; v[j] = (s >= 0) ? *(const u32x4*)(xp + (size_t)s * D) : (u32x4){0u, 0u, 0u, 0u}; }
            f32x4 xm[3][2];
#pragma unroll
            for (int j = 0; j < 3; ++j) unpack8(v[j], xm[j][0], xm[j][1]);
#pragma unroll
            for (int j = 0; j < 16; ++j) { const int s = s0 + j; f32x4 x0, x1; unpack8(v[3 + j], x0, x1);
                const f32x4 o0 = cb[0] + w[0][0] * xm[0][0] + w[1][0] * xm[1][0] + w[2][0] * xm[2][0] + w[3][0] * x0;
                const f32x4 o1 = cb[1] + w[0][1] * xm[0][1] + w[1][1] * xm[1][1] + w[2][1] * xm[2][1] + w[3][1] * x1;
                *(u32x4*)(op + (size_t)s * D) = pack8(o0, o1);
                xm[0][0] = xm[1][0]; xm[0][1] = xm[1][1]; xm[1][0] = xm[2][0]; xm[1][1] = xm[2][1]; xm[2][0] = x0; xm[2][1] = x1; }
        }
    }
}

constexpr int NSEG = 32, SEGL = SEQ / NSEG;
#ifndef SC1B
#define SC1B 64
#endif
#ifndef SC2B
#define SC2B 32
#endif
__device__ __forceinline__ f32x4 cvt4_fp8(unsigned v, float sc) { const f32x2 lo = __builtin_amdgcn_cvt_pk_f32_fp8((int)v, false), hi = __builtin_amdgcn_cvt_pk_f32_fp8((int)v, true); return (f32x4){lo.x, lo.y, hi.x, hi.y} * sc; }
__device__ __forceinline__ void scan1_item(const unsigned char* __restrict__ LA, const unsigned char* __restrict__ BT, float* __restrict__ AGS, float* __restrict__ AGB, int it, int lane) {
    const int cg = it & 3, sg = (it >> 2) & (NSEG - 1), b = it >> 7; const int ch = cg * 256 + 4 * lane;
    const size_t r0 = ((size_t)b * SEQ + sg * SEGL) * D + ch;
    f32x4 h = {0.f, 0.f, 0.f, 0.f}, ssum = h;
#pragma nounroll
    for (int sb = 0; sb < SEGL; sb += SC1B) {
        unsigned lv[SC1B], bv[SC1B];
#pragma unroll
        for (int k = 0; k < SC1B; ++k) { const size_t o = r0 + (size_t)(sb + k) * D; lv[k] = *(const unsigned*)(LA + o); bv[k] = *(const unsigned*)(BT + o); }
#pragma unroll
        for (int k = 0; k < SC1B; ++k) { const f32x4 l = cvt4_fp8(lv[k], 1.0f / LA8_SCALE), bb = cvt4_fp8(bv[k], 1.0f / BT8_SCALE); ssum += l;
#pragma unroll
            for (int j = 0; j < 4; ++j) h[j] = fast_exp2(l[j] * LOG2E) * h[j] + bb[j]; }
    }
    const size_t ao = ((size_t)b * NSEG + sg) * 1024 + ch;
    *(f32x4*)(AGS + ao) = ssum; *(f32x4*)(AGB + ao) = h;
}
__device__ __forceinline__ void phase_scan1(Frame& F) {
    const int gw = F.vcu * 8 + F.wave, NGW = F.G * 8;
    for (int it = gw; it < NB * NSEG * 4; it += NGW)
        scan1_item((const unsigned char*)(F.ob + OB_LOGA), (const unsigned char*)(F.ob + OB_BT), (float*)(F.ws + WS_AGS), (float*)(F.ws + WS_AGB), it, F.lane);
}
__device__ __forceinline__ void scan2_item(const unsigned char* __restrict__ LA, const unsigned char* __restrict__ BT, const bf16* __restrict__ GATE, bf16* __restrict__ YRG, const float* __restrict__ AGS, const float* __restrict__ AGB, int it, int lane) {
    const int cg = it & 3, sg = (it >> 2) & (NSEG - 1), b = it >> 7; const int ch = cg * 256 + 4 * lane;
    f32x4 h = {0.f, 0.f, 0.f, 0.f};
#pragma nounroll
    for (int c0 = 0; c0 < sg; c0 += 8) {
        f32x4 as[8], ab[8];
#pragma unroll
        for (int c = 0; c < 8; ++c) { const int cc = (c0 + c < sg) ? c0 + c : c0; const size_t ao = ((size_t)b * NSEG + cc) * 1024 + ch; as[c] = *(const f32x4*)(AGS + ao); ab[c] = *(const f32x4*)(AGB + ao); }
#pragma unroll
        for (int c = 0; c < 8; ++c) if (c0 + c < sg) {
#pragma unroll
            for (int j = 0; j < 4; ++j) h[j] = fast_exp2(as[c][j] * LOG2E) * h[j] + ab[c][j]; }
    }
    const size_t r0 = ((size_t)b * SEQ + sg * SEGL) * D + ch;
#pragma nounroll
    for (int sb = 0; sb < SEGL; sb += SC2B) {
        unsigned lv[SC2B], bv[SC2B]; u32x2 gv[SC2B];
#pragma unroll
        for (int k = 0; k < SC2B; ++k) { const size_t o = r0 + (size_t)(sb + k) * D; lv[k] = *(const unsigned*)(LA + o); bv[k] = *(const unsigned*)(BT + o); gv[k] = *(const u32x2*)(GATE + o); }
#pragma unroll
        for (int k = 0; k < SC2B; ++k) { const f32x4 l = cvt4_fp8(lv[k], 1.0f / LA8_SCALE), bb = cvt4_fp8(bv[k], 1.0f / BT8_SCALE);
#pragma unroll
            for (int j = 0; j < 4; ++j) h[j] = fast_exp2(l[j] * LOG2E) * h[j] + bb[j];
            *(u32x2*)(YRG + r0 + (size_t)(sb + k) * D) = (u32x2){cvt_pk_bf16(h[0] * bflo(gv[k].x), h[1] * bfhi(gv[k].x)), cvt_pk_bf16(h[2] * bflo(gv[k].y), h[3] * bfhi(gv[k].y))}; }
    }
}
__device__ __forceinline__ void phase_scan2(Frame& F, const bf16* GATE, bf16* YRG) {
    const int gw = F.vcu * 8 + F.wave, NGW = F.G * 8;
    for (int it = gw; it < NB * NSEG * 4; it += NGW)
        scan2_item((const unsigned char*)(F.ob + OB_LOGA), (const unsigned char*)(F.ob + OB_BT), GATE, YRG, (const float*)(F.ws + WS_AGS), (const float*)(F.ws + WS_AGB), it, F.lane);
}

#if MK_PER_PHASE
#define BAR_WRAP(call) do { } while (0)
#else
#if MK_TSEL >= 0
#define BAR_WRAP(call) do { volatile LAS unsigned* _m = (volatile LAS unsigned*)(F.lds + MISC_OFF); const unsigned _t0 = (unsigned)__builtin_amdgcn_s_memrealtime(); call; \
    if (threadIdx.x == 0) { const unsigned _k = _m[16]; const unsigned _t1 = (unsigned)__builtin_amdgcn_s_memrealtime(); if ((int)_k == MK_TSEL && !MK_GMODE) _m[18] = MK_TWAIT ? (_t1 - _t0) : (_t0 - _m[17]); _m[17] = _t1; _m[16] = _k + 1u; } } while (0)
#else
#define BAR_WRAP(call) call
#endif
#endif
#ifndef MK_MASK
#define MK_MASK 0x1fffffu
#endif
#define IN(k) ((((MK_MASK) >> (k)) & 1u) && lo <= (k) && (k) < hi)
#ifndef MK_GRPMASK
#define MK_GRPMASK 0x5ff5eu
#endif
#define SEAM(k) do { if (lo <= (k) + 1 && (k) + 1 < hi) { if ((((MK_GRPMASK) >> (k)) & 1u) && F.G == 256) { BAR_WRAP(group_barrier((unsigned*)(F.ws + WS_CTL), ++F.gep, 32u, F.guni)); } else { BAR_WRAP(xcd_barrier(bar)); } } } while (0)
#ifndef MK_DUP
#define MK_DUP 0u
#endif

template <int L>
__device__ __forceinline__ void mvw_gemm(Frame& F) {
    unsigned char* ws = F.ws;
    SchedMVW S{F.G, (int)blockIdx.x, (const char*)(ws + WS_K) + (size_t)L * 8388608, (const char*)(ws + WS_V) + (size_t)L * 8388608,
               (const char*)(ws + WS_W_Q) + (size_t)L * 2097152, (const char*)(ws + WS_W_OT) + (size_t)L * 2097152, (char*)(ws + WS_BS), (char*)(ws + WS_BO)};
    pg8::EpiMVW E{};
    pg8::gemm_phase<pg8::EpiMVW, SchedMVW, false>(F.lds + RING_OFF, 256, 2048u, 2048u, S, E, (LAS int*)(F.lds + TAB_OFF));
}
template <int L>
__device__ __forceinline__ void layer_phases(Frame& F, const Args& args, const XcdBarrier& bar, const int lo, const int hi) {
    unsigned char* ws = F.ws;
    LAS int* tab = (LAS int*)(F.lds + TAB_OFF); LAS float* tab2 = (LAS float*)(F.lds + TAB2_OFF);
    float* ss16 = (float*)(ws + WS_SS16);
    constexpr int ps = (L == 0) ? 3 : 15;
    if constexpr (L == 0) {
        if (IN(2)) {
            const bool swp = MK_STAGGER && F.G == 256 && ((int)blockIdx.x & 1);
            if (!swp) mvw_gemm<0>(F);
            SchedDense S{F.G, (int)blockIdx.x, 4, (const char*)(F.ob + OB_P0), (size_t)256 * 2048, (size_t)512, 1, (const char*)(ws + WS_W_POOL), (size_t)131072, 0, 256, MK_WGM_K256};
            pg8::EpiPool E{args.in[I_X], args.in[I_POOL_SCALE], (bf16*)(ws + WS_HA), ss16, (unsigned char*)(F.ob + OB_HMIX8)};
            pg8::gemm_phase<pg8::EpiPool, SchedDense, false>(F.lds + RING_OFF, 256, 2048u, 512u, S, E, tab);
            if (swp) mvw_gemm<0>(F);
            SEAM(2);
        }
    } else {
        const bf16* h3 = (const bf16*)(ws + WS_HA);
        bf16* XB = (bf16*)(ws + WS_HB); bf16* GATE = (bf16*)(ws + WS_Y); bf16* XC = (bf16*)(ws + WS_Y + 64 * MiB); bf16* YRG = (bf16*)(ws + WS_HB); bf16* HC = (bf16*)(ws + WS_Y);
        if (IN(9)) {
            SchedDense S{F.G, (int)blockIdx.x, 8, MK_IN8 ? (const char*)(ws + WS_H8B) : (const char*)h3, (size_t)256 * (MK_IN8 ? 1024 : 2048), 0, 1, (const char*)(ws + WS_W_IN), (size_t)256 * (MK_IN8 ? 1024 : 2048), 0, 256, MK_WGM_IN};
            const int par = ((int)blockIdx.x >> 3) & 1;
            if (par == 0) { conv_moe_weights(F, args, 1); __syncthreads(); }
            fill_row_scale(S, F, (const float*)(ws + WS_RSTD_A), 1);
            pg8::EpiIn E{XB, GATE, tab2};
            if constexpr (MK_IN8 != 0) pg8::gemm_phase<pg8::EpiIn, SchedDense, false, true>(F.lds + RING_OFF, 1024, 1024u, 1024u, S, E, tab);
            else pg8::gemm_phase<pg8::EpiIn, SchedDense, false>(F.lds + RING_OFF, 1024, 2048u, 2048u, S, E, tab);
            if (par != 0) { __syncthreads(); conv_moe_weights(F, args, 1); }
            SEAM(9);
        }
        if (IN(10)) { phase_conv(F, args, XB, XC); SEAM(10); }
        if (IN(11)) {
            SchedDense S{F.G, (int)blockIdx.x, 8, (const char*)XC, (size_t)256 * 2048, (size_t)512, 2, (const char*)(ws + WS_W_GATE), (size_t)131072, 0, 128, MK_WGM_GATES};
            pg8::EpiGates E{XC, (unsigned char*)(F.ob + OB_LOGA), (unsigned char*)(F.ob + OB_BT), args.in[I_RG_B_GATE], (const float*)(ws + WS_SPL)};
            pg8::gemm_phase<pg8::EpiGates, SchedDense, false>(F.lds + RING_OFF, 256, 2048u, 512u, S, E, tab);
            SEAM(11);
        }
        if (IN(12)) { phase_scan1(F); SEAM(12); }
        if (IN(13)) { phase_scan2(F, GATE, YRG); SEAM(13); }
        if (IN(14)) {
            SchedDense S{F.G, (int)blockIdx.x, 4, (const char*)YRG, (size_t)256 * 2048, 0, 1, (const char*)(ws + WS_W_OUT), (size_t)256 * 2048, 0, 256, 8};
            pg8::EpiRes<true> E{h3, HC, ss16, (unsigned char*)(F.ob + OB_HMIX8), 1.0f};
            pg8::gemm_phase<pg8::EpiRes<true>, SchedDense, false>(F.lds + RING_OFF, 1024, 2048u, 2048u, S, E, tab);
            SEAM(14);
        }
    }
    const bf16* hmix = (L == 0) ? (const bf16*)(ws + WS_HA) : (const bf16*)(ws + WS_Y);
    bf16* hatt = (L == 0) ? (bf16*)(ws + WS_HB) : (bf16*)(ws + WS_HA);
    unsigned char* PATT = (unsigned char*)(F.ob + OB_PATT);
    unsigned char* H8P = (L == 0) ? (unsigned char*)(ws + WS_H8) : (unsigned char*)(ws + WS_H8B);
    if (IN(ps)) {
        SchedDense S{F.G, (int)blockIdx.x, 4, (const char*)(F.ob + OB_HMIX8), (size_t)256 * 1024, 0, 1, (const char*)(ws + WS_BS), (size_t)256 * 1024, (size_t)1048576, 256, MK_WGM_ATT};
        const int par = ((int)blockIdx.x >> 3) & 1;
        if constexpr (L == 1) { if (MK_STAGGER && F.G == 256 && lo == 0 && hi == NPH && ((int)blockIdx.x & 1)) { mvw_gemm<1>(F); group_barrier((unsigned*)(F.ws + WS_CTL), ++F.gep, 32u, F.guni); } }
        if constexpr (L == 0) { if (par == 0) { conv_moe_weights(F, args, 0); __syncthreads(); } }
        fill_row_scale(S, F, ss16, 0);
        pg8::EpiS E{PATT, tab2, (LAS f32x2*)(F.lds + XCH_OFF)};
        pg8::gemm_phase<pg8::EpiS, SchedDense, false, true>(F.lds + RING_OFF, 1024, 1024u, 1024u, S, E, tab);
        if constexpr (L == 0) { if (par != 0) { __syncthreads(); conv_moe_weights(F, args, 0); } }
        SEAM(ps);
    }
    if (IN(ps + 1)) {
        SchedDense S{F.G, (int)blockIdx.x, 4, (const char*)PATT, (size_t)256 * 1024, 0, 1, (const char*)(ws + WS_BO), (size_t)256 * 1024, (size_t)1048576, 256, MK_WGM_ATT};
        pg8::EpiRes<false> E{hmix, hatt, ss16, H8P, 1.0f / (P8_SCALE * BO8_SCALE)};
        pg8::gemm_phase<pg8::EpiRes<false>, SchedDense, false, true>(F.lds + RING_OFF, 1024, 1024u, 1024u, S, E, tab);
        SEAM(ps + 1);
    }
    if (IN(ps + 2)) {
        phase_router(F, args, L, hatt);
        SEAM(ps + 2);
    }
    SchedMoE SM;
    if (IN(ps + 3)) {
        const int par = ((int)blockIdx.x >> 3) & 1;
        if constexpr (L == 0) { if (par == 0) { phase_prologue(F, args, 1); __syncthreads(); } }
        SchedMoE& S = SM; moe_sched_init(S, F, L); S.A = (const char*)H8P; S.atile = 0; S.B = (const char*)(ws + WS_W_GU) + (size_t)L * 16777216; S.bexp = 1048576; S.bpn = (size_t)256 * 1024;
        moe_fill_tables(S, F, L, 0);
        pg8::EpiGU E{(unsigned char*)(F.ob + OB_HMID), tab2};
        pg8::gemm_phase<pg8::EpiGU, SchedMoE, true, true>(F.lds + RING_OFF, 1024, 1024u, 1024u, S, E, tab);
        if constexpr (L == 0) { if (par != 0) { __syncthreads(); phase_prologue(F, args, 1); } }
        moe_fill_tables(S, F, L, 1);
        SEAM(ps + 3);
    }
    if (IN(ps + 4)) {
        SchedMoE& S = SM;
        if (!IN(ps + 3)) { moe_sched_init(S, F, L); moe_fill_tables(S, F, L, 1); }
        S.A = (const char*)(F.ob + OB_HMID); S.atile = (size_t)256 * 512; S.B = (const char*)(ws + WS_W_DOWN) + (size_t)L * 8388608; S.bexp = 524288; S.bpn = (size_t)256 * 512;
        pg8::EpiDown E{(unsigned char*)(ws + WS_Y), tab, tab2};
        pg8::gemm_phase<pg8::EpiDown, SchedMoE, false, true>(F.lds + RING_OFF, 512, 512u, 512u, S, E, tab);
        SEAM(ps + 4);
    }
    if (IN(ps + 5)) {
        if constexpr (L == 0) {
            const int par = ((int)blockIdx.x >> 3) & 1;
            const bool late = MK_STAGGER && F.G == 256 && lo == 0 && hi == NPH && ((int)blockIdx.x & 1);
            if (par == 0 && !late) { mvw_gemm<1>(F); __syncthreads(); }
            phase_combine(F, args, 0, hatt, (bf16*)(ws + WS_HA), nullptr, (unsigned char*)(ws + WS_H8B));
            if (par != 0 && !late) { __syncthreads(); mvw_gemm<1>(F); }
            SEAM(ps + 5); }
        else phase_combine(F, args, 1, hatt, nullptr, args.out, nullptr);
    }
}

__global__ void __launch_bounds__(512, 2) hybrid_fwd(Args args) {
    extern __shared__ __attribute__((aligned(16))) unsigned char lds[];
    Frame F;
    F.lds = (LAS unsigned char*)lds;
    F.tid = threadIdx.x; F.lane = F.tid & 63; F.wave = __builtin_amdgcn_readfirstlane(F.tid >> 6);
    F.G = gridDim.x; { const int bx = blockIdx.x; F.vcu = (F.G % 8 == 0) ? (bx % 8) * (F.G / 8) + bx / 8 : bx; }
    F.ws = args.ws; F.ob = (unsigned char*)args.out; F.gep = 0u; F.guni = false;
    volatile LAS unsigned* MISC = (volatile LAS unsigned*)(F.lds + MISC_OFF);
    for (int u = F.tid; u < (LDS_BYTES - MISC_OFF) / 4; u += 512) ((LAS unsigned*)(F.lds + MISC_OFF))[u] = 0u;
    __syncthreads();
    unsigned* ctl = (unsigned*)(F.ws + WS_CTL);
#if MK_PER_PHASE
    XcdBarrier bar; bar.bar = ctl + CW_BAR; bar.x = 0; bar.st = nullptr;
#else
    XcdBarrier bar = xcd_barrier_post(ctl + CW_BAR, MISC + 8);
#endif
    const int lo = args.ph_lo, hi = args.ph_hi;
    unsigned char* ws = F.ws;
    LAS int* tab = (LAS int*)(F.lds + TAB_OFF);
    if (threadIdx.x == 0) __hip_atomic_store(ctl + CW_GXCC + blockIdx.x, xb_xcc_id() + 1u, __ATOMIC_RELAXED, __HIP_MEMORY_SCOPE_AGENT);
#if MK_TSEL >= 0
    if (threadIdx.x == 0) MISC[17] = (unsigned)__builtin_amdgcn_s_memrealtime();
#endif

    if (IN(0)) { phase_prologue(F, args, 0); SEAM(0); }
    if (F.G == 256 && lo == 0 && hi == NPH) {
        unsigned v[32]; const unsigned mine = xb_xcc_id() + 1u; bool same = true;
#pragma unroll
        for (int k = 0; k < 32; ++k) v[k] = xb_ld(ctl + CW_GXCC + (blockIdx.x & 7u) + 8u * k);
#pragma unroll
        for (int k = 0; k < 32; ++k) same = same && (v[k] == mine);
        F.guni = same;
    }
    if (IN(1)) {
        const int par = ((int)blockIdx.x >> 3) & 1;
        if (par == 0) { phase_pool_p(F, args); __syncthreads(); }
        {
            SchedKV S{F.G, (int)blockIdx.x, (const char*)(ws + WS_MEMN), (const char*)(ws + WS_W_KV), (char*)(ws + WS_K), (char*)(ws + WS_V)};
            pg8::EpiPlain E{1024};
            pg8::gemm_phase<pg8::EpiPlain, SchedKV, false>(F.lds + RING_OFF, 1024, 2048u, 2048u, S, E, tab);
        }
        if (par != 0) { __syncthreads(); phase_pool_p(F, args); }
        SEAM(1);
    }
    layer_phases<0>(F, args, bar, lo, hi);
    layer_phases<1>(F, args, bar, lo, hi);
#if MK_TSEL >= 0
    if ((int)blockIdx.x == MK_TBLK && threadIdx.x == 0) { const unsigned long long w = (unsigned long long)MISC[18] * MK_TAMP, t0 = __builtin_amdgcn_s_memrealtime();
        while (__builtin_amdgcn_s_memrealtime() - t0 < w) __builtin_amdgcn_s_sleep(8); }
#endif
}
#undef IN
#undef SEAM

extern "C" void kernel_launch(void* const* d_in, const int* in_sizes, int n_in, void* d_out, int out_size, void* d_ws, size_t ws_size, hipStream_t stream) {
    static int grid = 0;
    if (grid == 0) {
        if (n_in != 25 || out_size != NTOK * D || ws_size < WS_END) { fprintf(stderr, "kernel_launch: unexpected shapes (n_in %d, out %d, ws %zu)\n", n_in, out_size, ws_size); grid = -1; return; }
        int dev = 0, cus = 0, per_cu = 0;
        if (hipGetDevice(&dev) != hipSuccess || hipDeviceGetAttribute(&cus, hipDeviceAttributeMultiprocessorCount, dev) != hipSuccess) { grid = -1; return; }
        if (hipFuncSetAttribute((const void*)hybrid_fwd, hipFuncAttributeMaxDynamicSharedMemorySize, LDS_BYTES) != hipSuccess) { fprintf(stderr, "kernel_launch: hipFuncSetAttribute failed\n"); grid = -1; return; }
        if (hipOccupancyMaxActiveBlocksPerMultiprocessor(&per_cu, (const void*)hybrid_fwd, 512, LDS_BYTES) != hipSuccess || per_cu < 1) fprintf(stderr, "kernel_launch: occupancy query reports %d\n", per_cu);
        (void)hipGetLastError();
        grid = cus;
    }
    if (grid < 0) return;
    (void)hipMemsetAsync((char*)d_ws + WS_CTL, 0, CTL_ZERO_BYTES, stream);
    Args a{};
    for (int i = 0; i < 25; ++i) a.in[i] = (const float*)d_in[i];
    a.out = (float*)d_out; a.ws = (unsigned char*)d_ws; a.dup = 0; a.pad = 0;
#if MK_PER_PHASE
    for (int p = 0; p < NPH; ++p) for (int r = 0; r < ((((MK_DUP) >> p) & 1u) ? 2 : 1); ++r) {
        if (r == 1 && (p == 5 || p == 17)) (void)hipMemsetAsync((char*)d_ws + WS_CTL + (size_t)(CW_CNT + (p == 17 ? 1 : 0) * 16 * 64) * 4, 0, 16 * 64 * 4, stream);
        a.ph_lo = p; a.ph_hi = p + 1; hipLaunchKernelGGL(hybrid_fwd, dim3(grid), dim3(512), LDS_BYTES, stream, a); }
#else
    a.ph_lo = 0; a.ph_hi = NPH; hipLaunchKernelGGL(hybrid_fwd, dim3(grid), dim3(512), LDS_BYTES, stream, a);
#endif
}
```
